# Optimizing an MI355X kernel written in HIP

```python
import jax, jax.numpy as jnp
from jax import lax
import numpy as np

D_MODEL = 1024
BATCH = 32
SEQ = 2048
DEPTH = 1
DEC_BATCH = 128
DEC_SEQ = 4
PAST_LEN = 8192
PAGE_SIZE = 128

D_CONV = 512
CONV_WIDTH = 3
N_HEADS = 8
N_KV_HEADS = 2
HEAD_DIM = 64
IDX_HEADS = 8
IDX_DIM = 64
IDX_SCALE = (IDX_DIM ** -0.5) * (IDX_HEADS ** -0.5)
TOPK_MAX = 256
Q_BLOCK = 128
ROPE_THETA = 10000.0
PEER_HEADS = 8
PEER_KEYS = 128
PEER_N_EXPERTS = PEER_KEYS * PEER_KEYS
PEER_QDIM = 256
PEER_TOPK = 16
PEER_BLOCK = 128
N_MOD = 6
NORM_EPS = 1e-6
NEG_INF = -1e30
PROJ_WIDTH = 3 * D_CONV + (N_HEADS + 2 * N_KV_HEADS) * HEAD_DIM + IDX_HEADS * IDX_DIM + IDX_DIM + IDX_HEADS + 2 * D_MODEL

kernel_name = "hybrid_shortconv_dsa_peer_adaln_step"


def _rmsnorm(x, w):
    xf = x.astype(jnp.float32)
    y = xf * lax.rsqrt(jnp.mean(xf * xf, axis=-1, keepdims=True) + NORM_EPS)
    return (y * w.astype(jnp.float32)).astype(x.dtype)


def _modulate(h, shift, scale):
    return h * (1.0 + scale[:, None, :]) + shift[:, None, :]


def _adaln(c, w_ada, b_ada):
    mod = c @ w_ada + b_ada
    return jnp.split(mod, N_MOD, axis=-1)


def _rope(x, pos):
    d = x.shape[-1]
    half = d // 2
    freqs = ROPE_THETA ** (-jnp.arange(half, dtype=jnp.float32) / half)
    ang = pos.astype(jnp.float32)[:, None] * freqs[None, :]
    cos = jnp.cos(ang)[:, None, :]
    sin = jnp.sin(ang)[:, None, :]
    xf = x.astype(jnp.float32)
    x1, x2 = xf[..., :half], xf[..., half:]
    return jnp.concatenate([x1 * cos - x2 * sin, x2 * cos + x1 * sin], axis=-1).astype(x.dtype)


def _split_proj(z):
    sizes = (D_CONV, D_CONV, D_CONV, N_HEADS * HEAD_DIM, N_KV_HEADS * HEAD_DIM, N_KV_HEADS * HEAD_DIM,
             IDX_HEADS * IDX_DIM, IDX_DIM, IDX_HEADS, D_MODEL, D_MODEL)
    parts, start = [], 0
    for s in sizes:
        parts.append(z[..., start:start + s])
        start += s
    return parts


def _mixer_inputs(x, shift, scale, norm_w, w_in, q_norm_w, k_norm_w, pos):
    h = _modulate(_rmsnorm(x, norm_w), shift, scale)
    z = jnp.einsum('btd,dp->btp', h, w_in)
    xin, b_gate, c_gate, q, k, v, qi, ki, wi, g_a, g_b = _split_proj(z)
    bsz, t = x.shape[0], x.shape[1]
    u = c_gate * xin
    q = _rope(_rmsnorm(q.reshape(bsz, t, N_HEADS, HEAD_DIM), q_norm_w), pos)
    k = _rope(_rmsnorm(k.reshape(bsz, t, N_KV_HEADS, HEAD_DIM), k_norm_w), pos)
    v = v.reshape(bsz, t, N_KV_HEADS, HEAD_DIM)
    qi = _rope(qi.reshape(bsz, t, IDX_HEADS, IDX_DIM), pos)
    ki = _rope(ki[:, :, None, :], pos)[:, :, 0, :]
    wi = wi * IDX_SCALE
    return u, b_gate, q, k, v, qi, ki, wi, g_a, g_b


def _causal_conv(u, past, conv_w):
    full = jnp.concatenate([past.astype(u.dtype), u], axis=1)
    t = u.shape[1]
    y = conv_w[CONV_WIDTH - 1] * full[:, CONV_WIDTH - 1:CONV_WIDTH - 1 + t]
    for j in range(CONV_WIDTH - 1):
        y = y + conv_w[j] * full[:, j:j + t]
    return y, full[:, full.shape[1] - (CONV_WIDTH - 1):]


def _index_select(qi, wi, pos_q, ki, pos_k, topk):
    s = jnp.einsum('qhd,ld->qhl', qi.astype(jnp.float32), ki.astype(jnp.float32))
    score = jnp.einsum('qh,qhl->ql', wi.astype(jnp.float32), jax.nn.relu(s))
    score = jnp.where(pos_k[None, :] <= pos_q[:, None], score, NEG_INF)
    _, sel = lax.top_k(score, topk)
    return sel


def _sparse_attend(q, ks, vs, valid):
    nq = q.shape[0]
    qg = q.reshape(nq, N_KV_HEADS, N_HEADS // N_KV_HEADS, HEAD_DIM).astype(jnp.float32)
    logits = jnp.einsum('qngd,qsnd->qngs', qg, ks.astype(jnp.float32)) * (HEAD_DIM ** -0.5)
    logits = jnp.where(valid[:, None, None, :], logits, NEG_INF)
    p = jax.nn.softmax(logits, axis=-1)
    o = jnp.einsum('qngs,qsnd->qngd', p, vs.astype(jnp.float32))
    return o.reshape(nq, N_HEADS * HEAD_DIM).astype(q.dtype)


def _prompt_attention(q, k, v, qi, ki, wi, pos):
    bsz, t = q.shape[0], q.shape[1]
    nb = t // Q_BLOCK
    topk = min(TOPK_MAX, t // 4)

    def one_block(idx):
        b = idx // nb
        start = (idx % nb) * Q_BLOCK
        row = lambda a: lax.dynamic_index_in_dim(a, b, 0, keepdims=False)
        blk = lambda a: lax.dynamic_slice_in_dim(row(a), start, Q_BLOCK, 0)
        qb, qib, wib = blk(q), blk(qi), blk(wi)
        pos_q = lax.dynamic_slice_in_dim(pos, start, Q_BLOCK, 0)
        kb, vb, kib = row(k), row(v), row(ki)
        sel = _index_select(qib, wib, pos_q, kib, pos, topk)
        valid = pos[sel] <= pos_q[:, None]
        return _sparse_attend(qb, kb[sel], vb[sel], valid)

    out = lax.map(one_block, jnp.arange(bsz * nb, dtype=jnp.int32))
    return out.reshape(bsz, t, N_HEADS * HEAD_DIM)


def _sample_attention(q, k_new, v_new, qi, ki_new, wi, pos_q, pool_k, pool_v, pool_ki, page_table):
    db, ds = q.shape[0], q.shape[1]
    past = page_table.shape[1] * PAGE_SIZE
    total = past + ds
    topk = min(TOPK_MAX, total // 4)
    ki_past = pool_ki[page_table].reshape(db, past, IDX_DIM)
    ki_all = jnp.concatenate([ki_past, ki_new.astype(ki_past.dtype)], axis=1)
    pos_k = jnp.arange(total, dtype=jnp.int32)
    sel = jax.vmap(lambda a, w, kk: _index_select(a, w, pos_q, kk, pos_k, topk))(qi, wi, ki_all)
    in_past = sel < past
    ps = jnp.minimum(sel, past - 1)
    phys = jnp.take_along_axis(page_table, (ps // PAGE_SIZE).reshape(db, -1), axis=1).reshape(sel.shape)
    rows = phys * PAGE_SIZE + ps % PAGE_SIZE
    ns = jnp.clip(sel - past, 0, ds - 1)
    take_new = jax.vmap(lambda arr, idx: arr[idx])
    ks = jnp.where(in_past[..., None, None], pool_k.reshape(-1, N_KV_HEADS, HEAD_DIM)[rows], take_new(k_new, ns))
    vs = jnp.where(in_past[..., None, None], pool_v.reshape(-1, N_KV_HEADS, HEAD_DIM)[rows], take_new(v_new, ns))
    valid = sel <= pos_q[None, :, None]
    return jax.vmap(_sparse_attend)(q, ks, vs, valid)


def _peer(h, w_q, sub_keys, u_tab, v_tab):
    t = h.shape[0]
    pad = (-t) % PEER_BLOCK
    blocks = jnp.pad(h, ((0, pad), (0, 0))).reshape(-1, PEER_BLOCK, D_MODEL)

    def block_fn(hb):
        q = (hb @ w_q).reshape(PEER_BLOCK, PEER_HEADS, 2, PEER_QDIM // 2).astype(jnp.float32)
        s = jnp.einsum('thpd,phkd->thpk', q, sub_keys.astype(jnp.float32))
        s1, i1 = lax.top_k(s[:, :, 0], PEER_TOPK)
        s2, i2 = lax.top_k(s[:, :, 1], PEER_TOPK)
        cand = (s1[..., :, None] + s2[..., None, :]).reshape(PEER_BLOCK, PEER_HEADS, PEER_TOPK * PEER_TOPK)
        cidx = (i1[..., :, None] * PEER_KEYS + i2[..., None, :]).reshape(PEER_BLOCK, PEER_HEADS, PEER_TOPK * PEER_TOPK)
        top_s, top_pos = lax.top_k(cand, PEER_TOPK)
        e = jnp.take_along_axis(cidx, top_pos, axis=-1)
        g = jax.nn.softmax(top_s, axis=-1)
        act = jax.nn.gelu(jnp.einsum('thkd,td->thk', u_tab[e], hb).astype(jnp.float32))
        return jnp.einsum('thk,thkd->td', (g * act).astype(hb.dtype), v_tab[e])

    return lax.map(block_fn, blocks).reshape(-1, D_MODEL)[:t]


def _finish_layer(x, a_pre, attn_o, g_a, g_b, gate1, shift2, scale2, gate2, w_conv_out, w_attn_out, w_out,
                  norm2_w, peer_w_q, peer_sub_keys, peer_u, peer_v):
    y_a = a_pre @ w_conv_out
    y_b = attn_o @ w_attn_out
    mix = jax.nn.sigmoid(g_a) * y_a + jax.nn.sigmoid(g_b) * y_b
    x = x + gate1[:, None, :] * (mix @ w_out)
    h2 = _modulate(_rmsnorm(x, norm2_w), shift2, scale2)
    y = _peer(h2.reshape(-1, D_MODEL), peer_w_q, peer_sub_keys, peer_u, peer_v).reshape(x.shape)
    return x + gate2[:, None, :] * y


def setup_inputs(seed: int = 0) -> dict:
    key = jax.random.key(seed)
    ks = jax.random.split(key, 32)
    f32 = jnp.float32
    n_pages = PAST_LEN // PAGE_SIZE
    n_phys = (DEC_BATCH * n_pages * 5) // 4

    def nrm(k, shape, scale):
        return jax.random.normal(k, shape, f32) * scale

    page_table = jax.random.permutation(ks[8], n_phys)[:DEC_BATCH * n_pages].reshape(DEC_BATCH, n_pages).astype(jnp.int32)
    return {
        "x_prompt": nrm(ks[0], (BATCH, SEQ, D_MODEL), 1.0),
        "x_sample": nrm(ks[1], (DEC_BATCH, DEC_SEQ, D_MODEL), 1.0),
        "cache_k": nrm(ks[4], (DEPTH, n_phys, PAGE_SIZE, N_KV_HEADS, HEAD_DIM), 1.0),
        "cache_v": nrm(ks[5], (DEPTH, n_phys, PAGE_SIZE, N_KV_HEADS, HEAD_DIM), 1.0),
        "cache_kidx": nrm(ks[6], (DEPTH, n_phys, PAGE_SIZE, IDX_DIM), 1.0),
        "state_conv": nrm(ks[7], (DEPTH, DEC_BATCH, CONV_WIDTH - 1, D_CONV), 1.0),
        "page_table": page_table,
        "c_prompt": nrm(ks[2], (BATCH, D_MODEL), 1.0),
        "c_sample": nrm(ks[3], (DEC_BATCH, D_MODEL), 1.0),
        "w_ada": nrm(ks[9], (DEPTH, D_MODEL, N_MOD * D_MODEL), 0.1 * D_MODEL ** -0.5),
        "b_ada": nrm(ks[10], (DEPTH, N_MOD * D_MODEL), 0.01),
        "norm1_w": 1.0 + nrm(ks[11], (DEPTH, D_MODEL), 0.01),
        "w_in": nrm(ks[12], (DEPTH, D_MODEL, PROJ_WIDTH), D_MODEL ** -0.5),
        "conv_w": nrm(ks[13], (DEPTH, CONV_WIDTH, D_CONV), CONV_WIDTH ** -0.5),
        "q_norm_w": 1.0 + nrm(ks[14], (DEPTH, HEAD_DIM), 0.01),
        "k_norm_w": 1.0 + nrm(ks[15], (DEPTH, HEAD_DIM), 0.01),
        "w_conv_out": nrm(ks[16], (DEPTH, D_CONV, D_MODEL), D_CONV ** -0.5),
        "w_attn_out": nrm(ks[17], (DEPTH, N_HEADS * HEAD_DIM, D_MODEL), (N_HEADS * HEAD_DIM) ** -0.5),
        "w_out": nrm(ks[18], (DEPTH, D_MODEL, D_MODEL), D_MODEL ** -0.5),
        "norm2_w": 1.0 + nrm(ks[19], (DEPTH, D_MODEL), 0.01),
        "peer_w_q": nrm(ks[20], (DEPTH, D_MODEL, PEER_HEADS * PEER_QDIM), D_MODEL ** -0.5),
        "peer_sub_keys": nrm(ks[21], (DEPTH, 2, PEER_HEADS, PEER_KEYS, PEER_QDIM // 2), (PEER_QDIM // 2) ** -0.5),
        "peer_u": nrm(ks[22], (DEPTH, PEER_N_EXPERTS, D_MODEL), D_MODEL ** -0.5),
        "peer_v": nrm(ks[23], (DEPTH, PEER_N_EXPERTS, D_MODEL), PEER_HEADS ** -0.5),
    }


def reference(x_prompt, x_sample, cache_k, cache_v, cache_kidx, state_conv, page_table, c_prompt, c_sample,
              w_ada, b_ada, norm1_w, w_in, conv_w, q_norm_w, k_norm_w, w_conv_out, w_attn_out, w_out,
              norm2_w, peer_w_q, peer_sub_keys, peer_u, peer_v):
    pos_p = jnp.arange(SEQ, dtype=jnp.int32)
    pos_s = PAST_LEN + jnp.arange(DEC_SEQ, dtype=jnp.int32)
    xp, xs = x_prompt, x_sample
    kp_l, vp_l, kip_l, cp_l = [], [], [], []
    ks_l, vs_l, kis_l, cs_l = [], [], [], []
    for layer in range(DEPTH):
        sh1, sc1, g1, sh2, sc2, g2 = _adaln(c_prompt, w_ada[layer], b_ada[layer])
        u, bg, q, k, v, qi, ki, wi, ga, gb = _mixer_inputs(xp, sh1, sc1, norm1_w[layer], w_in[layer],
                                                           q_norm_w[layer], k_norm_w[layer], pos_p)
        y_conv, conv_p = _causal_conv(u, jnp.zeros((xp.shape[0], CONV_WIDTH - 1, D_CONV), u.dtype), conv_w[layer])
        attn = _prompt_attention(q, k, v, qi, ki, wi, pos_p)
        xp = _finish_layer(xp, bg * y_conv, attn, ga, gb, g1, sh2, sc2, g2, w_conv_out[layer], w_attn_out[layer],
                           w_out[layer], norm2_w[layer], peer_w_q[layer], peer_sub_keys[layer], peer_u[layer], peer_v[layer])
        kp_l.append(k); vp_l.append(v); kip_l.append(ki); cp_l.append(conv_p)
        sh1, sc1, g1, sh2, sc2, g2 = _adaln(c_sample, w_ada[layer], b_ada[layer])
        u, bg, q, k, v, qi, ki, wi, ga, gb = _mixer_inputs(xs, sh1, sc1, norm1_w[layer], w_in[layer],
                                                           q_norm_w[layer], k_norm_w[layer], pos_s)
        y_conv, conv_s = _causal_conv(u, state_conv[layer], conv_w[layer])
        attn = _sample_attention(q, k, v, qi, ki, wi, pos_s, cache_k[layer], cache_v[layer], cache_kidx[layer], page_table)
        xs = _finish_layer(xs, bg * y_conv, attn, ga, gb, g1, sh2, sc2, g2, w_conv_out[layer], w_attn_out[layer],
                           w_out[layer], norm2_w[layer], peer_w_q[layer], peer_sub_keys[layer], peer_u[layer], peer_v[layer])
        ks_l.append(k); vs_l.append(v); kis_l.append(ki); cs_l.append(conv_s)
    k_prompt, v_prompt = jnp.stack(kp_l), jnp.stack(vp_l)
    kidx_prompt, conv_prompt = jnp.stack(kip_l), jnp.stack(cp_l)
    k_sample, v_sample = jnp.stack(ks_l), jnp.stack(vs_l)
    kidx_sample, conv_sample = jnp.stack(kis_l), jnp.stack(cs_l)
    return (xp, xs, k_prompt, v_prompt, kidx_prompt, conv_prompt, k_sample, v_sample, kidx_sample, conv_sample)
```

```cpp
#include <hip/hip_runtime.h>
#include <cstdio>
#include <cstdint>

#ifndef N_LAUNCH_MODE
#define N_LAUNCH_MODE 1
#endif

#define REPEAT_MASK 0x0000

#define PROBE_PARTS 15
#define LAS __attribute__((address_space(3)))
typedef unsigned short bf16_t;
typedef short bf16x8 __attribute__((ext_vector_type(8)));
typedef short bf16x4 __attribute__((ext_vector_type(4)));
typedef float f32x4 __attribute__((ext_vector_type(4)));
typedef float f32x2 __attribute__((ext_vector_type(2)));
typedef float f32x16 __attribute__((ext_vector_type(16)));
typedef unsigned u32x4 __attribute__((ext_vector_type(4)));
typedef unsigned u32x2 __attribute__((ext_vector_type(2)));
typedef unsigned long long u64;

constexpr int D = 1024, TP = 65536, TS = 512, T = TP + TS, SEQ = 2048, NB = 32, DB = 128, DS = 4;
constexpr int PAST = 8192, PAGE = 128, NPG = 64;
constexpr int NPROJ = 4936, NPROJ_PAD = 5120;
constexpr int NMOD = 6144;
constexpr float NORM_EPS = 1e-6f;
constexpr float IDX_SCALE = 0.125f * 0.35355339059327373f;
constexpr size_t OFF_Y = 0;
constexpr size_t OFF_KP = (size_t)T * D;
constexpr size_t OFF_VP = OFF_KP + (size_t)TP * 128;
constexpr size_t OFF_KIP = OFF_VP + (size_t)TP * 128;
constexpr size_t OFF_CONVP = OFF_KIP + (size_t)TP * 64;
constexpr size_t OFF_KS = OFF_CONVP + (size_t)NB * 2 * 512;
constexpr size_t OFF_VS = OFF_KS + (size_t)TS * 128;
constexpr size_t OFF_KIS = OFF_VS + (size_t)TS * 128;
constexpr size_t OFF_CONVS = OFF_KIS + (size_t)TS * 64;
constexpr size_t OUT_TOTAL = OFF_CONVS + (size_t)DB * 2 * 512;
static_assert(OUT_TOTAL == 88932352, "out size");

constexpr size_t al256(size_t x) { return (x + 255) & ~(size_t)255; }
constexpr size_t WS_CTL = 0;
constexpr size_t CTL_BYTES = 65536;
constexpr size_t WS_WIN = WS_CTL + CTL_BYTES;
constexpr size_t WS_WCO = WS_WIN + (size_t)NPROJ_PAD * 1024 * 2;
constexpr size_t WS_WAO = WS_WCO + (size_t)1024 * 512 * 2;
constexpr size_t WS_WOUT = WS_WAO + (size_t)1024 * 512 * 2;
constexpr size_t WS_WQ = WS_WOUT + (size_t)1024 * 1024 * 2;
constexpr size_t WS_SKBD = WS_WQ + (size_t)2048 * 1024 * 2;
constexpr size_t WS_UT = WS_SKBD + (size_t)2048 * 256 * 2;
constexpr size_t WS_VT2 = WS_UT + (size_t)16384 * 1024;
constexpr size_t WS_TSC = WS_VT2 + (size_t)16384 * 1024;
constexpr size_t WS_WADA = WS_TSC + (size_t)2 * 16384 * 4;
constexpr size_t WS_CB = WS_WADA + (size_t)NMOD * 1024 * 2;
constexpr size_t WS_MOD = WS_CB + (size_t)256 * 1024 * 2;
constexpr size_t WS_ROPE = WS_MOD + (size_t)256 * NMOD * 4;
constexpr size_t WS_H = al256(WS_ROPE + (size_t)2052 * 32 * 8);
constexpr size_t WS_U = WS_H + (size_t)T * 1024 * 2;
constexpr size_t WS_BG = WS_U + (size_t)T * 512 * 2;
constexpr size_t WS_Q = WS_BG + (size_t)T * 512 * 2;
constexpr size_t WS_K = WS_Q + (size_t)T * 512 * 2;
constexpr size_t WS_V = WS_K + (size_t)T * 128 * 2;
constexpr size_t WS_VTR = WS_V + (size_t)T * 128 * 2;
constexpr size_t WS_QI = WS_VTR + (size_t)TP * 128 * 2;
constexpr size_t WS_KI = WS_QI + (size_t)T * 512 * 2;
constexpr size_t WS_WI = WS_KI + (size_t)T * 64 * 2;
constexpr size_t WS_SGA = WS_WI + (size_t)T * 8 * 4;
constexpr size_t WS_SGB = WS_SGA + (size_t)T * 1024 * 2;
constexpr size_t WS_MASK = WS_SGB + (size_t)T * 1024 * 2;
constexpr size_t WS_APRE = WS_MASK + (size_t)TP * 32 * 8;
constexpr size_t WS_ATT = WS_APRE + (size_t)T * 512 * 2;
constexpr size_t WS_MIX = WS_ATT + (size_t)T * 512 * 2;
constexpr size_t WS_Q2 = WS_MIX + (size_t)T * 1024 * 2;
constexpr size_t WS_EIDX = WS_Q2 + (size_t)T * 2048 * 2;
constexpr size_t WS_G = WS_EIDX + (size_t)T * 128 * 4;
constexpr size_t WS_SCR = WS_G + (size_t)T * 128 * 4;
constexpr size_t SCR_BYTES = (size_t)T * 2048 * 4;
constexpr size_t WS_X1 = WS_SCR + SCR_BYTES;
constexpr size_t WS_ACT = WS_X1 + (size_t)T * 1024 * 4;
constexpr size_t WS_LISTG = WS_ACT + (size_t)T * 128 * 4;
constexpr size_t WS_METAG = WS_LISTG + (size_t)256 * 8192 * 4;
constexpr size_t WS_END = WS_METAG + (size_t)T * 128 * 8;

constexpr int CW_BAR = 0;
constexpr int CW_Q4 = 4096;
constexpr int CW_Q5 = 8192;

constexpr int LDS_BYTES = 155648;
constexpr int LDS_MISC = 155648 - 64;

#define XB_TMO      128
#define XB_XCNT(j)  (256  + 64 * (j))
#define XB_XSUB(j)  (1280 + 64 * (j))
#define XB_XGEN(j)  (2304 + 64 * (j))
#define XB_TOP      3328
#define XB_TOPGEN   3392
#define XCD_BAR_WORDS 3456
#define XB_SPIN_CAP (1u << 18)

__device__ __forceinline__ unsigned xb_ld(unsigned* p)              { return __hip_atomic_load(p, __ATOMIC_RELAXED, __HIP_MEMORY_SCOPE_AGENT); }
__device__ __forceinline__ unsigned xb_add(unsigned* p, unsigned v) { return __hip_atomic_fetch_add(p, v, __ATOMIC_RELAXED, __HIP_MEMORY_SCOPE_AGENT); }
__device__ __forceinline__ unsigned xb_xcc_id() { return (unsigned)__builtin_amdgcn_s_getreg((3 << 11) | 20) & 0xFu; }
#define XB_SPIN(cond, bar) do { unsigned _sp = 0; while (cond) { __builtin_amdgcn_s_sleep(1); \
    if ((++_sp & 255u) == 0u) { if (xb_ld(&(bar)[XB_TMO])) break; if (_sp > XB_SPIN_CAP) { atomicAdd(&(bar)[XB_TMO], 1u); break; } } } } while (0)

struct XcdBarrier { unsigned* bar; unsigned x; volatile LAS unsigned* st; };

__device__ __forceinline__ XcdBarrier xcd_barrier_post(unsigned* bar, volatile LAS unsigned* st) {
    XcdBarrier b; b.bar = bar; b.x = xb_xcc_id(); b.st = st;
    if (threadIdx.x == 0) (void)xb_add(&bar[XB_XCNT(b.x)], 1u);
    return b;
}
__device__ __forceinline__ void xcd_barrier_complete(unsigned* bar, unsigned x, unsigned& nloc, unsigned& nx) {
    const unsigned G = gridDim.x * gridDim.y * gridDim.z;
    unsigned sum, cnt, mine, sp = 0u;
    for (;;) {
        sum = 0u; cnt = 0u; mine = 0u;
#pragma unroll
        for (unsigned j = 0; j < 16; ++j) { const unsigned c = xb_ld(&bar[XB_XCNT(j)]); sum += c; cnt += (c > 0u) ? 1u : 0u; mine = (j == x) ? c : mine; }
        if (sum == G) break;
        __builtin_amdgcn_s_sleep(1);
        if ((++sp & 255u) == 0u) { if (xb_ld(&bar[XB_TMO])) break; if (sp > XB_SPIN_CAP) { atomicAdd(&bar[XB_TMO], 1u); break; } }
    }
    nloc = mine > 0u ? mine : 1u; nx = cnt > 0u ? cnt : 1u;
}
__device__ __forceinline__ void xcd_barrier(const XcdBarrier& b) {
    asm volatile("s_waitcnt vmcnt(0)" ::: "memory");
    __syncthreads();
    if (threadIdx.x == 0) {
        unsigned* bar = b.bar;
        __builtin_amdgcn_s_waitcnt(0);
        unsigned nloc = b.st[0], nx = b.st[1];
        if (nloc == 0u) { xcd_barrier_complete(bar, b.x, nloc, nx); b.st[0] = nloc; b.st[1] = nx; }
        const unsigned old = xb_add(&bar[XB_XSUB(b.x)], 1u);
        const unsigned gen = old / nloc;
        if (old + 1u == (gen + 1u) * nloc) {
            __builtin_amdgcn_fence(__ATOMIC_RELEASE, "agent");
            asm volatile("s_waitcnt vmcnt(0)" ::: "memory");
            const unsigned og = xb_add(&bar[XB_TOP], 1u);
            const unsigned tg = og / nx;
            if (og + 1u == (tg + 1u) * nx) xb_add(&bar[XB_TOPGEN], 1u);
            else XB_SPIN(xb_ld(&bar[XB_TOPGEN]) == tg, bar);
            __builtin_amdgcn_fence(__ATOMIC_ACQUIRE, "agent");
            xb_add(&bar[XB_XGEN(b.x)], 1u);
            asm volatile("s_waitcnt vmcnt(0)" ::: "memory");
        } else {
            XB_SPIN(xb_ld(&bar[XB_XGEN(b.x)]) == gen, bar);
            __builtin_amdgcn_fence(__ATOMIC_ACQUIRE, "agent");
            asm volatile("s_waitcnt vmcnt(0)" ::: "memory");
        }
    }
    __syncthreads();
}

typedef __bf16 cvtbf2_t __attribute__((ext_vector_type(2)));
__device__ __forceinline__ unsigned cvt_pk_bf16(float lo, float hi) { const cvtbf2_t v = __builtin_convertvector((f32x2){lo, hi}, cvtbf2_t); return __builtin_bit_cast(unsigned, v); }
__device__ __forceinline__ float bf_lo(unsigned u) { return __uint_as_float(u << 16); }
__device__ __forceinline__ float bf_hi(unsigned u) { return __uint_as_float(u & 0xffff0000u); }
__device__ __forceinline__ float bf2f(bf16_t b) { return __uint_as_float(((unsigned)b) << 16); }
__device__ __forceinline__ u32x4 pack8(const float (&v)[8]) { u32x4 w; w.x = cvt_pk_bf16(v[0], v[1]); w.y = cvt_pk_bf16(v[2], v[3]); w.z = cvt_pk_bf16(v[4], v[5]); w.w = cvt_pk_bf16(v[6], v[7]); return w; }
__device__ __forceinline__ void unpack8(const u32x4 w, float (&v)[8]) { v[0] = bf_lo(w.x); v[1] = bf_hi(w.x); v[2] = bf_lo(w.y); v[3] = bf_hi(w.y); v[4] = bf_lo(w.z); v[5] = bf_hi(w.z); v[6] = bf_lo(w.w); v[7] = bf_hi(w.w); }
__device__ __forceinline__ unsigned mono(float v) { const unsigned u = __float_as_uint(v); return (u & 0x80000000u) ? ~u : (u | 0x80000000u); }
__device__ __forceinline__ float unmono(unsigned k) { const unsigned u = (k & 0x80000000u) ? (k & 0x7fffffffu) : ~k; return __uint_as_float(u); }
__device__ __forceinline__ float sigmoidf_(float x) { return __builtin_amdgcn_rcpf(1.0f + __expf(-x)); }
__device__ __forceinline__ float gelu_tanh(float x) { const float u = 0.7978845608028654f * (x + 0.044715f * x * x * x); const float e = __expf(2.0f * u); const float th = 1.0f - 2.0f * __builtin_amdgcn_rcpf(e + 1.0f); return 0.5f * x * (1.0f + th); }
__device__ __forceinline__ int mbcnt64(u64 m) { return (int)__builtin_amdgcn_mbcnt_hi((unsigned)(m >> 32), __builtin_amdgcn_mbcnt_lo((unsigned)m, 0u)); }
__device__ __forceinline__ float wave_sum(float v) {
#pragma unroll
    for (int o = 32; o > 0; o >>= 1) v += __shfl_xor(v, o);
    return v;
}
__device__ __forceinline__ float wave_max(float v) {
#pragma unroll
    for (int o = 32; o > 0; o >>= 1) v = fmaxf(v, __shfl_xor(v, o));
    return v;
}

namespace pg8 {
constexpr int BM = 256, BK = 64, HALF = 128, HTB = HALF * BK * 2, STAGE_BYTES = 8 * HTB, NXCD = 8, WGM = 8;
__host__ __device__ __forceinline__ int lds_byte(int r, int c) { const int st = (r >> 4) * 2 + (c >> 5), rr = r & 15, cc = c & 31, ob = rr * 64 + cc * 2; return st * 1024 + (ob ^ (((ob >> 9) & 1) << 5)); }
__host__ __device__ __forceinline__ void stage_rc(int b, int& R, int& C) { const int st = b / 1024, sb = b % 1024, swz = sb ^ (((sb >> 9) & 1) << 5); R = (st >> 1) * 16 + swz / 64; C = (st & 1) * 32 + (swz % 64) / 2; }
__host__ __device__ __forceinline__ int perm32(int rho) { const int n = rho >> 4, i = rho & 15; return 8 * (i >> 2) + 4 * n + (i & 3); }

struct Unit { int pm, pn; };
struct Gemm { const bf16_t* A; const bf16_t* Bt; int M, N, K, lda, ldb, a_pn_cols; const bf16_t* A2 = nullptr; const bf16_t* Bt2 = nullptr; };

struct StaticOrder {
    int nM, nN, nwg, G, c;
    __host__ __device__ void init(int M, int N, int G_, int c_) { nM = M / BM; nN = N / BM; nwg = nM * nN; G = G_; c = c_; }
    __host__ __device__ bool next(int i, Unit& u) const {
        const long L = (long)i * G + c; if (L >= nwg) return false;
        int wgid = (int)L; { const int q = nwg / NXCD, r = nwg % NXCD, xcd = wgid % NXCD, off = wgid / NXCD; wgid = (xcd < r ? xcd * (q + 1) : r * (q + 1) + (xcd - r) * q) + off; }
        const int nig = WGM * nN, gid = wgid / nig, fm = gid * WGM, gsz = (nM - fm) < WGM ? (nM - fm) : WGM;
        u.pm = fm + ((wgid % nig) % gsz); u.pn = (wgid % nig) / gsz; return true;
    }
    __device__ __forceinline__ void a_ready(const Unit&) const {}
    __device__ __forceinline__ void done(const Unit&) const {}
};

template <class Epi, class Sched, bool ALIGN_EPI = true, bool SP2 = true, bool DUAL = false>
__device__ __forceinline__ void gemm_phase(LAS unsigned char* lds, const Gemm g, const Sched& S, const Epi& E) {
    const int tid = threadIdx.x, wid = __builtin_amdgcn_readfirstlane(tid >> 6), lane = tid & 63, wr = wid >> 2, wc = wid & 3, fr = lane & 15, fq = lane >> 4;
    const int K = g.K, nt = K / BK;
    unsigned voffA[2], voffB[2];
#pragma unroll
    for (int i = 0; i < 2; ++i) { int R, C; stage_rc(tid * 16 + i * 8192, R, C); const int Rb = Epi::PERM ? ((R & ~31) + perm32(R & 31)) : R;
        voffA[i] = (unsigned)(R * g.lda + C) * 2u; voffB[i] = (unsigned)(Rb * g.ldb + C) * 2u; }
    const size_t kstep = (size_t)(BK * 2);
    const int nh = nt / 2;
    const long dA = DUAL ? ((const char*)g.A2 - (const char*)g.A) - (long)nh * (long)kstep : 0, dB = DUAL ? ((const char*)g.Bt2 - (const char*)g.Bt) - (long)nh * (long)kstep : 0;
    const size_t hstepA = (size_t)HALF * g.lda * 2, hstepB = (size_t)HALF * g.ldb * 2;
    const size_t tstepA = 2 * hstepA, tstepB = 2 * hstepB;
    const size_t pnstepA = (size_t)g.a_pn_cols * 2;
    const unsigned ldsw = (unsigned)wid * 1024u;
    const int aoff = lds_byte(wr * 64 + fr, fq * 8), boff = lds_byte(wc * 32 + fr, fq * 8);
#define PG8_SA(b, h) (((b) * 2 + (h)) * HTB)
#define PG8_SB(b, h) ((4 + (b) * 2 + (h)) * HTB)
#define PG8_STAGE(bufoff, gbase, voff) do { _Pragma("unroll") for (int _i = 0; _i < 2; ++_i) \
        __builtin_amdgcn_global_load_lds((const unsigned*)((const char*)(gbase) + (voff)[_i]), (LAS unsigned*)(lds + (bufoff) + ldsw + _i * 8192), 16, 0, 0); } while (0)
#define PG8_LDA(dst, b, h) do { _Pragma("unroll") for (int m = 0; m < 4; ++m) _Pragma("unroll") for (int k = 0; k < 2; ++k) dst[m][k] = *(const LAS bf16x8*)(lds + PG8_SA(b, h) + aoff + m * 2048 + k * 1024); } while (0)
#define PG8_LDB(dst, b, h) do { _Pragma("unroll") for (int n = 0; n < 2; ++n) _Pragma("unroll") for (int k = 0; k < 2; ++k) dst[n][k] = *(const LAS bf16x8*)(lds + PG8_SB(b, h) + boff + n * 2048 + k * 1024); } while (0)
#define PG8_MMA(ai, bj, At, Bt) do { __builtin_amdgcn_s_setprio(1); _Pragma("unroll") for (int m = 0; m < 4; ++m) _Pragma("unroll") for (int n = 0; n < 2; ++n) _Pragma("unroll") for (int k = 0; k < 2; ++k) \
        acc[ai][bj][m][n] = __builtin_amdgcn_mfma_f32_16x16x32_bf16(Bt[n][k], At[m][k], acc[ai][bj][m][n], 0, 0, 0); __builtin_amdgcn_s_setprio(0); } while (0)
#define PG8_WAIT_V(n) asm volatile("s_waitcnt vmcnt(" #n ")" ::: "memory")
#define PG8_WAIT_L(n) asm volatile("s_waitcnt lgkmcnt(" #n ")" ::: "memory")
#define PG8_BAR __builtin_amdgcn_s_barrier()
#define PG8_SCHED __builtin_amdgcn_sched_barrier(0)
#define PG8_UA(u_) ((const char*)g.A + (size_t)(u_).pm * tstepA + (size_t)(u_).pn * pnstepA)
#define PG8_UB(u_) ((const char*)g.Bt + (size_t)(u_).pn * tstepB)
    Unit cur, nxt; int ui = 0;
    if (!S.next(0, cur)) return;
    f32x4 acc[2][2][4][2];
#pragma unroll
    for (int a = 0; a < 2; ++a)
#pragma unroll
        for (int b = 0; b < 2; ++b)
#pragma unroll
            for (int m = 0; m < 4; ++m)
#pragma unroll
                for (int n = 0; n < 2; ++n) acc[a][b][m][n] = (f32x4){0.f, 0.f, 0.f, 0.f};
    bf16x8 At[4][2], B0[2][2], B1[2][2];
    const char* cA = PG8_UA(cur); const char* cB = PG8_UB(cur);
    S.a_ready(cur);
    if constexpr (SP2) {
        PG8_STAGE(PG8_SB(0, 0), cB, voffB); PG8_STAGE(PG8_SB(0, 1), cB + hstepB, voffB); PG8_STAGE(PG8_SA(0, 0), cA, voffA); PG8_STAGE(PG8_SA(0, 1), cA + hstepA, voffA);
        if (wr == 1) PG8_BAR;
        PG8_WAIT_V(2); PG8_BAR;
        PG8_STAGE(PG8_SB(1, 0), cB + kstep, voffB); PG8_STAGE(PG8_SA(1, 0), cA + kstep, voffA); PG8_STAGE(PG8_SB(1, 1), cB + hstepB + kstep, voffB);
        PG8_WAIT_V(6); PG8_BAR;
    } else {
        PG8_STAGE(PG8_SB(0, 0), cB, voffB); PG8_STAGE(PG8_SA(0, 0), cA, voffA); PG8_STAGE(PG8_SB(0, 1), cB + hstepB, voffB); PG8_STAGE(PG8_SA(0, 1), cA + hstepA, voffA);
        if (wr == 1) PG8_BAR;
        PG8_WAIT_V(4); PG8_BAR;
        PG8_STAGE(PG8_SB(1, 0), cB + kstep, voffB); PG8_STAGE(PG8_SA(1, 0), cA + kstep, voffA); PG8_STAGE(PG8_SB(1, 1), cB + hstepB + kstep, voffB);
        PG8_WAIT_V(6); PG8_BAR;
    }
    for (;;) {
        const bool has_next = S.next(ui + 1, nxt);
        const char* nA = has_next ? PG8_UA(nxt) : cA; const char* nB = has_next ? PG8_UB(nxt) : cB;
        for (int t = 0; t < nt; t += 2) {
            const bool last = (t == nt - 2);
            const char* a1 = cA + (size_t)(t + 1) * kstep;
            const char* a2 = last ? nA : cA + (size_t)(t + 2) * kstep; const char* b2 = last ? nB : cB + (size_t)(t + 2) * kstep;
            if constexpr (DUAL) {
                if (t >= nh) a1 += dA;
                if (!last && t + 2 >= nh) { a2 += dA; b2 += dB; }
                if (t == nh) E.mid(acc, cur, wr, wc, fr, fq);
            }
            const char* a3 = a2 + kstep; const char* b3 = b2 + kstep;
            if (last && has_next) S.a_ready(nxt);
            if constexpr (SP2) {
            PG8_LDB(B0, 0, 0); PG8_LDB(B1, 0, 1); PG8_SCHED; PG8_LDA(At, 0, 0); PG8_STAGE(PG8_SA(1, 1), a1 + hstepA, voffA);
            PG8_WAIT_V(8); PG8_WAIT_L(0); PG8_BAR; PG8_MMA(0, 0, At, B0); PG8_MMA(0, 1, At, B1); PG8_BAR; PG8_SCHED;
            PG8_LDA(At, 0, 1); PG8_STAGE(PG8_SB(0, 0), b2, voffB); PG8_STAGE(PG8_SB(0, 1), b2 + hstepB, voffB); PG8_STAGE(PG8_SA(0, 0), a2, voffA);
            PG8_WAIT_V(8); PG8_WAIT_L(0); PG8_BAR; PG8_MMA(1, 0, At, B0); PG8_MMA(1, 1, At, B1); PG8_BAR; PG8_SCHED;
            PG8_LDB(B0, 1, 0); PG8_LDB(B1, 1, 1); PG8_SCHED; PG8_LDA(At, 1, 0); PG8_STAGE(PG8_SA(0, 1), a2 + hstepA, voffA);
            PG8_WAIT_V(8); PG8_WAIT_L(0); PG8_BAR; PG8_MMA(0, 0, At, B0); PG8_MMA(0, 1, At, B1); PG8_BAR; PG8_SCHED;
            PG8_LDA(At, 1, 1); PG8_STAGE(PG8_SB(1, 0), b3, voffB); PG8_STAGE(PG8_SB(1, 1), b3 + hstepB, voffB); PG8_STAGE(PG8_SA(1, 0), a3, voffA);
            PG8_WAIT_V(8); PG8_WAIT_L(0); PG8_BAR; PG8_MMA(1, 0, At, B0); PG8_MMA(1, 1, At, B1); PG8_BAR; PG8_SCHED;
            } else {
            PG8_LDB(B0, 0, 0); PG8_SCHED; PG8_LDA(At, 0, 0); PG8_STAGE(PG8_SA(1, 1), a1 + hstepA, voffA);
            PG8_WAIT_L(8); PG8_BAR; PG8_WAIT_L(0); PG8_MMA(0, 0, At, B0); PG8_BAR; PG8_SCHED;
            PG8_LDB(B1, 0, 1); PG8_STAGE(PG8_SB(0, 0), b2, voffB);
            PG8_BAR; PG8_WAIT_L(0); PG8_MMA(0, 1, At, B1); PG8_BAR;
            PG8_LDA(At, 0, 1); PG8_STAGE(PG8_SA(0, 0), a2, voffA);
            PG8_BAR; PG8_WAIT_L(0); PG8_MMA(1, 0, At, B0); PG8_BAR; PG8_SCHED;
            PG8_STAGE(PG8_SB(0, 1), b2 + hstepB, voffB);
            PG8_WAIT_V(6); PG8_BAR; PG8_MMA(1, 1, At, B1); PG8_BAR;
            PG8_LDB(B0, 1, 0); PG8_SCHED; PG8_LDA(At, 1, 0); PG8_STAGE(PG8_SA(0, 1), a2 + hstepA, voffA);
            PG8_WAIT_L(8); PG8_BAR; PG8_WAIT_L(0); PG8_MMA(0, 0, At, B0); PG8_BAR; PG8_SCHED;
            PG8_LDB(B1, 1, 1); PG8_STAGE(PG8_SB(1, 0), b3, voffB);
            PG8_BAR; PG8_WAIT_L(0); PG8_MMA(0, 1, At, B1); PG8_BAR;
            PG8_LDA(At, 1, 1); PG8_STAGE(PG8_SA(1, 0), a3, voffA);
            PG8_BAR; PG8_WAIT_L(0); PG8_MMA(1, 0, At, B0); PG8_BAR; PG8_SCHED;
            PG8_STAGE(PG8_SB(1, 1), b3 + hstepB, voffB);
            PG8_WAIT_V(6); PG8_BAR; PG8_MMA(1, 1, At, B1); PG8_BAR;
            }
        }
        if constexpr (ALIGN_EPI) { if (wr == 0) PG8_BAR; }
        E(acc, cur, wr, wc, fr, fq); S.done(cur);
        if (!has_next) break;
#pragma unroll
        for (int a = 0; a < 2; ++a)
#pragma unroll
            for (int b = 0; b < 2; ++b)
#pragma unroll
                for (int m = 0; m < 4; ++m)
#pragma unroll
                    for (int n = 0; n < 2; ++n) acc[a][b][m][n] = (f32x4){0.f, 0.f, 0.f, 0.f};
        cur = nxt; cA = nA; cB = nB; ++ui;
        if constexpr (ALIGN_EPI) { if (wr == 1) PG8_BAR; }
    }
    PG8_WAIT_V(0);
    if constexpr (!ALIGN_EPI) { if (wr == 0) PG8_BAR; }
    PG8_BAR;
#undef PG8_UA
#undef PG8_UB
#undef PG8_SA
#undef PG8_SB
#undef PG8_STAGE
#undef PG8_LDA
#undef PG8_LDB
#undef PG8_MMA
#undef PG8_WAIT_V
#undef PG8_WAIT_L
#undef PG8_BAR
#undef PG8_SCHED
}
}
using pg8::Unit;

__device__ __forceinline__ int mod_row(int r) { return r < TP ? (r >> 11) : NB + ((r - TP) >> 2); }
__device__ __forceinline__ int pos_idx(int r) { return r < TP ? (r & 2047) : 2048 + ((r - TP) & 3); }

struct EpiF32Bias {
    static constexpr bool PERM = false;
    float* C; int ldc; const float* bias;
    __device__ __forceinline__ void operator()(const f32x4 (&acc)[2][2][4][2], const Unit& u, int wr, int wc, int fr, int fq) const {
        const int row0 = u.pm * 256 + wr * 64 + fr, col0 = u.pn * 256 + wc * 32 + 4 * fq;
#pragma unroll
        for (int ai = 0; ai < 2; ++ai)
#pragma unroll
            for (int m = 0; m < 4; ++m) { float* rowp = C + (size_t)(row0 + ai * 128 + m * 16) * ldc + col0;
#pragma unroll
                for (int bj = 0; bj < 2; ++bj)
#pragma unroll
                    for (int n = 0; n < 2; ++n) { const f32x4 bv = *(const f32x4*)(bias + col0 + bj * 128 + n * 16); *(f32x4*)(rowp + bj * 128 + n * 16) = acc[ai][bj][m][n] + bv; } }
    }
};

struct EpiBf16Plain {
    static constexpr bool PERM = true;
    bf16_t* O; int ldc;
    __device__ __forceinline__ void operator()(const f32x4 (&acc)[2][2][4][2], const Unit& u, int wr, int wc, int fr, int fq) const {
        const int row0 = u.pm * 256 + wr * 64 + fr, col0 = u.pn * 256 + wc * 32 + 8 * fq;
#pragma unroll
        for (int ai = 0; ai < 2; ++ai)
#pragma unroll
            for (int m = 0; m < 4; ++m) { bf16_t* rowp = O + (size_t)(row0 + ai * 128 + m * 16) * ldc + col0;
#pragma unroll
                for (int bj = 0; bj < 2; ++bj) { const f32x4 v0 = acc[ai][bj][m][0], v1 = acc[ai][bj][m][1];
                    u32x4 w; w.x = cvt_pk_bf16(v0[0], v0[1]); w.y = cvt_pk_bf16(v0[2], v0[3]); w.z = cvt_pk_bf16(v1[0], v1[1]); w.w = cvt_pk_bf16(v1[2], v1[3]);
                    *(u32x4*)(rowp + bj * 128) = w; } }
    }
};

struct EpiInProj {
    static constexpr bool PERM = true;
    bf16_t *U, *BG, *Q, *K, *V, *QI, *KI, *SGA, *SGB; float* WI; const float *qnw, *knw; const f32x2* rope; float* out;
    __device__ __forceinline__ void rope_rows(const f32x4 (&acc)[2][2][4][2], int ai, int m, int r, int fq, const float* nw, float (&o1)[8], float (&o2)[8]) const {
        float x1[8], x2[8];
#pragma unroll
        for (int n = 0; n < 2; ++n)
#pragma unroll
            for (int j = 0; j < 4; ++j) { x1[n * 4 + j] = acc[ai][0][m][n][j]; x2[n * 4 + j] = acc[ai][1][m][n][j]; }
        const int i0 = fq * 8;
        if (nw) {
            float ss = 0.f;
#pragma unroll
            for (int e = 0; e < 8; ++e) ss += x1[e] * x1[e] + x2[e] * x2[e];
            ss += __shfl_xor(ss, 16); ss += __shfl_xor(ss, 32);
            const float rstd = rsqrtf(ss * (1.0f / 64.0f) + NORM_EPS);
#pragma unroll
            for (int e = 0; e < 8; ++e) { x1[e] = x1[e] * rstd * nw[i0 + e]; x2[e] = x2[e] * rstd * nw[32 + i0 + e]; }
        }
        const f32x2* rp = rope + (size_t)pos_idx(r) * 32 + i0;
#pragma unroll
        for (int e = 0; e < 8; ++e) { const f32x2 cs = rp[e]; o1[e] = x1[e] * cs.x - x2[e] * cs.y; o2[e] = x2[e] * cs.x + x1[e] * cs.y; }
    }
    __device__ __forceinline__ void operator()(const f32x4 (&acc)[2][2][4][2], const Unit& u, int wr, int wc, int fr, int fq) const {
        const int pn = u.pn;
        const bool smp = u.pm >= 256;
#pragma unroll
        for (int ai = 0; ai < 2; ++ai)
#pragma unroll
            for (int m = 0; m < 4; ++m) {
                const int r = u.pm * 256 + ai * 128 + wr * 64 + m * 16 + fr;
                const int rs = r - TP;
                if (pn < 4) {
                    float uv[8];
#pragma unroll
                    for (int n = 0; n < 2; ++n)
#pragma unroll
                        for (int j = 0; j < 4; ++j) uv[n * 4 + j] = acc[ai][0][m][n][j] * acc[ai][1][m][n][j];
                    const int c0 = pn * 128 + wc * 32 + fq * 8;
                    *(u32x4*)(U + (size_t)r * 512 + c0) = pack8(uv);
                    float* cp = nullptr;
                    if (!smp) { const int t = r & 2047; if (t >= 2046) cp = out + OFF_CONVP + ((size_t)(r >> 11) * 2 + (t - 2046)) * 512 + c0; }
                    else { const int j4 = rs & 3; if (j4 >= 2) cp = out + OFF_CONVS + ((size_t)(rs >> 2) * 2 + (j4 - 2)) * 512 + c0; }
                    if (cp) { *(f32x4*)cp = (f32x4){uv[0], uv[1], uv[2], uv[3]}; *(f32x4*)(cp + 4) = (f32x4){uv[4], uv[5], uv[6], uv[7]}; }
                } else if (pn < 6) {
#pragma unroll
                    for (int bj = 0; bj < 2; ++bj) { float v[8];
#pragma unroll
                        for (int n = 0; n < 2; ++n)
#pragma unroll
                            for (int j = 0; j < 4; ++j) v[n * 4 + j] = acc[ai][bj][m][n][j];
                        *(u32x4*)(BG + (size_t)r * 512 + (pn - 4) * 256 + bj * 128 + wc * 32 + fq * 8) = pack8(v); }
                } else if (pn < 8) {
                    float o1[8], o2[8]; rope_rows(acc, ai, m, r, fq, qnw, o1, o2);
                    bf16_t* p = Q + (size_t)r * 512 + ((pn - 6) * 4 + wc) * 64 + fq * 8;
                    *(u32x4*)p = pack8(o1); *(u32x4*)(p + 32) = pack8(o2);
                } else if (pn == 8) {
                    float o1[8], o2[8];
                    const int hd = wc & 1;
                    if (wc < 2) rope_rows(acc, ai, m, r, fq, knw, o1, o2);
                    else {
#pragma unroll
                        for (int n = 0; n < 2; ++n)
#pragma unroll
                            for (int j = 0; j < 4; ++j) { o1[n * 4 + j] = acc[ai][0][m][n][j]; o2[n * 4 + j] = acc[ai][1][m][n][j]; }
                    }
                    bf16_t* p = (wc < 2 ? K : V) + (size_t)r * 128 + hd * 64 + fq * 8;
                    *(u32x4*)p = pack8(o1); *(u32x4*)(p + 32) = pack8(o2);
                    float* op = out + (smp ? (wc < 2 ? OFF_KS : OFF_VS) + (size_t)rs * 128 : (wc < 2 ? OFF_KP : OFF_VP) + (size_t)r * 128) + hd * 64 + fq * 8;
                    *(f32x4*)op = (f32x4){o1[0], o1[1], o1[2], o1[3]}; *(f32x4*)(op + 4) = (f32x4){o1[4], o1[5], o1[6], o1[7]};
                    *(f32x4*)(op + 32) = (f32x4){o2[0], o2[1], o2[2], o2[3]}; *(f32x4*)(op + 36) = (f32x4){o2[4], o2[5], o2[6], o2[7]};
                } else if (pn < 11) {
                    float o1[8], o2[8]; rope_rows(acc, ai, m, r, fq, nullptr, o1, o2);
                    bf16_t* p = QI + (size_t)r * 512 + ((pn - 9) * 4 + wc) * 64 + fq * 8;
                    *(u32x4*)p = pack8(o1); *(u32x4*)(p + 32) = pack8(o2);
                } else if (pn == 11) {
                    if (wc == 0) {
                        float o1[8], o2[8]; rope_rows(acc, ai, m, r, fq, nullptr, o1, o2);
                        bf16_t* p = KI + (size_t)r * 64 + fq * 8;
                        *(u32x4*)p = pack8(o1); *(u32x4*)(p + 32) = pack8(o2);
                        float* op = out + (smp ? OFF_KIS + (size_t)rs * 64 : OFF_KIP + (size_t)r * 64) + fq * 8;
                        *(f32x4*)op = (f32x4){o1[0], o1[1], o1[2], o1[3]}; *(f32x4*)(op + 4) = (f32x4){o1[4], o1[5], o1[6], o1[7]};
                        *(f32x4*)(op + 32) = (f32x4){o2[0], o2[1], o2[2], o2[3]}; *(f32x4*)(op + 36) = (f32x4){o2[4], o2[5], o2[6], o2[7]};
                    } else if (wc == 1 && fq == 0) {
                        float* wp = WI + (size_t)r * 8;
                        *(f32x4*)wp = acc[ai][0][m][0] * IDX_SCALE; *(f32x4*)(wp + 4) = acc[ai][0][m][1] * IDX_SCALE;
                    }
                } else {
                    bf16_t* base = pn < 16 ? SGA : SGB; const int pc = pn < 16 ? pn - 12 : pn - 16;
#pragma unroll
                    for (int bj = 0; bj < 2; ++bj) { float v[8];
#pragma unroll
                        for (int n = 0; n < 2; ++n)
#pragma unroll
                            for (int j = 0; j < 4; ++j) v[n * 4 + j] = sigmoidf_(acc[ai][bj][m][n][j]);
                        *(u32x4*)(base + (size_t)r * 1024 + pc * 256 + bj * 128 + wc * 32 + fq * 8) = pack8(v); }
                }
            }
    }
};
__host__ __device__ __forceinline__ int win_src_col(int j) {
    const int pn = j >> 8, tc = j & 255, bj = tc >> 7, wc = (tc >> 5) & 3, i = tc & 31;
    if (pn < 4) return (bj ? 1024 : 0) + pn * 128 + (tc & 127);
    if (pn < 6) return 512 + (pn - 4) * 256 + tc;
    if (pn < 8) return 1536 + ((pn - 6) * 4 + wc) * 64 + bj * 32 + i;
    if (pn == 8) return wc < 2 ? 2048 + wc * 64 + bj * 32 + i : 2176 + (wc - 2) * 64 + bj * 32 + i;
    if (pn < 11) return 2304 + ((pn - 9) * 4 + wc) * 64 + bj * 32 + i;
    if (pn == 11) { if (wc == 0) return 2816 + bj * 32 + i; if (wc == 1 && bj == 0 && i < 8) return 2880 + i; return -1; }
    if (pn < 16) return 2888 + (pn - 12) * 256 + tc;
    return 3912 + (pn - 16) * 256 + tc;
}

template <int MODE> struct EpiMix {
    static constexpr bool PERM = true;
    const bf16_t* SG; bf16_t* MIX;
    __device__ __forceinline__ void operator()(const f32x4 (&acc)[2][2][4][2], const Unit& u, int wr, int wc, int fr, int fq) const {
        const int row0 = u.pm * 256 + wr * 64 + fr, col0 = u.pn * 256 + wc * 32 + 8 * fq;
#pragma unroll
        for (int ai = 0; ai < 2; ++ai)
#pragma unroll
            for (int m = 0; m < 4; ++m) { const size_t ro = (size_t)(row0 + ai * 128 + m * 16) * 1024 + col0;
#pragma unroll
                for (int bj = 0; bj < 2; ++bj) {
                    float g[8], v[8]; unpack8(*(const u32x4*)(SG + ro + bj * 128), g);
#pragma unroll
                    for (int n = 0; n < 2; ++n)
#pragma unroll
                        for (int j = 0; j < 4; ++j) v[n * 4 + j] = g[n * 4 + j] * acc[ai][bj][m][n][j];
                    if (MODE == 1) { float pv[8]; unpack8(*(const u32x4*)(MIX + ro + bj * 128), pv);
#pragma unroll
                        for (int e = 0; e < 8; ++e) v[e] += pv[e]; }
                    *(u32x4*)(MIX + ro + bj * 128) = pack8(v); } }
    }
};

struct EpiMixFused {
    static constexpr bool PERM = true;
    const bf16_t* SGA; const bf16_t* SGB; bf16_t* MIX;
    __device__ __forceinline__ void mid(f32x4 (&acc)[2][2][4][2], const Unit& u, int wr, int wc, int fr, int fq) const {
        unsigned o0 = ((unsigned)(u.pm * 256 + wr * 64 + fr) * 1024u + (unsigned)(u.pn * 256 + wc * 32 + 8 * fq)) * 2u;
        asm volatile("" : "+v"(o0));
#pragma unroll
        for (int ai = 0; ai < 2; ++ai)
#pragma unroll
            for (int m = 0; m < 4; ++m) { const unsigned ro = o0 + (unsigned)(ai * 128 + m * 16) * 2048u;
#pragma unroll
                for (int bj = 0; bj < 2; ++bj) {
                    float ga[8], gb[8]; unpack8(*(const u32x4*)((const char*)SGA + ro + bj * 256), ga); unpack8(*(const u32x4*)((const char*)SGB + ro + bj * 256), gb);
#pragma unroll
                    for (int n = 0; n < 2; ++n)
#pragma unroll
                        for (int j = 0; j < 4; ++j) acc[ai][bj][m][n][j] *= ga[n * 4 + j] * __builtin_amdgcn_rcpf(fmaxf(gb[n * 4 + j], 1e-20f)); }
                if (m & 1) __builtin_amdgcn_sched_barrier(0); }
    }
    __device__ __forceinline__ void operator()(const f32x4 (&acc)[2][2][4][2], const Unit& u, int wr, int wc, int fr, int fq) const {
        unsigned o0 = ((unsigned)(u.pm * 256 + wr * 64 + fr) * 1024u + (unsigned)(u.pn * 256 + wc * 32 + 8 * fq)) * 2u;
        asm volatile("" : "+v"(o0));
#pragma unroll
        for (int ai = 0; ai < 2; ++ai)
#pragma unroll
            for (int m = 0; m < 4; ++m) { const unsigned ro = o0 + (unsigned)(ai * 128 + m * 16) * 2048u;
#pragma unroll
                for (int bj = 0; bj < 2; ++bj) {
                    float gb[8], v[8]; unpack8(*(const u32x4*)((const char*)SGB + ro + bj * 256), gb);
#pragma unroll
                    for (int n = 0; n < 2; ++n)
#pragma unroll
                        for (int j = 0; j < 4; ++j) v[n * 4 + j] = fmaxf(gb[n * 4 + j], 1e-20f) * acc[ai][bj][m][n][j];
                    *(u32x4*)((char*)MIX + ro + bj * 256) = pack8(v); } }
    }
};

struct EpiOut {
    static constexpr bool PERM = true;
    const float* MOD; bf16_t* Dm;
    __device__ __forceinline__ void operator()(const f32x4 (&acc)[2][2][4][2], const Unit& u, int wr, int wc, int fr, int fq) const {
        const int col0 = u.pn * 256 + wc * 32 + 8 * fq;
#pragma unroll
        for (int ai = 0; ai < 2; ++ai)
#pragma unroll
            for (int m = 0; m < 4; ++m) {
                const int r = u.pm * 256 + ai * 128 + wr * 64 + m * 16 + fr;
                const float* gr = MOD + (size_t)mod_row(r) * NMOD + 2048;
#pragma unroll
                for (int bj = 0; bj < 2; ++bj) { const int c = col0 + bj * 128;
                    const f32x4 g0 = *(const f32x4*)(gr + c), g1 = *(const f32x4*)(gr + c + 4); float v[8];
#pragma unroll
                    for (int j = 0; j < 4; ++j) { v[j] = g0[j] * acc[ai][bj][m][0][j]; v[4 + j] = g1[j] * acc[ai][bj][m][1][j]; }
                    *(u32x4*)(Dm + (size_t)r * 1024 + c) = pack8(v); } }
    }
};

typedef _Float16 h2_t __attribute__((ext_vector_type(2)));
__device__ __forceinline__ unsigned cvt_pk_f16(float lo, float hi) { const h2_t v = __builtin_convertvector((f32x2){lo, hi}, h2_t); return __builtin_bit_cast(unsigned, v); }
struct EpiPST {
    static constexpr bool PERM = true;
    unsigned short* PST;
    __device__ __forceinline__ void operator()(const f32x4 (&acc)[2][2][4][2], const Unit& u, int wr, int wc, int fr, int fq) const {
        unsigned short* base = PST + (size_t)(u.pm * 8 + u.pn) * 65536 + wc * 32 + 8 * fq;
#pragma unroll
        for (int ai = 0; ai < 2; ++ai)
#pragma unroll
            for (int m = 0; m < 4; ++m) { const int rl = ai * 128 + wr * 64 + m * 16 + fr;
#pragma unroll
                for (int bj = 0; bj < 2; ++bj) { const f32x4 v0 = acc[ai][bj][m][0], v1 = acc[ai][bj][m][1];
                    u32x4 w; w.x = cvt_pk_f16(v0[0], v0[1]); w.y = cvt_pk_f16(v0[2], v0[3]); w.z = cvt_pk_f16(v1[0], v1[1]); w.w = cvt_pk_f16(v1[2], v1[3]);
                    *(u32x4*)(base + (size_t)rl * 256 + bj * 128) = w; } }
    }
};

struct Params { const float* in[24]; float* out; unsigned char* ws; int ph_lo, ph_hi, rep_mask, pad; };
struct Frame {
    LAS unsigned char* lds; int tid, lane, wave, bid, nblk; unsigned* ctl; unsigned char* ws; float* out;
    const float *x_prompt, *x_sample, *cache_k, *cache_v, *cache_kidx, *state_conv; const int* page_table; const float *c_prompt, *c_sample, *w_ada, *b_ada, *norm1_w, *w_in, *conv_w, *q_norm_w, *k_norm_w,
        *w_conv_out, *w_attn_out, *w_out, *norm2_w, *peer_w_q, *peer_sub_keys, *peer_u, *peer_v;
};
#define WSP(type, off) ((type*)(F.ws + (off)))

template <bool DUAL, class Fin, int KQ = 256>
__device__ __forceinline__ void skinny_phase(const Frame& F, const bf16_t* A1, const bf16_t* B1, const bf16_t* A2, const bf16_t* B2, int lda, int ldb, int N, int row_base, int nrt, Fin fin, int a_pn_cols = 0) {
    LAS float* P = (LAS float*)F.lds;
    const int lane = F.lane, q = lane & 31, half = lane >> 5, w = F.wave, rb = w & 1, kq = w >> 1;
    const bf16_t* Asel = (DUAL && kq >= 2) ? A2 : A1; const bf16_t* Bsel = (DUAL && kq >= 2) ? B2 : B1;
    const int k0 = (DUAL ? (kq & 1) : kq) * KQ + half * 8;
    const int ntile = nrt * (N / 32);
    for (int tl = F.bid; tl < ntile; tl += F.nblk) {
        const int rt = tl % nrt, ct = tl / nrt;
        const bf16_t* ap = Asel + (size_t)(row_base + rt * 64 + rb * 32 + q) * lda + k0 + (ct >> 3) * a_pn_cols;
        const bf16_t* bp = Bsel + (size_t)(ct * 32 + q) * ldb + k0;
        f32x16 acc;
#pragma unroll
        for (int i = 0; i < 16; ++i) acc[i] = 0.f;
        constexpr int NS = KQ / 16 < 8 ? KQ / 16 : 8;
#pragma unroll 1
        for (int kb = 0; kb < KQ / 16 / NS; ++kb) {
            u32x4 a[NS], b[NS];
#pragma unroll
            for (int i = 0; i < NS; ++i) { a[i] = *(const u32x4*)(ap + (kb * NS + i) * 16); b[i] = *(const u32x4*)(bp + (kb * NS + i) * 16); }
#pragma unroll
            for (int i = 0; i < NS; ++i) acc = __builtin_amdgcn_mfma_f32_32x32x16_bf16(__builtin_bit_cast(bf16x8, a[i]), __builtin_bit_cast(bf16x8, b[i]), acc, 0, 0, 0);
        }
        __syncthreads();
#pragma unroll
        for (int i = 0; i < 16; ++i) P[(kq * 64 + rb * 32 + 8 * (i >> 2) + 4 * half + (i & 3)) * 33 + q] = acc[i];
        __syncthreads();
        const int r = F.tid >> 3, c4 = (F.tid & 7) * 4;
        float s01[4], s23[4];
#pragma unroll
        for (int j = 0; j < 4; ++j) { s01[j] = P[(0 * 64 + r) * 33 + c4 + j] + P[(1 * 64 + r) * 33 + c4 + j]; s23[j] = P[(2 * 64 + r) * 33 + c4 + j] + P[(3 * 64 + r) * 33 + c4 + j]; }
        fin(row_base + rt * 64 + r, ct * 32 + c4, s01, s23);
    }
    __syncthreads();
}

template <class Map> __device__ __forceinline__ void transpose_cvt(const Frame& F, const float* src, int ld_src, bf16_t* dst, int K, int Nd, Map map) {
    LAS float* tile = (LAS float*)F.lds;
    const int ntk = K / 64, ntn = Nd / 64, ntile = ntk * ntn;
    float v[8];
#define TC_LOAD(tix_) do { const int tn_ = (tix_) / ntk, tk_ = (tix_) % ntk; _Pragma("unroll") for (int i_ = 0; i_ < 8; ++i_) { const int e_ = F.tid + 512 * i_, kk_ = e_ >> 6, nn_ = e_ & 63; \
        const int sc_ = map(tn_ * 64 + nn_); v[i_] = sc_ >= 0 ? src[(size_t)(tk_ * 64 + kk_) * ld_src + sc_] : 0.f; } } while (0)
    int tix = F.bid;
    if (tix < ntile) TC_LOAD(tix);
    for (; tix < ntile; tix += F.nblk) {
        const int tn = tix / ntk, tk = tix % ntk;
#pragma unroll
        for (int i = 0; i < 8; ++i) { const int e = F.tid + 512 * i, kk = e >> 6, nn = e & 63; tile[kk * 65 + nn] = v[i]; }
        __syncthreads();
        if (tix + F.nblk < ntile) TC_LOAD(tix + F.nblk);
#pragma unroll
        for (int i = 0; i < 4; ++i) { const int e = F.tid + 512 * i, nn = e >> 5, kp = e & 31;
            *(unsigned*)(dst + (size_t)(tn * 64 + nn) * K + tk * 64 + 2 * kp) = cvt_pk_bf16(tile[(2 * kp) * 65 + nn], tile[(2 * kp + 1) * 65 + nn]); }
        __syncthreads();
    }
#undef TC_LOAD
}
struct MapId { __device__ __forceinline__ int operator()(int n) const { return n; } };
struct MapWin { __device__ __forceinline__ int operator()(int n) const { return win_src_col(n); } };

__device__ __forceinline__ void p0_convert(const Frame& F) {
    transpose_cvt(F, F.w_in, NPROJ, WSP(bf16_t, WS_WIN), 1024, NPROJ_PAD, MapWin());
    transpose_cvt(F, F.w_conv_out, 1024, WSP(bf16_t, WS_WCO), 512, 1024, MapId());
    transpose_cvt(F, F.w_attn_out, 1024, WSP(bf16_t, WS_WAO), 512, 1024, MapId());
    transpose_cvt(F, F.w_out, 1024, WSP(bf16_t, WS_WOUT), 1024, 1024, MapId());
    transpose_cvt(F, F.peer_w_q, 2048, WSP(bf16_t, WS_WQ), 1024, 2048, MapId());
    transpose_cvt(F, F.w_ada, NMOD, WSP(bf16_t, WS_WADA), 1024, NMOD, MapId());
    const size_t gt = (size_t)F.bid * 512 + F.tid, gn = (size_t)F.nblk * 512;
    { unsigned char* d8 = WSP(unsigned char, WS_UT); float* tsc = WSP(float, WS_TSC);
      for (int row = F.bid * 8 + F.wave; row < 2 * 16384; row += F.nblk * 8) {
          const float* s = (row < 16384 ? F.peer_u : F.peer_v) + (size_t)(row & 16383) * 1024 + F.lane * 16;
          f32x4 v[4]; float am = 0.f;
#pragma unroll
          for (int i = 0; i < 4; ++i) { v[i] = *(const f32x4*)(s + 4 * i); am = fmaxf(am, fmaxf(fmaxf(fabsf(v[i][0]), fabsf(v[i][1])), fmaxf(fabsf(v[i][2]), fabsf(v[i][3])))); }
          am = wave_max(am);
          const float sc = am > 0.f ? 240.0f / am : 1.0f;
          u32x4 w; unsigned ww[4];
#pragma unroll
          for (int i = 0; i < 4; ++i) { int pk = 0; pk = __builtin_amdgcn_cvt_pk_fp8_f32(v[i][0] * sc, v[i][1] * sc, pk, false); pk = __builtin_amdgcn_cvt_pk_fp8_f32(v[i][2] * sc, v[i][3] * sc, pk, true); ww[i] = (unsigned)pk; }
          w.x = ww[0]; w.y = ww[1]; w.z = ww[2]; w.w = ww[3];
          *(u32x4*)(d8 + (size_t)row * 1024 + F.lane * 16) = w;
          if (F.lane == 0) tsc[row] = am > 0.f ? am / 240.0f : 1.0f;
      } }
    { bf16_t* d = WSP(bf16_t, WS_SKBD);
      for (size_t i = gt; i < (size_t)2048 * 256 / 2; i += gn) { const int row = (int)(i >> 7), cp = (int)(i & 127) * 2; const int h = row >> 8, rr = row & 255, p = rr >> 7, key = rr & 127;
          float a = 0.f, b = 0.f; if ((cp >> 7) == p) { const float* s = F.peer_sub_keys + (((size_t)p * 8 + h) * 128 + key) * 128 + (cp & 127); a = s[0]; b = s[1]; }
          *(unsigned*)(d + (size_t)row * 256 + cp) = cvt_pk_bf16(a, b); } }
    { bf16_t* d = WSP(bf16_t, WS_CB);
      for (size_t i = gt; i < (size_t)256 * 1024 / 2; i += gn) { const int row = (int)(i >> 9), cp = (int)(i & 511) * 2; float a = 0.f, b = 0.f;
          if (row < NB) { a = F.c_prompt[row * 1024 + cp]; b = F.c_prompt[row * 1024 + cp + 1]; } else if (row < NB + DB) { a = F.c_sample[(row - NB) * 1024 + cp]; b = F.c_sample[(row - NB) * 1024 + cp + 1]; }
          *(unsigned*)(d + (size_t)row * 1024 + cp) = cvt_pk_bf16(a, b); } }
    { f32x2* d = WSP(f32x2, WS_ROPE);
      for (size_t i = gt; i < (size_t)2052 * 32; i += gn) { const int pi = (int)(i >> 5), fi = (int)(i & 31); const int pos = pi < 2048 ? pi : PAST + (pi - 2048);
          const float fr = powf(10000.0f, -(float)fi / 32.0f); const float ang = (float)pos * fr;
          d[i] = (f32x2){(float)cos((double)ang), (float)sin((double)ang)}; } }
}

template <bool SECOND> __device__ __forceinline__ void row_norm_pass(const Frame& F) {
    const float* MOD = WSP(float, WS_MOD); bf16_t* H = WSP(bf16_t, WS_H);
    const float* nw = SECOND ? F.norm2_w : F.norm1_w;
    const int so = SECOND ? 3 * 1024 : 0;
    for (int r = F.bid * 8 + F.wave; r < T; r += F.nblk * 8) {
        const float* xr = r < TP ? F.x_prompt + (size_t)r * 1024 : F.x_sample + (size_t)(r - TP) * 1024;
        f32x4 v[4]; float ss = 0.f;
#pragma unroll
        for (int i = 0; i < 4; ++i) { v[i] = *(const f32x4*)(xr + i * 256 + F.lane * 4);
            if (SECOND) { const u32x2 dv = *(const u32x2*)(WSP(bf16_t, WS_X1) + (size_t)r * 1024 + i * 256 + F.lane * 4); v[i] += (f32x4){bf_lo(dv.x), bf_hi(dv.x), bf_lo(dv.y), bf_hi(dv.y)}; }
            ss += v[i][0] * v[i][0] + v[i][1] * v[i][1] + v[i][2] * v[i][2] + v[i][3] * v[i][3]; }
        ss = wave_sum(ss);
        const float rstd = rsqrtf(ss * (1.0f / 1024.0f) + NORM_EPS);
        const float* mr = MOD + (size_t)mod_row(r) * NMOD + so;
#pragma unroll
        for (int i = 0; i < 4; ++i) { const int c = i * 256 + F.lane * 4;
            const f32x4 w = *(const f32x4*)(nw + c), sh = *(const f32x4*)(mr + c), sc = *(const f32x4*)(mr + 1024 + c);
            const f32x4 y = v[i] * rstd * w * (sc + 1.0f) + sh;
            u32x2 o; o.x = cvt_pk_bf16(y[0], y[1]); o.y = cvt_pk_bf16(y[2], y[3]);
            *(u32x2*)(H + (size_t)r * 1024 + c) = o; }
    }
}

__device__ __forceinline__ void p4_vtranspose(const Frame& F) {
    const bf16_t* V = WSP(bf16_t, WS_V); bf16_t* VTR = WSP(bf16_t, WS_VTR);
    LAS bf16_t* tile = (LAS bf16_t*)F.lds;
    for (int tix = F.bid; tix < NB * 2 * 32; tix += F.nblk) {
        const int b = tix >> 6, kvh = (tix >> 5) & 1, tt = tix & 31;
        { const int trow = F.tid >> 3, dc = F.tid & 7;
          const u32x4 w = *(const u32x4*)(V + ((size_t)(b * 2048 + tt * 64 + trow)) * 128 + kvh * 64 + dc * 8);
          const unsigned ww[4] = {w.x, w.y, w.z, w.w};
#pragma unroll
          for (int e = 0; e < 8; ++e) tile[(dc * 8 + e) * 72 + trow] = (bf16_t)((ww[e >> 1] >> ((e & 1) * 16)) & 0xffffu); }
        __syncthreads();
        { const int d = F.tid >> 3, tc = F.tid & 7;
          const u32x4 w = *(const LAS u32x4*)(tile + d * 72 + tc * 8);
          *(u32x4*)(VTR + ((size_t)((b * 2 + kvh) * 64 + d)) * 2048 + tt * 64 + tc * 8) = w; }
        __syncthreads();
    }
}
__device__ __forceinline__ void p4_conv(const Frame& F) {
    const bf16_t* U = WSP(bf16_t, WS_U); const bf16_t* BG = WSP(bf16_t, WS_BG); bf16_t* APRE = WSP(bf16_t, WS_APRE);
    const size_t gt = (size_t)F.bid * 512 + F.tid, gn = (size_t)F.nblk * 512;
    for (size_t i = gt; i < (size_t)T * 64; i += gn) {
        const int r = (int)(i >> 6), c0 = (int)(i & 63) * 8;
        float u0[8], u1[8], u2[8], bg[8], w0[8], w1[8], w2[8];
        unpack8(*(const u32x4*)(U + (size_t)r * 512 + c0), u2);
        unpack8(*(const u32x4*)(BG + (size_t)r * 512 + c0), bg);
#pragma unroll
        for (int e = 0; e < 8; ++e) { w0[e] = F.conv_w[c0 + e]; w1[e] = F.conv_w[512 + c0 + e]; w2[e] = F.conv_w[1024 + c0 + e]; u1[e] = 0.f; u0[e] = 0.f; }
        if (r < TP) { const int t = r & 2047;
            if (t >= 1) unpack8(*(const u32x4*)(U + (size_t)(r - 1) * 512 + c0), u1);
            if (t >= 2) unpack8(*(const u32x4*)(U + (size_t)(r - 2) * 512 + c0), u0);
        } else { const int rs = r - TP, b = rs >> 2, j = rs & 3;
            const float* st = F.state_conv + (size_t)b * 1024 + c0;
            if (j >= 1) unpack8(*(const u32x4*)(U + (size_t)(r - 1) * 512 + c0), u1);
            else {
#pragma unroll
                for (int e = 0; e < 8; ++e) u1[e] = st[512 + e]; }
            if (j >= 2) unpack8(*(const u32x4*)(U + (size_t)(r - 2) * 512 + c0), u0);
            else {
#pragma unroll
                for (int e = 0; e < 8; ++e) u0[e] = st[(j == 1 ? 512 : 0) + e]; }
        }
        float o[8];
#pragma unroll
        for (int e = 0; e < 8; ++e) o[e] = bg[e] * (w2[e] * u2[e] + w1[e] * u1[e] + w0[e] * u0[e]);
        *(u32x4*)(APRE + (size_t)r * 512 + c0) = pack8(o);
    }
}

constexpr int QL_STRIDE = 1040;
template <bool WLDS> __device__ __forceinline__ f32x16 idx_tile_t(const bf16x8 (&kf)[4], const LAS unsigned char* qb_, const float (&w8)[8], const LAS float* wl) {
    unsigned qo = (unsigned)(size_t)qb_; asm volatile("" : "+v"(qo));
    const LAS unsigned char* qb = (const LAS unsigned char*)(size_t)qo;
    f32x16 sc;
#pragma unroll
    for (int i = 0; i < 16; ++i) sc[i] = 0.f;
#pragma unroll
    for (int h = 0; h < 8; ++h) {
        f32x16 a;
#pragma unroll
        for (int i = 0; i < 16; ++i) a[i] = 0.f;
#pragma unroll
        for (int s = 0; s < 4; ++s) { const bf16x8 qf = *(const LAS bf16x8*)(qb + h * 128 + s * 32); a = __builtin_amdgcn_mfma_f32_32x32x16_bf16(kf[s], qf, a, 0, 0, 0); }
        const float wh = WLDS ? wl[h] : w8[h];
#pragma unroll
        for (int i = 0; i < 16; ++i) sc[i] += wh * fmaxf(a[i], 0.f);
    }
    return sc;
}
__device__ __forceinline__ f32x16 idx_tile(const bf16x8 (&kf)[4], const LAS unsigned char* qb_, const float (&w8)[8]) { return idx_tile_t<false>(kf, qb_, w8, nullptr); }

__device__ __forceinline__ int wave_sum_i_dpp(int x) {
    x += __builtin_amdgcn_update_dpp(0, x, 0xB1, 0xF, 0xF, true);
    x += __builtin_amdgcn_update_dpp(0, x, 0x4E, 0xF, 0xF, true);
    x += __builtin_amdgcn_update_dpp(0, x, 0x141, 0xF, 0xF, true);
    x += __builtin_amdgcn_update_dpp(0, x, 0x140, 0xF, 0xF, true);
    x += __builtin_amdgcn_update_dpp(0, x, 0x142, 0xA, 0xF, false);
    x += __builtin_amdgcn_update_dpp(0, x, 0x143, 0xC, 0xF, false);
    return __builtin_amdgcn_readlane(x, 63);
}
template <int NREG> __device__ __forceinline__ void select_rows8(const float* sc0, int n0, u64* mask0, int lane) {
    float cur[NREG], nxt[NREG];
#pragma unroll
    for (int j = 0; j < NREG; ++j) { cur[j] = sc0[64 * j + lane]; nxt[j] = 0.f; }
#pragma unroll 1
    for (int rr = 0; rr < 8; ++rr) {
        if (rr < 7) {
#pragma unroll
            for (int j = 0; j < NREG; ++j) nxt[j] = sc0[(size_t)(rr + 1) * 2048 + 64 * j + lane]; }
        const int n = n0 + rr;
        unsigned key[NREG];
#pragma unroll
        for (int j = 0; j < NREG; ++j) { const int idx = 64 * j + lane; const unsigned k = mono(cur[j]); key[j] = idx < n ? k : 0u; }
        unsigned thr = 0u, cut = 0u; bool exact = false;
#pragma unroll 1
        for (int bit = 31; bit >= 0; --bit) {
            const unsigned cand = thr | (1u << bit); int c = 0;
#pragma unroll
            for (int j = 0; j < NREG; ++j) c += (key[j] >= cand) ? 1 : 0;
            c = wave_sum_i_dpp(c);
            if (c == 256) { cut = cand; exact = true; break; }
            if (c > 256) thr = cand;
        }
        u64 myword = 0ull;
        if (exact) {
#pragma unroll
            for (int j = 0; j < NREG; ++j) { const u64 word = __ballot(key[j] >= cut); if (lane == j) myword = word; }
        } else {
            int cgt = 0;
#pragma unroll
            for (int j = 0; j < NREG; ++j) cgt += (key[j] > thr) ? 1 : 0;
            int need = 256 - wave_sum_i_dpp(cgt);
#pragma unroll
            for (int j = 0; j < NREG; ++j) {
                const u64 eq = __ballot(key[j] == thr);
                const int rank = mbcnt64(eq);
                const u64 word = __ballot(key[j] > thr || (key[j] == thr && rank < need));
                const int pe = __popcll(eq); need = need > pe ? need - pe : 0;
                if (lane == j) myword = word;
            }
        }
        if (lane < 32) mask0[(size_t)rr * 32 + lane] = myword;
#pragma unroll
        for (int j = 0; j < NREG; ++j) cur[j] = nxt[j];
    }
}
__device__ __forceinline__ void select_rows8_prompt(const float* sc0, int t0, u64* mask0, int lane) {
    t0 = __builtin_amdgcn_readfirstlane(t0);
    const int nmax = t0 + 8;
    if (nmax <= 256) {
#pragma unroll 1
        for (int rr = 0; rr < 8; ++rr) { const int n = t0 + rr + 1;
            if (lane < 32) { const int lo = 64 * lane; const u64 word = (n >= lo + 64) ? ~0ull : (n > lo ? ((1ull << (n - lo)) - 1ull) : 0ull); mask0[(size_t)rr * 32 + lane] = word; } }
    } else if (nmax <= 512) select_rows8<8>(sc0, t0 + 1, mask0, lane);
    else if (nmax <= 1024) select_rows8<16>(sc0, t0 + 1, mask0, lane);
    else if (nmax <= 1536) select_rows8<24>(sc0, t0 + 1, mask0, lane);
    else select_rows8<32>(sc0, t0 + 1, mask0, lane);
}

__device__ __forceinline__ void p4_prompt_unit(const Frame& F, int b, int qt, int parts, LAS int* qslot, unsigned* qhead) {
    const bf16_t* QI = WSP(bf16_t, WS_QI); const bf16_t* KI = WSP(bf16_t, WS_KI); const float* WI = WSP(float, WS_WI); float* SC = WSP(float, WS_SCR); u64* MASK = WSP(u64, WS_MASK);
    const int w = F.wave, lane = F.lane, q = lane & 31, half = lane >> 5;
    if (!(parts & 32)) {
    {
#pragma unroll
        for (int i = 0; i < 8; ++i) { const int e = F.tid + 512 * i, rw = e >> 6, ch = e & 63;
            *(LAS u32x4*)(F.lds + rw * QL_STRIDE + ch * 16) = *(const u32x4*)(QI + ((size_t)b * 2048 + qt * 64 + rw) * 512 + ch * 8); }
    }
    __syncthreads();
    {
        const int qh = w & 1, stripe = w >> 1, t0 = qt * 64 + qh * 32;
        const size_t rowq = (size_t)b * 2048 + t0 + q;
        const LAS unsigned char* qb = F.lds + (qh * 32 + q) * QL_STRIDE + half * 16;
        float w8[8];
        { const f32x4 a = *(const f32x4*)(WI + rowq * 8), c = *(const f32x4*)(WI + rowq * 8 + 4); w8[0] = a[0]; w8[1] = a[1]; w8[2] = a[2]; w8[3] = a[3]; w8[4] = c[0]; w8[5] = c[1]; w8[6] = c[2]; w8[7] = c[3]; }
        const int nkt = t0 / 32 + 1;
        if (stripe < nkt) {
            bf16x8 ka[4], kb[4];
#define P4_LOADK(dst, kt_) do { const int k_ = (kt_) < nkt ? (kt_) : stripe; const size_t rowk_ = (size_t)b * 2048 + k_ * 32 + q; \
        _Pragma("unroll") for (int s_ = 0; s_ < 4; ++s_) dst[s_] = *(const bf16x8*)(KI + rowk_ * 64 + s_ * 16 + half * 8); } while (0)
#define P4_STORE(scv, kt_) do { float* dst_ = SC + rowq * 2048 + (kt_) * 32 + 4 * half; \
        _Pragma("unroll") for (int g_ = 0; g_ < 4; ++g_) *(f32x4*)(dst_ + 8 * g_) = (f32x4){scv[4 * g_], scv[4 * g_ + 1], scv[4 * g_ + 2], scv[4 * g_ + 3]}; } while (0)
            P4_LOADK(ka, stripe);
#pragma unroll 1
            for (int kt = stripe; kt < nkt; kt += 4) {
                P4_LOADK(kb, kt + 4); __builtin_amdgcn_sched_barrier(0);
                const f32x16 sc = idx_tile(ka, qb, w8);
#pragma unroll
                for (int s = 0; s < 4; ++s) ka[s] = kb[s];
                __builtin_amdgcn_sched_barrier(0);
                P4_STORE(sc, kt);
            }
#undef P4_LOADK
#undef P4_STORE
        }
    }
    }
    __syncthreads();
    int unext = 0;
    if (F.tid == 0) unext = (int)__hip_atomic_fetch_add(qhead, 1u, __ATOMIC_RELAXED, __HIP_MEMORY_SCOPE_AGENT);
    if (!(parts & 16)) { const int t0 = qt * 64 + w * 8; const size_t row = (size_t)b * 2048 + t0; select_rows8_prompt(SC + row * 2048, t0, MASK + row * 32, lane); }
    if (F.tid == 0) *qslot = unext;
    __syncthreads();
}

__device__ __forceinline__ void p4_sample_unit(const Frame& F, int b) {
    const bf16_t* QI = WSP(bf16_t, WS_QI); const bf16_t* KI = WSP(bf16_t, WS_KI); const float* WI = WSP(float, WS_WI);
    const bf16_t* Q = WSP(bf16_t, WS_Q); const bf16_t* K = WSP(bf16_t, WS_K); const bf16_t* V = WSP(bf16_t, WS_V); bf16_t* ATT = WSP(bf16_t, WS_ATT);
    constexpr int SLW = 8224;
    constexpr int NEWKEY = 0x40000000;
    LAS unsigned* SL = (LAS unsigned*)F.lds;
    LAS int* SELR = (LAS int*)(F.lds + 4 * SLW * 4);
    LAS unsigned char* QL = F.lds + 4 * SLW * 4 + 4096;
    LAS int* CNT = (LAS int*)(F.lds + 4 * SLW * 4 + 4096 + 4 * QL_STRIDE);
    const int w = F.wave, lane = F.lane, q = lane & 31, half = lane >> 5, tid = F.tid;
    const int* pt = F.page_table + b * NPG;
    const size_t r0 = (size_t)TP + b * 4;
    if (tid < 256) { const int rw = tid >> 6, ch = tid & 63; *(LAS u32x4*)(QL + rw * QL_STRIDE + ch * 16) = *(const u32x4*)(QI + (r0 + rw) * 512 + ch * 8); }
    if (tid < 32) ((LAS float*)(QL + 4 * QL_STRIDE + 256))[tid] = WI[r0 * 8 + tid];
    LAS int* PTL = (LAS int*)(QL + 4 * QL_STRIDE + 512);
    if (tid >= 64 && tid < 128) PTL[tid - 64] = pt[tid - 64];
    __syncthreads();
    {
        const size_t rowq = r0 + (q & 3);
        const LAS unsigned char* qb = QL + (q & 3) * QL_STRIDE + half * 16;
        const LAS float* wl = (const LAS float*)(QL + 4 * QL_STRIDE + 256) + (q & 3) * 8;
        const float w8[8] = {0.f, 0.f, 0.f, 0.f, 0.f, 0.f, 0.f, 0.f};
        (void)rowq;
        f32x4 ta[8], tb[8];
#define SMP_LOAD(dst, kt_) do { const int k_ = (kt_) < 256 ? (kt_) : 255; const float* kr_ = F.cache_kidx + ((size_t)PTL[k_ >> 2] * PAGE + ((k_ & 3) * 32 + q)) * 64 + half * 8; \
        _Pragma("unroll") for (int s_ = 0; s_ < 4; ++s_) { dst[2 * s_] = *(const f32x4*)(kr_ + s_ * 16); dst[2 * s_ + 1] = *(const f32x4*)(kr_ + s_ * 16 + 4); } } while (0)
#define SMP_TILE(srcb, kt_) do { if ((kt_) < 256) { bf16x8 kf_[4]; \
        _Pragma("unroll") for (int s_ = 0; s_ < 4; ++s_) { const f32x4 a_ = srcb[2 * s_], c_ = srcb[2 * s_ + 1]; \
            u32x4 wv_; wv_.x = cvt_pk_bf16(a_[0], a_[1]); wv_.y = cvt_pk_bf16(a_[2], a_[3]); wv_.z = cvt_pk_bf16(c_[0], c_[1]); wv_.w = cvt_pk_bf16(c_[2], c_[3]); kf_[s_] = __builtin_bit_cast(bf16x8, wv_); } \
        const f32x16 sc_ = idx_tile_t<true>(kf_, qb, w8, wl); \
        if (q < 4) { _Pragma("unroll") for (int i_ = 0; i_ < 16; ++i_) SL[q * SLW + (kt_) * 32 + 8 * (i_ >> 2) + 4 * half + (i_ & 3)] = mono(sc_[i_]); } } } while (0)
        SMP_LOAD(ta, w);
#pragma unroll 1
        for (int kt = w; kt < 256; kt += 16) {
            SMP_LOAD(tb, kt + 8); __builtin_amdgcn_sched_barrier(0); SMP_TILE(ta, kt);
            SMP_LOAD(ta, kt + 16); __builtin_amdgcn_sched_barrier(0); SMP_TILE(tb, kt + 8);
        }
#undef SMP_LOAD
#undef SMP_TILE
        if (w == 0) {
            bf16x8 kf[4];
#pragma unroll
            for (int s = 0; s < 4; ++s) { u32x4 wv = (u32x4){0u, 0u, 0u, 0u}; if (q < 4) wv = *(const u32x4*)(KI + (r0 + q) * 64 + s * 16 + half * 8); kf[s] = __builtin_bit_cast(bf16x8, wv); }
            const f32x16 sc = idx_tile_t<true>(kf, qb, w8, wl);
            if (q < 4) {
#pragma unroll
                for (int i = 0; i < 16; ++i) SL[q * SLW + 256 * 32 + 8 * (i >> 2) + 4 * half + (i & 3)] = mono(sc[i]);
            }
        }
    }
    __syncthreads();
    {
        const int j = w >> 1, hw = w & 1, n = PAST + 1 + j;
        unsigned key[65];
#pragma unroll
        for (int k = 0; k < 65; ++k) { const int idx = hw * 4160 + 64 * k + lane; key[k] = 0u; if (idx < n) key[k] = SL[j * SLW + idx]; }
        unsigned thr = 0u;
#pragma unroll 1
        for (int bit = 31; bit >= 0; --bit) {
            const unsigned cand = thr | (1u << bit); int c = 0;
#pragma unroll
            for (int k = 0; k < 65; ++k) c += __popcll(__ballot(key[k] >= cand));
            if (lane == 0) CNT[(bit & 1) * 8 + w] = c;
            __syncthreads();
            const int tot = CNT[(bit & 1) * 8 + (w & ~1)] + CNT[(bit & 1) * 8 + (w | 1)];
            if (tot >= 256) thr = cand;
        }
        int cgt = 0, ceq = 0;
#pragma unroll 1
        for (int k = 0; k < 65; ++k) { const int idx = hw * 4160 + 64 * k + lane; const unsigned kk = idx < n ? SL[j * SLW + idx] : 0u;
            cgt += __popcll(__ballot(kk > thr)); ceq += __popcll(__ballot(kk == thr)); }
        if (lane == 0) { CNT[16 + w * 2] = cgt; CNT[16 + w * 2 + 1] = ceq; }
        __syncthreads();
        const int cgt0 = CNT[16 + (w & ~1) * 2], ceq0 = CNT[16 + (w & ~1) * 2 + 1], cgt1 = CNT[16 + (w | 1) * 2];
        const int need_tot = 256 - (cgt0 + cgt1);
        const int take0 = ceq0 < need_tot ? ceq0 : need_tot;
        int need = hw == 0 ? take0 : need_tot - take0;
        int base = hw == 0 ? 0 : cgt0 + take0;
#pragma unroll 1
        for (int k = 0; k < 65; ++k) {
            const int idx = hw * 4160 + 64 * k + lane; const unsigned kk = idx < n ? SL[j * SLW + idx] : 0u;
            const u64 eq = __ballot(kk == thr);
            const int rank = (int)__builtin_amdgcn_mbcnt_hi((unsigned)(eq >> 32), __builtin_amdgcn_mbcnt_lo((unsigned)eq, 0u));
            const bool on = kk > thr || (kk == thr && rank < need);
            const u64 sel = __ballot(on);
            const int pe = __popcll(eq); need = need > pe ? need - pe : 0;
            if (on) { const int pos = base + (int)__builtin_amdgcn_mbcnt_hi((unsigned)(sel >> 32), __builtin_amdgcn_mbcnt_lo((unsigned)sel, 0u));
                if (pos < 256) SELR[j * 256 + pos] = idx < PAST ? PTL[idx >> 7] * PAGE + (idx & 127) : (NEWKEY | (idx - PAST)); }
            base += __popcll(sel);
        }
    }
    __syncthreads();
    {
        LAS float* QF4 = (LAS float*)F.lds;
        LAS float* LG4 = (LAS float*)(F.lds + 8192);
        LAS float* PV4 = (LAS float*)(F.lds + 8192 + 32768);
#pragma unroll
        for (int j = 0; j < 4; ++j) QF4[j * 512 + tid] = bf2f(Q[(r0 + j) * 512 + tid]);
        __syncthreads();
#pragma unroll 1
        for (int j = 0; j < 4; ++j) {
            const int slot = tid >> 1, kvh = tid & 1; const int row = SELR[j * 256 + slot];
            float d0 = 0.f, d1 = 0.f, d2 = 0.f, d3 = 0.f;
            const LAS float* qb = QF4 + j * 512 + kvh * 256;
            if (row < NEWKEY) {
                const float* kr = F.cache_k + ((size_t)row * 2 + kvh) * 64;
                f32x4 kv[16];
#pragma unroll
                for (int c = 0; c < 16; ++c) kv[c] = *(const f32x4*)(kr + c * 4);
#pragma unroll
                for (int c = 0; c < 16; ++c)
#pragma unroll
                    for (int e = 0; e < 4; ++e) { const float kk = kv[c][e]; const int dd = c * 4 + e; d0 += kk * qb[dd]; d1 += kk * qb[64 + dd]; d2 += kk * qb[128 + dd]; d3 += kk * qb[192 + dd]; }
            } else {
                const bf16_t* kr = K + (r0 + (row - NEWKEY)) * 128 + kvh * 64;
#pragma unroll
                for (int c = 0; c < 8; ++c) { float kv[8]; unpack8(*(const u32x4*)(kr + c * 8), kv);
#pragma unroll
                    for (int e = 0; e < 8; ++e) { const float kk = kv[e]; const int dd = c * 8 + e; d0 += kk * qb[dd]; d1 += kk * qb[64 + dd]; d2 += kk * qb[128 + dd]; d3 += kk * qb[192 + dd]; } }
            }
            LAS float* lg = LG4 + j * 2048 + kvh * 1024 + slot;
            lg[0] = d0 * 0.125f; lg[256] = d1 * 0.125f; lg[512] = d2 * 0.125f; lg[768] = d3 * 0.125f;
        }
        __syncthreads();
#pragma unroll 1
        for (int j = 0; j < 4; ++j) {
            LAS float* lr = LG4 + j * 2048 + w * 256;
            float v0 = lr[lane], v1 = lr[64 + lane], v2 = lr[128 + lane], v3 = lr[192 + lane];
            const float mx = wave_max(fmaxf(fmaxf(v0, v1), fmaxf(v2, v3)));
            v0 = __expf(v0 - mx); v1 = __expf(v1 - mx); v2 = __expf(v2 - mx); v3 = __expf(v3 - mx);
            const float inv = 1.0f / wave_sum(v0 + v1 + v2 + v3);
            lr[lane] = v0 * inv; lr[64 + lane] = v1 * inv; lr[128 + lane] = v2 * inv; lr[192 + lane] = v3 * inv;
        }
        __syncthreads();
#pragma unroll 1
        for (int j = 0; j < 4; ++j) {
            float acc[8];
#pragma unroll
            for (int h = 0; h < 8; ++h) acc[h] = 0.f;
#pragma unroll 1
            for (int s0 = 0; s0 < 32; s0 += 16) {
                float v0[16], v1[16];
#pragma unroll
                for (int i = 0; i < 16; ++i) { const int row = SELR[j * 256 + w * 32 + s0 + i];
                    if (row < NEWKEY) { const float* vr = F.cache_v + (size_t)row * 128 + lane; v0[i] = vr[0]; v1[i] = vr[64]; }
                    else { const bf16_t* vr = V + (r0 + (row - NEWKEY)) * 128 + lane; v0[i] = bf2f(vr[0]); v1[i] = bf2f(vr[64]); } }
#pragma unroll
                for (int i = 0; i < 16; ++i) { const int slot = w * 32 + s0 + i;
#pragma unroll
                    for (int h = 0; h < 8; ++h) acc[h] += LG4[j * 2048 + h * 256 + slot] * (h < 4 ? v0[i] : v1[i]); }
            }
#pragma unroll
            for (int h = 0; h < 8; ++h) PV4[(w * 4 + j) * 512 + h * 64 + lane] = acc[h];
        }
        __syncthreads();
#pragma unroll
        for (int j = 0; j < 4; ++j) { float o = 0.f;
#pragma unroll
            for (int ww = 0; ww < 8; ++ww) o += PV4[(ww * 4 + j) * 512 + tid];
            ATT[(r0 + j) * 512 + tid] = (bf16_t)(cvt_pk_bf16(o, 0.f) & 0xffffu); }
        __syncthreads();
    }
}

__device__ __forceinline__ void p4_all(const Frame& F, int rep, int parts) {
    if (parts & 1) p4_vtranspose(F);
    if (parts & 2) p4_conv(F);
    if (parts & 4) { for (int b = F.bid; b < DB; b += F.nblk) p4_sample_unit(F, b); }
    if (!(parts & 8)) return;
    LAS int* qslot = (LAS int*)(F.lds + LDS_MISC + 32);
    __syncthreads();
    if (F.tid == 0) *qslot = (int)__hip_atomic_fetch_add(F.ctl + CW_Q4 + 64 * rep, 1u, __ATOMIC_RELAXED, __HIP_MEMORY_SCOPE_AGENT);
    for (;;) {
        __syncthreads();
        const int u = *qslot;
        if (u >= NB * 32) break;
        p4_prompt_unit(F, u & 31, 31 - (u >> 5), parts, qslot, F.ctl + CW_Q4 + 64 * rep);
    }
}

template <bool FAST> __device__ __forceinline__ void p5_unit_t(const Frame& F, int b, int kvh, int qt, const bf16x8 (&qf)[4], float mq, u32x4 kv, u32x4 vv, u64 mw) {
    const bf16_t* Q = WSP(bf16_t, WS_Q); const bf16_t* K = WSP(bf16_t, WS_K); const bf16_t* VTR = WSP(bf16_t, WS_VTR); const u64* MASK = WSP(u64, WS_MASK); bf16_t* ATT = WSP(bf16_t, WS_ATT);
    LAS unsigned char* Kl = F.lds;
    LAS unsigned char* Vl = F.lds + 64 * 144;
    const int w = F.wave, lane = F.lane, q = lane & 31, half = lane >> 5, tid = F.tid;
    const int g = w & 3, th = w >> 2, head = kvh * 4 + g;
    const size_t rowq = (size_t)b * 2048 + qt * 64 + th * 32 + q;
    f32x16 O0, O1;
#pragma unroll
    for (int i = 0; i < 16; ++i) { O0[i] = 0.f; O1[i] = 0.f; }
    float mrun = -1e30f, lrun = 0.f;
    const int rw = tid >> 3, ch = tid & 7;
    const bf16_t* kgp = K + ((size_t)b * 2048 + rw) * 128 + kvh * 64 + ch * 8;
    const bf16_t* vgp = VTR + ((size_t)((b * 2 + kvh) * 64 + rw)) * 2048 + ch * 8;
    for (int kt = 0; kt <= qt; ++kt) {
        __syncthreads();
        *(LAS u32x4*)(Kl + rw * 144 + ch * 16) = kv;
        *(LAS u32x4*)(Vl + rw * 144 + ch * 16) = vv;
        const u64 mwc = mw;
        __syncthreads();
        { const int kn = kt < qt ? kt + 1 : kt;
          kv = *(const u32x4*)(kgp + (size_t)kn * 64 * 128); vv = *(const u32x4*)(vgp + kn * 64); mw = MASK[rowq * 32 + kn]; }
        f32x16 S[2];
#pragma unroll
        for (int ks = 0; ks < 2; ++ks) {
            f32x16 a;
#pragma unroll
            for (int i = 0; i < 16; ++i) a[i] = FAST ? -mq : 0.f;
#pragma unroll
            for (int s = 0; s < 4; ++s) { const bf16x8 kf = *(const LAS bf16x8*)(Kl + (ks * 32 + q) * 144 + s * 32 + half * 16); a = __builtin_amdgcn_mfma_f32_32x32x16_bf16(kf, qf[s], a, 0, 0, 0); }
            S[ks] = a;
        }
        const u64 mh = mwc >> (4 * half);
        const unsigned mword[2] = {(unsigned)mh, (unsigned)(mh >> 32)};
        if (FAST) {
            float ls = 0.f;
#pragma unroll
            for (int ks = 0; ks < 2; ++ks)
#pragma unroll
                for (int i = 0; i < 16; ++i) { const unsigned keep = (unsigned)__builtin_amdgcn_sbfe((int)mword[ks], 8 * (i >> 2) + (i & 3), 1);
                    const float p = __uint_as_float(__float_as_uint(__builtin_amdgcn_exp2f(S[ks][i])) & keep); S[ks][i] = p; ls += p; }
            lrun += ls;
        } else {
            float mx = -INFINITY;
#pragma unroll
            for (int ks = 0; ks < 2; ++ks)
#pragma unroll
                for (int i = 0; i < 16; ++i) { const bool on = (mword[ks] >> (8 * (i >> 2) + (i & 3))) & 1u; const float sv = on ? S[ks][i] : -INFINITY; S[ks][i] = sv; mx = fmaxf(mx, sv); }
            mx = fmaxf(mx, __shfl_xor(mx, 32));
            const float mnew = fmaxf(mrun, mx);
            const float alpha = __builtin_amdgcn_exp2f(mrun - mnew);
            float ls = 0.f;
#pragma unroll
            for (int ks = 0; ks < 2; ++ks)
#pragma unroll
                for (int i = 0; i < 16; ++i) { const float p = __builtin_amdgcn_exp2f(S[ks][i] - mnew); S[ks][i] = p; ls += p; }
            lrun = lrun * alpha + ls;
            if (__any(mnew != mrun)) {
#pragma unroll
                for (int i = 0; i < 16; ++i) { O0[i] *= alpha; O1[i] *= alpha; } }
            mrun = mnew;
        }
#pragma unroll
        for (int ks = 0; ks < 2; ++ks)
#pragma unroll
            for (int s2 = 0; s2 < 2; ++s2) {
                u32x4 pw; pw.x = cvt_pk_bf16(S[ks][8 * s2 + 0], S[ks][8 * s2 + 1]); pw.y = cvt_pk_bf16(S[ks][8 * s2 + 2], S[ks][8 * s2 + 3]); pw.z = cvt_pk_bf16(S[ks][8 * s2 + 4], S[ks][8 * s2 + 5]); pw.w = cvt_pk_bf16(S[ks][8 * s2 + 6], S[ks][8 * s2 + 7]);
                const bf16x8 pf = __builtin_bit_cast(bf16x8, pw);
                const int kb = (ks * 32 + 16 * s2 + 4 * half) * 2;
                { const u32x2 a = *(const LAS u32x2*)(Vl + q * 144 + kb), c = *(const LAS u32x2*)(Vl + q * 144 + kb + 16);
                  const bf16x8 vf = __builtin_bit_cast(bf16x8, (u32x4){a.x, a.y, c.x, c.y}); O0 = __builtin_amdgcn_mfma_f32_32x32x16_bf16(vf, pf, O0, 0, 0, 0); }
                { const u32x2 a = *(const LAS u32x2*)(Vl + (32 + q) * 144 + kb), c = *(const LAS u32x2*)(Vl + (32 + q) * 144 + kb + 16);
                  const bf16x8 vf = __builtin_bit_cast(bf16x8, (u32x4){a.x, a.y, c.x, c.y}); O1 = __builtin_amdgcn_mfma_f32_32x32x16_bf16(vf, pf, O1, 0, 0, 0); }
            }
    }
    const float inv = 1.0f / (lrun + __shfl_xor(lrun, 32));
    bf16_t* op = ATT + rowq * 512 + head * 64 + 4 * half;
#pragma unroll
    for (int gq = 0; gq < 4; ++gq) {
        u32x2 a; a.x = cvt_pk_bf16(O0[4 * gq] * inv, O0[4 * gq + 1] * inv); a.y = cvt_pk_bf16(O0[4 * gq + 2] * inv, O0[4 * gq + 3] * inv); *(u32x2*)(op + 8 * gq) = a;
        u32x2 c; c.x = cvt_pk_bf16(O1[4 * gq] * inv, O1[4 * gq + 1] * inv); c.y = cvt_pk_bf16(O1[4 * gq + 2] * inv, O1[4 * gq + 3] * inv); *(u32x2*)(op + 32 + 8 * gq) = c;
    }
}
__device__ __forceinline__ void p5_unit_fast(const Frame& F, int b, int kvh, int qt, const bf16x8 (&qf)[4], float mq, u32x4 kv, u32x4 vv, u32x4 kv1, u32x4 vv1, u64 mcur, u64 mnxt) {
    const bf16_t* K = WSP(bf16_t, WS_K); const bf16_t* VTR = WSP(bf16_t, WS_VTR); const u64* MASK = WSP(u64, WS_MASK); bf16_t* ATT = WSP(bf16_t, WS_ATT);
    LAS unsigned char* Kl = F.lds;
    LAS unsigned char* Vl = F.lds + 4 * 64 * 144;
    const bool late = __builtin_amdgcn_readfirstlane(F.wave) >= 4;
    const int w = F.wave, lane = F.lane, q = lane & 31, half = lane >> 5, tid = F.tid;
    const int g = w & 3, th = w >> 2, head = kvh * 4 + g;
    const size_t rowq = (size_t)b * 2048 + qt * 64 + th * 32 + q;
    f32x16 O0, O1, L;
#pragma unroll
    for (int i = 0; i < 16; ++i) { O0[i] = 0.f; O1[i] = 0.f; L[i] = 0.f; }
    bf16x8 ones;
    { u32x4 o; o.x = o.y = o.z = o.w = 0x3F803F80u; asm volatile("" : "+v"(o)); ones = __builtin_bit_cast(bf16x8, o); }
    const int rw = tid >> 3, ch = tid & 7, nt = qt + 1;
    const int vwo = (ch >> 1) * 32 + (ch & 1) * 8;
    const bf16_t* kgp = K + ((size_t)b * 2048 + rw) * 128 + kvh * 64 + ch * 8;
    const bf16_t* vgp = VTR + ((size_t)((b * 2 + kvh) * 64 + rw)) * 2048 + ch * 8;
    const int k2 = nt > 2 ? 2 : 0;
    __syncthreads();
    *(LAS u32x4*)(Kl + rw * 144 + ch * 16) = kv; *(LAS u32x2*)(Vl + rw * 144 + vwo) = (u32x2){vv.x, vv.y}; *(LAS u32x2*)(Vl + rw * 144 + vwo + 16) = (u32x2){vv.z, vv.w};
    *(LAS u32x4*)(Kl + 9216 + rw * 144 + ch * 16) = kv1; *(LAS u32x2*)(Vl + 9216 + rw * 144 + vwo) = (u32x2){vv1.x, vv1.y}; *(LAS u32x2*)(Vl + 9216 + rw * 144 + vwo + 16) = (u32x2){vv1.z, vv1.w};
    __syncthreads();
    kv = *(const u32x4*)(kgp + (size_t)k2 * 64 * 128); vv = *(const u32x4*)(vgp + k2 * 64);
    int obm = 27648, ob0 = 0, ob1 = 9216, ob2 = 18432;
    f32x16 SA[2], SB[2];
#pragma unroll
    for (int ks = 0; ks < 2; ++ks) {
        f32x16 a;
#pragma unroll
        for (int i = 0; i < 16; ++i) a[i] = 0.f;
#pragma unroll
        for (int s = 0; s < 4; ++s) { const bf16x8 kf = *(const LAS bf16x8*)(Kl + (ks * 32 + q) * 144 + s * 32 + half * 16); a = __builtin_amdgcn_mfma_f32_32x32x16_bf16(kf, qf[s], a, 0, 0, 0); }
        SA[ks] = a;
    }
    auto pv = [&](f32x16 (&Sp)[2], const int voff) __attribute__((always_inline)) {
#pragma unroll
        for (int ks = 0; ks < 2; ++ks)
#pragma unroll
            for (int s2 = 0; s2 < 2; ++s2) {
                u32x4 pw; pw.x = cvt_pk_bf16(Sp[ks][8 * s2 + 0], Sp[ks][8 * s2 + 1]); pw.y = cvt_pk_bf16(Sp[ks][8 * s2 + 2], Sp[ks][8 * s2 + 3]); pw.z = cvt_pk_bf16(Sp[ks][8 * s2 + 4], Sp[ks][8 * s2 + 5]); pw.w = cvt_pk_bf16(Sp[ks][8 * s2 + 6], Sp[ks][8 * s2 + 7]);
                const bf16x8 pf = __builtin_bit_cast(bf16x8, pw);
                const int kb = (ks * 2 + s2) * 32 + half * 16;
                const LAS unsigned char* vb = Vl + voff;
                { const bf16x8 vf = *(const LAS bf16x8*)(vb + q * 144 + kb); O0 = __builtin_amdgcn_mfma_f32_32x32x16_bf16(vf, pf, O0, 0, 0, 0); }
                { const bf16x8 vf = *(const LAS bf16x8*)(vb + (32 + q) * 144 + kb); O1 = __builtin_amdgcn_mfma_f32_32x32x16_bf16(vf, pf, O1, 0, 0, 0); }
                L = __builtin_amdgcn_mfma_f32_32x32x16_bf16(ones, pf, L, 0, 0, 0);
            }
    };
    auto tile = [&](f32x16 (&Sc)[2], f32x16 (&Sn)[2], const int kt) __attribute__((always_inline)) {
        if (late && kt > 0) pv(Sn, obm);
        *(LAS u32x4*)(Kl + ob2 + rw * 144 + ch * 16) = kv; *(LAS u32x2*)(Vl + ob2 + rw * 144 + vwo) = (u32x2){vv.x, vv.y}; *(LAS u32x2*)(Vl + ob2 + rw * 144 + vwo + 16) = (u32x2){vv.z, vv.w};
        { const int kn = kt + 3 < nt ? kt + 3 : kt;
          kv = *(const u32x4*)(kgp + (size_t)kn * 64 * 128); vv = *(const u32x4*)(vgp + kn * 64); }
        const u64 mnn = MASK[rowq * 32 + (kt + 2 < nt ? kt + 2 : kt)];
        bf16x8 kf[9];
        const LAS unsigned char* kfb = Kl + ob1 + q * 144 + half * 16;
        kf[0] = *(const LAS bf16x8*)kfb;
        const u64 mh = mcur >> (4 * half);
        const unsigned mword[2] = {(unsigned)mh, (unsigned)(mh >> 32)};
#pragma unroll
        for (int i = 0; i < 16; ++i) { Sn[0][i] = 0.f; Sn[1][i] = 0.f; }
#pragma unroll
        for (int j = 0; j < 8; ++j) {
            const int ks = j & 1, s = j >> 1;
            if (j < 7) kf[j + 1] = *(const LAS bf16x8*)(kfb + ((j + 1) & 1) * 32 * 144 + ((j + 1) >> 1) * 32);
            Sn[ks] = __builtin_amdgcn_mfma_f32_32x32x16_bf16(kf[j], qf[s], Sn[ks], 0, 0, 0);
            const int eks = j >> 2;
#pragma unroll
            for (int e = 0; e < 4; ++e) { const int i = (j & 3) * 4 + e;
                unsigned keep;
                asm("v_bfe_i32 %0, %1, %2, 1" : "=v"(keep) : "v"(mword[eks]), "n"(8 * (i >> 2) + (i & 3)));
                Sc[eks][i] = __uint_as_float(__float_as_uint(__builtin_amdgcn_exp2f(Sc[eks][i])) & keep); }
            __builtin_amdgcn_sched_barrier(0);
        }
        if (!late) pv(Sc, ob0);
        mcur = mnxt; mnxt = mnn;
        { const int t = obm; obm = ob0; ob0 = ob1; ob1 = ob2; ob2 = t; }
        __syncthreads();
    };
    int kt = 0;
    for (; kt + 1 < nt; kt += 2) { tile(SA, SB, kt); tile(SB, SA, kt + 1); }
    if (kt < nt) tile(SA, SB, kt);
    if (late) { if (nt & 1) pv(SA, obm); else pv(SB, obm); }
    const float inv = 1.0f / L[0];
    bf16_t* op = ATT + rowq * 512 + head * 64 + 4 * half;
#pragma unroll
    for (int gq = 0; gq < 4; ++gq) {
        u32x2 a; a.x = cvt_pk_bf16(O0[4 * gq] * inv, O0[4 * gq + 1] * inv); a.y = cvt_pk_bf16(O0[4 * gq + 2] * inv, O0[4 * gq + 3] * inv); *(u32x2*)(op + 8 * gq) = a;
        u32x2 c; c.x = cvt_pk_bf16(O1[4 * gq] * inv, O1[4 * gq + 1] * inv); c.y = cvt_pk_bf16(O1[4 * gq + 2] * inv, O1[4 * gq + 3] * inv); *(u32x2*)(op + 32 + 8 * gq) = c;
    }
}
__device__ __forceinline__ void p5_unit(const Frame& F, int b, int kvh, int qt, float kbound) {
    const bf16_t* Q = WSP(bf16_t, WS_Q);
    const int w = F.wave, lane = F.lane, q = lane & 31, half = lane >> 5;
    const int g = w & 3, th = w >> 2, head = kvh * 4 + g;
    const size_t rowq = (size_t)b * 2048 + qt * 64 + th * 32 + q;
    bf16x8 qf[4]; float qs = 0.f;
    u32x4 qraw[4];
#pragma unroll
    for (int s = 0; s < 4; ++s) qraw[s] = *(const u32x4*)(Q + rowq * 512 + head * 64 + s * 16 + half * 8);
    const int rw0 = F.tid >> 3, ch0 = F.tid & 7, k1 = qt > 0 ? 1 : 0;
    const bf16_t* kgp0 = WSP(bf16_t, WS_K) + ((size_t)b * 2048 + rw0) * 128 + kvh * 64 + ch0 * 8;
    const bf16_t* vgp0 = WSP(bf16_t, WS_VTR) + ((size_t)((b * 2 + kvh) * 64 + rw0)) * 2048 + ch0 * 8;
    const u32x4 kv0 = *(const u32x4*)kgp0, vv0 = *(const u32x4*)vgp0;
    const u32x4 kv1 = *(const u32x4*)(kgp0 + (size_t)k1 * 64 * 128), vv1 = *(const u32x4*)(vgp0 + k1 * 64);
    const u64 m0 = WSP(u64, WS_MASK)[rowq * 32], m1 = WSP(u64, WS_MASK)[rowq * 32 + k1];
#pragma unroll
    for (int s = 0; s < 4; ++s) { float t8[8]; unpack8(qraw[s], t8);
#pragma unroll
        for (int e = 0; e < 8; ++e) t8[e] *= 0.125f * 1.4426950408889634f;
        const u32x4 pk = pack8(t8); qf[s] = __builtin_bit_cast(bf16x8, pk);
        float r8[8]; unpack8(pk, r8);
#pragma unroll
        for (int e = 0; e < 8; ++e) qs += r8[e] * r8[e]; }
    qs += __shfl_xor(qs, 32);
    const float mq = sqrtf(qs) * kbound;
    if (!__any(!(mq <= 40.0f))) p5_unit_fast(F, b, kvh, qt, qf, mq, kv0, vv0, kv1, vv1, m0, m1);
    else p5_unit_t<false>(F, b, kvh, qt, qf, 0.f, kv0, vv0, m0);
}
__device__ __forceinline__ void p5_all(const Frame& F, int rep) {
    const float kbound = 8.1f * wave_max(fabsf(F.k_norm_w[F.lane]));

    LAS int* qslot = (LAS int*)(F.lds + LDS_MISC + 32);
    const int xq = blockIdx.x & 7;
    int unext = 0;
    if (F.tid == 0) unext = (int)__hip_atomic_fetch_add(F.ctl + CW_Q5 + 64 * (xq + 8 * rep), 1u, __ATOMIC_RELAXED, __HIP_MEMORY_SCOPE_AGENT);
    for (;;) {
        __syncthreads();
        if (F.tid == 0) *qslot = unext;
        __syncthreads();
        const int u = *qslot;
        if (u >= 4 * 2 * 32) break;
        if (F.tid == 0) unext = (int)__hip_atomic_fetch_add(F.ctl + CW_Q5 + 64 * (xq + 8 * rep), 1u, __ATOMIC_RELAXED, __HIP_MEMORY_SCOPE_AGENT);
        p5_unit(F, 4 * xq + ((u >> 1) & 3), u & 1, 31 - (u >> 3), kbound);
    }
}

__device__ __forceinline__ void ce_desc(unsigned& a, unsigned& b) { const unsigned hi = a > b ? a : b, lo = a > b ? b : a; a = hi; b = lo; }
__device__ __forceinline__ void sort16_desc(unsigned (&a)[16]) {
#pragma unroll
    for (int k = 2; k <= 16; k <<= 1)
#pragma unroll
        for (int j = k >> 1; j > 0; j >>= 1)
#pragma unroll
            for (int i = 0; i < 16; ++i) { const int l = i ^ j; if (l > i) { if ((i & k) == 0) ce_desc(a[i], a[l]); else ce_desc(a[l], a[i]); } }
}
__device__ __forceinline__ void merge_top16(unsigned (&L)[16], const unsigned (&N)[16]) {
#pragma unroll
    for (int i = 0; i < 16; ++i) L[i] = L[i] > N[15 - i] ? L[i] : N[15 - i];
#pragma unroll
    for (int j = 8; j > 0; j >>= 1)
#pragma unroll
        for (int i = 0; i < 16; ++i) { const int l = i ^ j; if (l > i) ce_desc(L[i], L[l]); }
}
__device__ __forceinline__ unsigned mono16(unsigned h) { return (h & 0x8000u) ? (~h & 0xffffu) : (h | 0x8000u); }
__device__ __forceinline__ float unmono16(unsigned k) { const unsigned h = (k & 0x8000u) ? (k & 0x7fffu) : (~k & 0xffffu); return (float)__builtin_bit_cast(_Float16, (unsigned short)h); }
__device__ __forceinline__ void p11_select(const Frame& F) {
    const unsigned short* PST = WSP(unsigned short, WS_SCR); int* EIDX = WSP(int, WS_EIDX); float* G = WSP(float, WS_G);
    LAS unsigned char* TILE = F.lds;
    LAS unsigned* LST = (LAS unsigned*)F.lds;
    const int tid = F.tid;
    for (int unit = F.bid; unit < 258 * 8; unit += F.nblk) {
        const int pm = unit >> 3, h = unit & 7;
        const int row = tid & 255, p = tid >> 8;
        __syncthreads();
#pragma unroll
        for (int i = 0; i < 16; ++i) { const int e = tid + 512 * i, rw = e >> 5, ch = e & 31;
            *(LAS u32x4*)(TILE + rw * 528 + ch * 16) = *(const u32x4*)(PST + (size_t)unit * 65536 + rw * 256 + ch * 8); }
        __syncthreads();
        unsigned L[16];
#pragma unroll 1
        for (int k0 = 0; k0 < 128; k0 += 16) {
            const u32x4 a = *(const LAS u32x4*)(TILE + row * 528 + p * 256 + k0 * 2), b = *(const LAS u32x4*)(TILE + row * 528 + p * 256 + k0 * 2 + 16);
            const unsigned wv[8] = {a.x, a.y, a.z, a.w, b.x, b.y, b.z, b.w};
            unsigned N[16];
#pragma unroll
            for (int e = 0; e < 8; ++e) { N[2 * e] = (mono16(wv[e] & 0xffffu) << 16) | (unsigned)(127 - (k0 + 2 * e)); N[2 * e + 1] = (mono16(wv[e] >> 16) << 16) | (unsigned)(127 - (k0 + 2 * e + 1)); }
            sort16_desc(N);
            if (k0 == 0) {
#pragma unroll
                for (int e = 0; e < 16; ++e) L[e] = N[e];
            } else merge_top16(L, N);
        }
        __syncthreads();
#pragma unroll
        for (int q = 0; q < 16; ++q) LST[tid * 17 + q] = L[q];
        __syncthreads();
        if (tid < 256) {
            unsigned L2[16];
#pragma unroll
            for (int q = 0; q < 16; ++q) L2[q] = LST[(tid + 256) * 17 + q];
            float s1[16], s2[16];
#pragma unroll
            for (int q = 0; q < 16; ++q) { s1[q] = unmono16(L[q] >> 16); s2[q] = unmono16(L2[q] >> 16); }
            unsigned C[16], N[16]; int nn = 0; bool first = true;
#pragma unroll
            for (int i = 0; i < 16; ++i)
#pragma unroll
                for (int j = 0; j < 16; ++j)
                    if ((i + 1) * (j + 1) <= 16) {
                        N[nn++] = (mono(s1[i] + s2[j]) & ~255u) | (unsigned)(255 - (i * 16 + j));
                        if (nn == 16) { sort16_desc(N); if (first) {
#pragma unroll
                                for (int e = 0; e < 16; ++e) C[e] = N[e];
                                first = false; } else merge_top16(C, N); nn = 0; }
                    }
            {
#pragma unroll
                for (int e = 2; e < 16; ++e) N[e] = 0u;
                sort16_desc(N); merge_top16(C, N); }
            float sv[16]; int ev[16]; float mx = -INFINITY;
#pragma unroll
            for (int q = 0; q < 16; ++q) { const int pos = 255 - (int)(C[q] & 255u); const int i = pos >> 4, j = pos & 15;
                const unsigned k1 = LST[tid * 17 + i], k2 = LST[(tid + 256) * 17 + j];
                ev[q] = (127 - (int)(k1 & 127u)) * 128 + (127 - (int)(k2 & 127u));
                sv[q] = unmono16(k1 >> 16) + unmono16(k2 >> 16); mx = fmaxf(mx, sv[q]); }
            float sum = 0.f;
#pragma unroll
            for (int q = 0; q < 16; ++q) { sv[q] = __expf(sv[q] - mx); sum += sv[q]; }
            const float inv = 1.0f / sum;
            const size_t ob = ((size_t)(pm * 256 + row) * 8 + h) * 16;
#pragma unroll
            for (int q4 = 0; q4 < 4; ++q4) {
                *(int4*)(EIDX + ob + q4 * 4) = make_int4(ev[q4 * 4], ev[q4 * 4 + 1], ev[q4 * 4 + 2], ev[q4 * 4 + 3]);
                *(f32x4*)(G + ob + q4 * 4) = (f32x4){sv[q4 * 4] * inv, sv[q4 * 4 + 1] * inv, sv[q4 * 4 + 2] * inv, sv[q4 * 4 + 3] * inv}; }
        }
    }
}

typedef float f32x2v __attribute__((ext_vector_type(2)));
typedef __bf16 bf2_t __attribute__((ext_vector_type(2)));
__device__ __forceinline__ float dpp_add_xor1(float x) { return x + __uint_as_float(__builtin_amdgcn_update_dpp(0u, __float_as_uint(x), 0xB1, 0xF, 0xF, true)); }
__device__ __forceinline__ float dpp_add_xor2(float x) { return x + __uint_as_float(__builtin_amdgcn_update_dpp(0u, __float_as_uint(x), 0x4E, 0xF, 0xF, true)); }
__device__ __forceinline__ float dpp_add_hmir(float x) { return x + __uint_as_float(__builtin_amdgcn_update_dpp(0u, __float_as_uint(x), 0x141, 0xF, 0xF, true)); }

constexpr int P12A_TB_ = 48;
__device__ __forceinline__ void p12a_entry(const u32x4 (&rows)[8], int ent, const LAS unsigned char* H2L, int l8, float* ACT, int tb) {
    const int tl = (ent >> 21) & 63, slot = (ent >> 14) & 127;
    const LAS unsigned char* hp = H2L + tl * 2080 + l8 * 32;
    float acc = 0.f;
#pragma unroll
    for (int j = 0; j < 8; ++j) {
        const u32x4 ha = *(const LAS u32x4*)(hp + j * 256), hb = *(const LAS u32x4*)(hp + j * 256 + 16);
        const unsigned hw[8] = {ha.x, ha.y, ha.z, ha.w, hb.x, hb.y, hb.z, hb.w};
        const unsigned uw[4] = {rows[j].x, rows[j].y, rows[j].z, rows[j].w};
#pragma unroll
        for (int k = 0; k < 4; ++k) {
            acc = __builtin_amdgcn_fdot2_f32_bf16(__builtin_amdgcn_cvt_scalef32_pk_bf16_fp8(uw[k], 1.0f, false), __builtin_bit_cast(bf2_t, hw[2 * k]), acc, false);
            acc = __builtin_amdgcn_fdot2_f32_bf16(__builtin_amdgcn_cvt_scalef32_pk_bf16_fp8(uw[k], 1.0f, true), __builtin_bit_cast(bf2_t, hw[2 * k + 1]), acc, false); }
    }
    acc = dpp_add_hmir(dpp_add_xor2(dpp_add_xor1(acc)));
    if (l8 == 0 && ent >= 0) ACT[((size_t)tb * P12A_TB_ + tl) * 128 + slot] = acc;
}

constexpr int P12A_TB = 48, P12A_HSTRIDE = 2080;
__device__ __forceinline__ void p12a_act(const Frame& F, int probe) {
    const unsigned char* H2 = WSP(unsigned char, WS_H); const int* EIDX = WSP(int, WS_EIDX); const unsigned char* UT = WSP(unsigned char, WS_UT); float* ACT = (probe & 64) ? WSP(float, WS_SCR) : WSP(float, WS_ACT);
    const int emask = (probe & 64) ? 0x38ff : 0x3fff;
    LAS unsigned char* H2L = F.lds;
    LAS int* LSTL = (LAS int*)(F.lds + P12A_TB * P12A_HSTRIDE);
    LAS int* CTR = (LAS int*)(F.lds + P12A_TB * P12A_HSTRIDE + 6144 * 4);
    const int lane = F.lane, w = F.wave, tid = F.tid, g = lane >> 3, l8 = lane & 7;
    const bool part = (F.nblk & 7) == 0;
    const int xv = part ? (F.bid & 7) : 0, r = part ? (F.bid >> 3) : F.bid, nr = part ? (F.nblk >> 3) : F.nblk, npass = part ? 1 : 8;
    for (int pass = 0; pass < npass; ++pass) {
        const int v = xv * npass + pass;
        for (int tb = r; tb < T / P12A_TB; tb += nr) {
            u32x4 hreg[12]; int eAs[6], eBs[6];
#pragma unroll
            for (int i = 0; i < 12; ++i) { const int e_ = tid + 512 * i, row = e_ >> 7, ch = e_ & 127; hreg[i] = *(const u32x4*)(H2 + ((size_t)(tb * P12A_TB + row)) * 2048 + ch * 16); }
#pragma unroll
            for (int i = 0; i < 6; ++i) { const size_t t = (size_t)tb * P12A_TB + 6 * w + i; eAs[i] = EIDX[t * 128 + lane]; eBs[i] = EIDX[t * 128 + 64 + lane]; }
            __syncthreads();
            if (tid == 0) *CTR = 0;
#pragma unroll
            for (int i = 0; i < 12; ++i) { const int e_ = tid + 512 * i, row = e_ >> 7, ch = e_ & 127; *(LAS u32x4*)(H2L + row * P12A_HSTRIDE + ch * 16) = hreg[i]; }
            __syncthreads();
#pragma unroll
            for (int i = 0; i < 6; ++i) {
                const int tl = 6 * w + i; const int eA = eAs[i], eB = eBs[i];
                const bool onA = (eA >> 11) == v, onB = (eB >> 11) == v;
                const u64 mA = __ballot(onA), mB = __ballot(onB);
                const int nA = __popcll(mA), cnt = nA + __popcll(mB);
                int base = 0;
                if (lane == 0 && cnt > 0) base = __hip_atomic_fetch_add(CTR, cnt, __ATOMIC_RELAXED, __HIP_MEMORY_SCOPE_WORKGROUP);
                base = __builtin_amdgcn_readfirstlane(base);
                if (onA) LSTL[base + mbcnt64(mA)] = (tl << 21) | (lane << 14) | eA;
                if (onB) LSTL[base + nA + mbcnt64(mB)] = (tl << 21) | ((64 + lane) << 14) | eB;
            }
            __syncthreads();
            const int total = *CTR;
            const int nsteps = (total + 7) >> 3;
#define P12A_ENT(s_) ({ const int ix_ = (s_) * 8 + g; ix_ < total ? LSTL[ix_] : -1; })
#define P12A_ROWS(dst, ent_) do { const unsigned char* rp_ = UT + (size_t)((ent_) & emask) * 1024 + l8 * 16; \
        _Pragma("unroll") for (int j_ = 0; j_ < 8; ++j_) dst[j_] = *(const u32x4*)(rp_ + j_ * 128); } while (0)
            int s = w;
            if (s < nsteps) {
                int e0 = P12A_ENT(s), e1 = P12A_ENT(s + 8);
                u32x4 ra[8], rb[8];
                P12A_ROWS(ra, e0);
                for (;;) {
                    P12A_ROWS(rb, e1);
                    const int e2 = P12A_ENT(s + 16);
                    __builtin_amdgcn_sched_barrier(0);
                    p12a_entry(ra, e0, H2L, l8, ACT, tb);
                    s += 8; if (s >= nsteps) break;
                    P12A_ROWS(ra, e2);
                    const int e3 = P12A_ENT(s + 16);
                    __builtin_amdgcn_sched_barrier(0);
                    p12a_entry(rb, e1, H2L, l8, ACT, tb);
                    s += 8; if (s >= nsteps) break;
                    e0 = e2; e1 = e3;
                }
            }
#undef P12A_ENT
#undef P12A_ROWS
        }
    }
}

__device__ __forceinline__ void p12c_coef(const Frame& F) {
    const int* EIDX = WSP(int, WS_EIDX); const float* G = WSP(float, WS_G); const float* ACT = WSP(float, WS_ACT); const float* USC = WSP(float, WS_TSC); const float* VSC = WSP(float, WS_TSC) + 16384;
    u64* META = WSP(u64, WS_METAG);
    const size_t gt = (size_t)F.bid * 512 + F.tid, gn = (size_t)F.nblk * 512;
    size_t i = gt;
    for (; i + 3 * gn < (size_t)T * 128; i += 4 * gn) {
        int e[4]; float gg[4], aa[4], us[4], vs[4];
#pragma unroll
        for (int k = 0; k < 4; ++k) { e[k] = EIDX[i + k * gn]; gg[k] = G[i + k * gn]; aa[k] = ACT[i + k * gn]; }
#pragma unroll
        for (int k = 0; k < 4; ++k) { us[k] = USC[e[k]]; vs[k] = VSC[e[k]]; }
#pragma unroll
        for (int k = 0; k < 4; ++k) { const float c = gg[k] * gelu_tanh(aa[k] * us[k]) * vs[k]; META[i + k * gn] = (u64)(unsigned)e[k] | ((u64)__float_as_uint(c) << 32); }
    }
    for (; i < (size_t)T * 128; i += gn) { const int e = EIDX[i]; const float c = G[i] * gelu_tanh(ACT[i] * USC[e]) * VSC[e];
        META[i] = (u64)(unsigned)e | ((u64)__float_as_uint(c) << 32); }
}

__device__ __forceinline__ void p12b_out(const Frame& F) {
    const u64* METAG = WSP(u64, WS_METAG); const unsigned char* VT2 = WSP(unsigned char, WS_VT2); const float* MOD = WSP(float, WS_MOD); const bf16_t* Dm = WSP(bf16_t, WS_X1);
    const int lane = F.lane, w = F.wave, g = lane >> 3, l8 = lane & 7;
    LAS u64* META = (LAS u64*)(F.lds + w * 16384);
    const bool part = (F.nblk & 7) == 0;
    const int xv = part ? (F.bid & 7) : 0, r = part ? (F.bid >> 3) : F.bid, nr = part ? (F.nblk >> 3) : F.nblk, npass = part ? 1 : 8;
    const int qstride = nr * 8, nq = T / 8;
    for (int pass = 0; pass < npass; ++pass) {
        const int v = xv * npass + pass;
        const unsigned char* vbase = VT2 + v * 128 + l8 * 16;
        int q = r * 8 + w, buf = 0;
        if (q < nq) {
#pragma unroll
            for (int i = 0; i < 16; ++i) META[i * 64 + lane] = METAG[(size_t)q * 1024 + i * 64 + lane];
        }
        for (; q < nq; q += qstride) {
            const int qn = q + qstride;
            if (qn < nq) {
#pragma unroll
                for (int i = 0; i < 8; ++i) __builtin_amdgcn_global_load_lds((const unsigned*)((const unsigned char*)METAG + (size_t)qn * 8192 + i * 1024 + lane * 16), (LAS unsigned*)((LAS unsigned char*)(META + (buf ^ 1) * 1024) + i * 1024), 16, 0, 0); }
            const LAS u64* mp = META + buf * 1024 + g * 128;
            f32x2v acc[8];
#pragma unroll
            for (int k = 0; k < 8; ++k) acc[k] = (f32x2v){0.f, 0.f};
            u32x4 pa[16], pb[16];
            const LAS unsigned* mw = (const LAS unsigned*)mp;
#define P12B_LOAD(dst, c_) do { _Pragma("unroll") for (int i_ = 0; i_ < 16; ++i_) dst[i_] = *(const u32x4*)(vbase + (size_t)(mw[2 * ((c_) * 16 + i_)] & 0x3fffu) * 1024); } while (0)
#define P12B_FMA(srcb, c_) do { _Pragma("unroll") for (int i_ = 0; i_ < 16; ++i_) { const u32x4 p_ = srcb[i_]; const int wv_[4] = {(int)p_.x, (int)p_.y, (int)p_.z, (int)p_.w}; \
        const float cfv_ = __uint_as_float(mw[2 * ((c_) * 16 + i_) + 1]); const f32x2v cc_ = (f32x2v){cfv_, cfv_}; \
        _Pragma("unroll") for (int k_ = 0; k_ < 4; ++k_) { acc[2 * k_] += cc_ * __builtin_amdgcn_cvt_pk_f32_fp8(wv_[k_], false); acc[2 * k_ + 1] += cc_ * __builtin_amdgcn_cvt_pk_f32_fp8(wv_[k_], true); } } } while (0)
            P12B_LOAD(pa, 0);
#pragma unroll 1
            for (int cc = 0; cc < 3; ++cc) { P12B_LOAD(pb, 2 * cc + 1); P12B_FMA(pa, 2 * cc); P12B_LOAD(pa, 2 * cc + 2); P12B_FMA(pb, 2 * cc + 1); }
            P12B_LOAD(pb, 7); P12B_FMA(pa, 6); P12B_FMA(pb, 7);
#undef P12B_LOAD
#undef P12B_FMA
            { const size_t t = (size_t)q * 8 + g; const int c0 = v * 128 + l8 * 16;
              const float* xr = (t < (size_t)TP ? F.x_prompt + t * 1024 : F.x_sample + (t - TP) * 1024) + c0; const bf16_t* dr = Dm + t * 1024 + c0;
              const float* g2 = MOD + (size_t)mod_row((int)t) * NMOD + 5 * 1024 + c0; float* yr = F.out + t * 1024 + c0;
#pragma unroll
              for (int k = 0; k < 4; ++k) { const u32x2 dv = *(const u32x2*)(dr + 4 * k); const f32x4 xv4 = *(const f32x4*)(xr + 4 * k) + (f32x4){bf_lo(dv.x), bf_hi(dv.x), bf_lo(dv.y), bf_hi(dv.y)}, gv4 = *(const f32x4*)(g2 + 4 * k);
                  *(f32x4*)(yr + 4 * k) = xv4 + gv4 * (f32x4){acc[2 * k].x, acc[2 * k].y, acc[2 * k + 1].x, acc[2 * k + 1].y}; } }
            asm volatile("s_waitcnt vmcnt(0)" ::: "memory");
            buf ^= 1;
        }
    }
}


#ifndef SELF_CHECK
#define SELF_CHECK 0
#endif
#if SELF_CHECK
__device__ __forceinline__ void chk_fail(const Frame& F, size_t off) { F.out[off] = __uint_as_float(0x7fc00000u); }
__device__ __forceinline__ void self_check_mask(const Frame& F) {
    if (F.bid >= 18 || F.wave != 0) return;
    const int bs[3] = {0, 13, 31}; const int ts[6] = {255, 256, 300, 777, 1500, 2047};
    const int b = bs[F.bid / 6], t = ts[F.bid % 6], n = t + 1;
    const float* sc = WSP(float, WS_SCR) + ((size_t)b * 2048 + t) * 2048; const u64* mk = WSP(u64, WS_MASK) + ((size_t)b * 2048 + t) * 32;
    int bad = 0;
    for (int s = F.lane; s < 2048; s += 64) {
        bool sel = false;
        if (s < n) { const float v = sc[s]; int cnt = 0; for (int s2 = 0; s2 < n; ++s2) { const float v2 = sc[s2]; cnt += (v2 > v || (v2 == v && s2 < s)) ? 1 : 0; } sel = cnt < 256; }
        const bool got = (mk[s >> 6] >> (s & 63)) & 1ull;
        bad += (sel != got) ? 1 : 0;
    }
    if (__ballot(bad != 0) != 0ull && F.lane == 0) chk_fail(F, OFF_KP);
}
__device__ __forceinline__ void self_check_attn(const Frame& F) {
    if (F.bid >= 18) return;
    const int bs[3] = {0, 13, 31}; const int ts[6] = {0, 255, 256, 300, 1500, 2047};
    const int b = bs[F.bid / 6], t = ts[F.bid % 6], head = F.wave, kvh = head >> 2;
    const bf16_t* Q = WSP(bf16_t, WS_Q); const bf16_t* K = WSP(bf16_t, WS_K); const bf16_t* V = WSP(bf16_t, WS_V); const bf16_t* ATT = WSP(bf16_t, WS_ATT);
    const u64* mk = WSP(u64, WS_MASK) + ((size_t)b * 2048 + t) * 32;
    const size_t rq = (size_t)b * 2048 + t;
    float mx = -INFINITY;
    for (int s = F.lane; s <= t; s += 64) if ((mk[s >> 6] >> (s & 63)) & 1ull) { float d = 0.f; for (int e = 0; e < 64; ++e) d += bf2f(Q[rq * 512 + head * 64 + e]) * bf2f(K[((size_t)b * 2048 + s) * 128 + kvh * 64 + e]); mx = fmaxf(mx, d * 0.125f); }
    mx = wave_max(mx);
    float o[64]; float l = 0.f;
#pragma unroll
    for (int e = 0; e < 64; ++e) o[e] = 0.f;
    for (int s = F.lane; s <= t; s += 64) if ((mk[s >> 6] >> (s & 63)) & 1ull) { float d = 0.f; for (int e = 0; e < 64; ++e) d += bf2f(Q[rq * 512 + head * 64 + e]) * bf2f(K[((size_t)b * 2048 + s) * 128 + kvh * 64 + e]);
        const float p = __expf(d * 0.125f - mx); l += p;
#pragma unroll
        for (int e = 0; e < 64; ++e) o[e] += p * bf2f(V[((size_t)b * 2048 + s) * 128 + kvh * 64 + e]); }
    l = wave_sum(l); float err = 0.f, mag = 0.f;
#pragma unroll
    for (int e = 0; e < 64; ++e) { const float r = wave_sum(o[e]) / l; const float gts = bf2f(ATT[rq * 512 + head * 64 + e]); err = fmaxf(err, fabsf(r - gts)); mag = fmaxf(mag, fabsf(r)); }
    if (!(err <= 0.03f * mag + 2e-3f) && F.lane == 0) chk_fail(F, OFF_VP);
}
__device__ __forceinline__ void self_check_peer(const Frame& F) {
    if (F.bid >= 6) return;
    const int tsamp[6] = {0, 1000, 40000, 65535, 65536, 66047};
    const int t = tsamp[F.bid], tid = F.tid;
    const bf16_t* Q2 = WSP(bf16_t, WS_Q2); const bf16_t* H2 = WSP(bf16_t, WS_H); const int* EIDX = WSP(int, WS_EIDX); const float* G = WSP(float, WS_G);
    const bf16_t* Dm = WSP(bf16_t, WS_X1); const float* MOD = WSP(float, WS_MOD);
    LAS float* S = (LAS float*)F.lds;
    LAS int* REF = (LAS int*)(F.lds + 8192);
    LAS float* CO = (LAS float*)(F.lds + 8192 + 512);
    LAS int* CNTW = (LAS int*)(F.lds + 8192 + 1024);
    for (int i = tid; i < 2048; i += 512) { const int hp = i >> 7, key = i & 127, h = hp >> 1, p = hp & 1; float d = 0.f;
        for (int e = 0; e < 128; ++e) d += bf2f(Q2[(size_t)t * 2048 + h * 256 + p * 128 + e]) * F.peer_sub_keys[(((size_t)p * 8 + h) * 128 + key) * 128 + e];
        S[i] = d; }
    if (tid == 0) *CNTW = 0;
    __syncthreads();
    if (tid < 8) { const int h = tid; int i1[16], i2[16]; float s1[16], s2[16];
        for (int p = 0; p < 2; ++p) { const LAS float* sp = S + (h * 2 + p) * 128; int n = 0;
            for (int k = 0; k < 128; ++k) { int rank = 0; for (int k2 = 0; k2 < 128; ++k2) rank += (sp[k2] > sp[k] || (sp[k2] == sp[k] && k2 < k)) ? 1 : 0;
                if (rank < 16) { if (p == 0) { i1[rank] = k; s1[rank] = sp[k]; } else { i2[rank] = k; s2[rank] = sp[k]; } ++n; } } }
        for (int a = 0; a < 16; ++a) for (int c = 0; c < 16; ++c) { const float v = s1[a] + s2[c]; int rank = 0;
            for (int a2 = 0; a2 < 16; ++a2) for (int c2 = 0; c2 < 16; ++c2) { const float v2 = s1[a2] + s2[c2]; rank += (v2 > v || (v2 == v && (a2 * 16 + c2) < (a * 16 + c))) ? 1 : 0; }
            if (rank < 16) REF[h * 16 + rank] = i1[a] * 128 + i2[c]; } }
    __syncthreads();
    if (tid < 128) { const int h = tid >> 4; const int e = EIDX[(size_t)t * 128 + tid]; bool found = false; for (int k = 0; k < 16; ++k) found |= (REF[h * 16 + k] == e); if (!found) atomicAdd((int*)CNTW, 1); }
    __syncthreads();
    if (tid == 0 && *CNTW > 12) chk_fail(F, OFF_KIP);
    { const int slot = tid >> 2, part = tid & 3; const int e = EIDX[(size_t)t * 128 + slot]; float d = 0.f;
      for (int c = part * 256; c < part * 256 + 256; ++c) d += F.peer_u[(size_t)e * 1024 + c] * bf2f(H2[(size_t)t * 1024 + c]);
      d += __shfl_xor(d, 1); d += __shfl_xor(d, 2);
      if (part == 0) CO[slot] = G[(size_t)t * 128 + slot] * gelu_tanh(d); }
    __syncthreads();
    float err = 0.f, mag = 0.f;
    for (int c = tid; c < 1024; c += 512) { float o = 0.f; for (int slot = 0; slot < 128; ++slot) o += CO[slot] * F.peer_v[(size_t)EIDX[(size_t)t * 128 + slot] * 1024 + c];
        const float g2 = MOD[(size_t)mod_row(t) * NMOD + 5 * 1024 + c]; const float ref = g2 * o, got = F.out[(size_t)t * 1024 + c] - ((t < TP ? F.x_prompt[(size_t)t * 1024 + c] : F.x_sample[(size_t)(t - TP) * 1024 + c]) + bf2f(Dm[(size_t)t * 1024 + c]));
        err = fmaxf(err, fabsf(ref - got)); mag = fmaxf(mag, fabsf(ref)); }
    err = wave_max(err); mag = wave_max(mag);
    LAS float* RED = (LAS float*)(F.lds + 8192 + 2048);
    if (F.lane == 0) { RED[F.wave] = err; RED[8 + F.wave] = mag; }
    __syncthreads();
    if (tid == 0) { float e2 = 0.f, m2 = 0.f; for (int w = 0; w < 8; ++w) { e2 = fmaxf(e2, RED[w]); m2 = fmaxf(m2, RED[8 + w]); } if (!(e2 <= 0.12f * m2 + 1e-4f)) chk_fail(F, OFF_CONVP); }
}
#endif

constexpr int N_PHASES = 15;
__global__ void __launch_bounds__(512, 2) fwd_kernel(Params P) {
    extern __shared__ __attribute__((aligned(16))) unsigned char lds_raw[];
    Frame F;
    F.lds = (LAS unsigned char*)lds_raw; F.tid = threadIdx.x; F.lane = F.tid & 63; F.wave = __builtin_amdgcn_readfirstlane(F.tid >> 6); F.bid = blockIdx.x; F.nblk = gridDim.x;
    F.ws = P.ws; F.ctl = (unsigned*)(P.ws + WS_CTL); F.out = P.out;
    F.x_prompt = P.in[0]; F.x_sample = P.in[1]; F.cache_k = P.in[2]; F.cache_v = P.in[3]; F.cache_kidx = P.in[4]; F.state_conv = P.in[5]; F.page_table = (const int*)P.in[6];
    F.c_prompt = P.in[7]; F.c_sample = P.in[8]; F.w_ada = P.in[9]; F.b_ada = P.in[10]; F.norm1_w = P.in[11]; F.w_in = P.in[12]; F.conv_w = P.in[13]; F.q_norm_w = P.in[14]; F.k_norm_w = P.in[15];
    F.w_conv_out = P.in[16]; F.w_attn_out = P.in[17]; F.w_out = P.in[18]; F.norm2_w = P.in[19]; F.peer_w_q = P.in[20]; F.peer_sub_keys = P.in[21]; F.peer_u = P.in[22]; F.peer_v = P.in[23];
    if (F.tid < 16) ((LAS unsigned*)(F.lds + LDS_MISC))[F.tid] = 0u;
    __syncthreads();
    const int lo = P.ph_lo, hi = P.ph_hi;
    const bool one = (hi - lo) > 1;
    XcdBarrier bar; bar.bar = F.ctl + CW_BAR; bar.x = 0; bar.st = nullptr;
    if (one) bar = xcd_barrier_post(F.ctl + CW_BAR, (volatile LAS unsigned*)(F.lds + LDS_MISC));
#define IN(k) (lo <= (k) && (k) < hi)
#define SEAM(k) do { if (IN(k) && IN((k) + 1)) xcd_barrier(bar); } while (0)

#define PHASE(k, ...) do { if (IN(k)) { const int rep = 0; __VA_ARGS__; } SEAM(k); } while (0)

    PHASE(0, p0_convert(F));
    PHASE(1, {
        float* MODw = WSP(float, WS_MOD); const float* bias = F.b_ada;
        skinny_phase<false>(F, WSP(bf16_t, WS_CB), WSP(bf16_t, WS_WADA), nullptr, nullptr, 1024, 1024, NMOD, 0, 3, [=](int r, int c, const float (&s01)[4], const float (&s23)[4]) {
            const f32x4 bv = *(const f32x4*)(bias + c);
            *(f32x4*)(MODw + (size_t)r * NMOD + c) = (f32x4){s01[0] + s23[0] + bv[0], s01[1] + s23[1] + bv[1], s01[2] + s23[2] + bv[2], s01[3] + s23[3] + bv[3]}; }); });
    PHASE(2, row_norm_pass<false>(F));
    PHASE(3, {
        pg8::Gemm g{WSP(bf16_t, WS_H), WSP(bf16_t, WS_WIN), T, NPROJ_PAD, 1024, 1024, 1024, 0}; pg8::StaticOrder S; S.init(T, NPROJ_PAD, F.nblk, F.bid);
        EpiInProj E{WSP(bf16_t, WS_U), WSP(bf16_t, WS_BG), WSP(bf16_t, WS_Q), WSP(bf16_t, WS_K), WSP(bf16_t, WS_V), WSP(bf16_t, WS_QI), WSP(bf16_t, WS_KI), WSP(bf16_t, WS_SGA), WSP(bf16_t, WS_SGB),
                    WSP(float, WS_WI), F.q_norm_w, F.k_norm_w, WSP(f32x2, WS_ROPE), F.out};
        pg8::gemm_phase(F.lds, g, S, E); });
    PHASE(4, p4_all(F, rep, P.pad));
#if SELF_CHECK
#define SC_MASK() self_check_mask(F)
#define SC_ATTN() self_check_attn(F)
#else
#define SC_MASK() do {} while (0)
#define SC_ATTN() do {} while (0)
#endif
    PHASE(5, { SC_MASK(); p5_all(F, rep); });
    PHASE(6, { SC_ATTN();
        { pg8::Gemm g{WSP(bf16_t, WS_APRE), WSP(bf16_t, WS_WCO), TP, 1024, 1024, 512, 512, 0, WSP(bf16_t, WS_ATT), WSP(bf16_t, WS_WAO)}; pg8::StaticOrder S; S.init(TP, 1024, F.nblk, F.bid);
          EpiMixFused E{WSP(bf16_t, WS_SGA), WSP(bf16_t, WS_SGB), WSP(bf16_t, WS_MIX)}; pg8::gemm_phase<EpiMixFused, pg8::StaticOrder, true, true, true>(F.lds, g, S, E); }
        { const bf16_t* SGA = WSP(bf16_t, WS_SGA); const bf16_t* SGB = WSP(bf16_t, WS_SGB); bf16_t* MIX = WSP(bf16_t, WS_MIX);
          skinny_phase<true>(F, WSP(bf16_t, WS_APRE), WSP(bf16_t, WS_WCO), WSP(bf16_t, WS_ATT), WSP(bf16_t, WS_WAO), 512, 512, 1024, TP, 8, [=](int r, int c, const float (&s01)[4], const float (&s23)[4]) {
              const size_t o = (size_t)r * 1024 + c; const u32x2 ga = *(const u32x2*)(SGA + o), gb = *(const u32x2*)(SGB + o);
              u32x2 m; m.x = cvt_pk_bf16(bf_lo(ga.x) * s01[0] + bf_lo(gb.x) * s23[0], bf_hi(ga.x) * s01[1] + bf_hi(gb.x) * s23[1]);
              m.y = cvt_pk_bf16(bf_lo(ga.y) * s01[2] + bf_lo(gb.y) * s23[2], bf_hi(ga.y) * s01[3] + bf_hi(gb.y) * s23[3]); *(u32x2*)(MIX + o) = m; }); } });
    PHASE(7, {
        pg8::Gemm g{WSP(bf16_t, WS_MIX), WSP(bf16_t, WS_WOUT), TP, 1024, 1024, 1024, 1024, 0}; pg8::StaticOrder S; S.init(TP, 1024, F.nblk, F.bid);
        EpiOut E{WSP(float, WS_MOD), WSP(bf16_t, WS_X1)}; pg8::gemm_phase(F.lds, g, S, E);
        { const float* MOD = WSP(float, WS_MOD); bf16_t* Dm = WSP(bf16_t, WS_X1);
          skinny_phase<false>(F, WSP(bf16_t, WS_MIX), WSP(bf16_t, WS_WOUT), nullptr, nullptr, 1024, 1024, 1024, TP, 8, [=](int r, int c, const float (&s01)[4], const float (&s23)[4]) {
              const f32x4 g1 = *(const f32x4*)(MOD + (size_t)mod_row(r) * NMOD + 2048 + c);
              u32x2 d; d.x = cvt_pk_bf16(g1[0] * (s01[0] + s23[0]), g1[1] * (s01[1] + s23[1])); d.y = cvt_pk_bf16(g1[2] * (s01[2] + s23[2]), g1[3] * (s01[3] + s23[3]));
              *(u32x2*)(Dm + (size_t)r * 1024 + c) = d; }); } });
    PHASE(8, row_norm_pass<true>(F));
    PHASE(9, {
        pg8::Gemm g{WSP(bf16_t, WS_H), WSP(bf16_t, WS_WQ), TP, 2048, 1024, 1024, 1024, 0}; pg8::StaticOrder S; S.init(TP, 2048, F.nblk, F.bid);
        EpiBf16Plain E{WSP(bf16_t, WS_Q2), 2048}; pg8::gemm_phase(F.lds, g, S, E);
        { bf16_t* Q2 = WSP(bf16_t, WS_Q2);
          skinny_phase<false>(F, WSP(bf16_t, WS_H), WSP(bf16_t, WS_WQ), nullptr, nullptr, 1024, 1024, 2048, TP, 8, [=](int r, int c, const float (&s01)[4], const float (&s23)[4]) {
              u32x2 d; d.x = cvt_pk_bf16(s01[0] + s23[0], s01[1] + s23[1]); d.y = cvt_pk_bf16(s01[2] + s23[2], s01[3] + s23[3]); *(u32x2*)(Q2 + (size_t)r * 2048 + c) = d; }); } });
    PHASE(10, {
        pg8::Gemm g{WSP(bf16_t, WS_Q2), WSP(bf16_t, WS_SKBD), TP, 2048, 256, 2048, 256, 256}; pg8::StaticOrder S; S.init(TP, 2048, F.nblk, F.bid);
        EpiPST E{WSP(unsigned short, WS_SCR)}; pg8::gemm_phase<EpiPST, pg8::StaticOrder, false, false>(F.lds, g, S, E);
        { unsigned short* PST = WSP(unsigned short, WS_SCR);
          auto fin = [=](int r, int c, const float (&s01)[4], const float (&s23)[4]) {
              u32x2 d; d.x = cvt_pk_f16(s01[0] + s23[0], s01[1] + s23[1]); d.y = cvt_pk_f16(s01[2] + s23[2], s01[3] + s23[3]);
              *(u32x2*)(PST + (size_t)((r >> 8) * 8 + (c >> 8)) * 65536 + (size_t)(r & 255) * 256 + (c & 255)) = d; };
          skinny_phase<false, decltype(fin), 64>(F, WSP(bf16_t, WS_Q2), WSP(bf16_t, WS_SKBD), nullptr, nullptr, 2048, 256, 2048, TP, 8, fin, 256); } });
    PHASE(11, p11_select(F));
    PHASE(12, p12a_act(F, P.pad));
    PHASE(13, p12c_coef(F));
    PHASE(14, p12b_out(F));
#if SELF_CHECK
    xcd_barrier(bar);
    self_check_peer(F);
#endif
#undef PHASE
#undef IN
#undef SEAM
}

extern "C" void kernel_launch(void* const* d_in, const int* in_sizes, int n_in, void* d_out, int out_size, void* d_ws, size_t ws_size, hipStream_t stream) {
    static int grid = 0;
    if (grid == 0) {
        if (n_in != 24 || (size_t)out_size != OUT_TOTAL || ws_size < WS_END) { fprintf(stderr, "kernel_launch: unexpected sizes n_in %d out %d ws %zu (need %zu)\n", n_in, out_size, ws_size, (size_t)WS_END); grid = -1; return; }
        int dev = 0, cus = 0, per_cu = 0;
        if (hipGetDevice(&dev) != hipSuccess || hipDeviceGetAttribute(&cus, hipDeviceAttributeMultiprocessorCount, dev) != hipSuccess) { grid = -1; return; }
        if (hipFuncSetAttribute((const void*)fwd_kernel, hipFuncAttributeMaxDynamicSharedMemorySize, LDS_BYTES) != hipSuccess) { fprintf(stderr, "kernel_launch: hipFuncSetAttribute failed\n"); grid = -1; return; }
        if (hipOccupancyMaxActiveBlocksPerMultiprocessor(&per_cu, (const void*)fwd_kernel, 512, LDS_BYTES) != hipSuccess || per_cu < 1) { fprintf(stderr, "kernel_launch: occupancy query says %d\n", per_cu); }
        (void)hipGetLastError();
        grid = cus;
    }
    if (grid < 0) return;
    (void)hipMemsetAsync((char*)d_ws + WS_CTL, 0, CTL_BYTES, stream);
    Params p{};
    for (int i = 0; i < 24; ++i) p.in[i] = (const float*)d_in[i];
    p.out = (float*)d_out; p.ws = (unsigned char*)d_ws; p.rep_mask = 0; p.pad = 15;
#if N_LAUNCH_MODE == 1
    p.ph_lo = 0; p.ph_hi = N_PHASES;
    hipLaunchKernelGGL(fwd_kernel, dim3(grid), dim3(512), LDS_BYTES, stream, p);
#else
    for (int k = 0; k < N_PHASES; ++k) { p.ph_lo = k; p.ph_hi = k + 1; hipLaunchKernelGGL(fwd_kernel, dim3(grid), dim3(512), LDS_BYTES, stream, p);
        if ((REPEAT_MASK >> k) & 1) { (void)hipMemsetAsync((char*)d_ws + WS_CTL, 0, CTL_BYTES, stream); p.pad = PROBE_PARTS; hipLaunchKernelGGL(fwd_kernel, dim3(grid), dim3(512), LDS_BYTES, stream, p); p.pad = 15; } }
#endif
}
```

```cpp
#include <hip/hip_runtime.h>
#include <cstdio>
#include <cstdint>

#ifndef N_LAUNCH_MODE
#define N_LAUNCH_MODE 1
#endif

#define REPEAT_MASK 0x0000

#define PROBE_PARTS 15
#define LAS __attribute__((address_space(3)))
typedef unsigned short bf16_t;
typedef short bf16x8 __attribute__((ext_vector_type(8)));
typedef short bf16x4 __attribute__((ext_vector_type(4)));
typedef float f32x4 __attribute__((ext_vector_type(4)));
typedef float f32x2 __attribute__((ext_vector_type(2)));
typedef float f32x16 __attribute__((ext_vector_type(16)));
typedef unsigned u32x4 __attribute__((ext_vector_type(4)));
typedef unsigned u32x2 __attribute__((ext_vector_type(2)));
typedef unsigned long long u64;

constexpr int D = 1024, TP = 65536, TS = 512, T = TP + TS, SEQ = 2048, NB = 32, DB = 128, DS = 4;
constexpr int PAST = 8192, PAGE = 128, NPG = 64;
constexpr int NPROJ = 4936, NPROJ_PAD = 5120;
constexpr int NMOD = 6144;
constexpr float NORM_EPS = 1e-6f;
constexpr float IDX_SCALE = 0.125f * 0.35355339059327373f;
constexpr size_t OFF_Y = 0;
constexpr size_t OFF_KP = (size_t)T * D;
constexpr size_t OFF_VP = OFF_KP + (size_t)TP * 128;
constexpr size_t OFF_KIP = OFF_VP + (size_t)TP * 128;
constexpr size_t OFF_CONVP = OFF_KIP + (size_t)TP * 64;
constexpr size_t OFF_KS = OFF_CONVP + (size_t)NB * 2 * 512;
constexpr size_t OFF_VS = OFF_KS + (size_t)TS * 128;
constexpr size_t OFF_KIS = OFF_VS + (size_t)TS * 128;
constexpr size_t OFF_CONVS = OFF_KIS + (size_t)TS * 64;
constexpr size_t OUT_TOTAL = OFF_CONVS + (size_t)DB * 2 * 512;
static_assert(OUT_TOTAL == 88932352, "out size");

constexpr size_t al256(size_t x) { return (x + 255) & ~(size_t)255; }
constexpr size_t WS_CTL = 0;
constexpr size_t CTL_BYTES = 65536;
constexpr size_t WS_WIN = WS_CTL + CTL_BYTES;
constexpr size_t WS_WCO = WS_WIN + (size_t)NPROJ_PAD * 1024 * 2;
constexpr size_t WS_WAO = WS_WCO + (size_t)1024 * 512 * 2;
constexpr size_t WS_WOUT = WS_WAO + (size_t)1024 * 512 * 2;
constexpr size_t WS_WQ = WS_WOUT + (size_t)1024 * 1024 * 2;
constexpr size_t WS_SKBD = WS_WQ + (size_t)2048 * 1024 * 2;
constexpr size_t WS_UT = WS_SKBD + (size_t)2048 * 256 * 2;
constexpr size_t WS_VT2 = WS_UT + (size_t)16384 * 1024;
constexpr size_t WS_TSC = WS_VT2 + (size_t)16384 * 1024;
constexpr size_t WS_WADA = WS_TSC + (size_t)2 * 16384 * 4;
constexpr size_t WS_CB = WS_WADA + (size_t)NMOD * 1024 * 2;
constexpr size_t WS_MOD = WS_CB + (size_t)256 * 1024 * 2;
constexpr size_t WS_ROPE = WS_MOD + (size_t)256 * NMOD * 4;
constexpr size_t WS_H = al256(WS_ROPE + (size_t)2052 * 32 * 8);
constexpr size_t WS_U = WS_H + (size_t)T * 1024 * 2;
constexpr size_t WS_BG = WS_U + (size_t)T * 512 * 2;
constexpr size_t WS_Q = WS_BG + (size_t)T * 512 * 2;
constexpr size_t WS_K = WS_Q + (size_t)T * 512 * 2;
constexpr size_t WS_V = WS_K + (size_t)T * 128 * 2;
constexpr size_t WS_VTR = WS_V + (size_t)T * 128 * 2;
constexpr size_t WS_QI = WS_VTR + (size_t)TP * 128 * 2;
constexpr size_t WS_KI = WS_QI + (size_t)T * 512 * 2;
constexpr size_t WS_WI = WS_KI + (size_t)T * 64 * 2;
constexpr size_t WS_SGA = WS_WI + (size_t)T * 8 * 4;
constexpr size_t WS_SGB = WS_SGA + (size_t)T * 1024 * 2;
constexpr size_t WS_MASK = WS_SGB + (size_t)T * 1024 * 2;
constexpr size_t WS_APRE = WS_MASK + (size_t)TP * 32 * 8;
constexpr size_t WS_ATT = WS_APRE + (size_t)T * 512 * 2;
constexpr size_t WS_MIX = WS_ATT + (size_t)T * 512 * 2;
constexpr size_t WS_Q2 = WS_MIX + (size_t)T * 1024 * 2;
constexpr size_t WS_EIDX = WS_Q2 + (size_t)T * 2048 * 2;
constexpr size_t WS_G = WS_EIDX + (size_t)T * 128 * 4;
constexpr size_t WS_SCR = WS_G + (size_t)T * 128 * 4;
constexpr size_t SCR_BYTES = (size_t)T * 2048 * 4;
constexpr size_t WS_X1 = WS_SCR + SCR_BYTES;
constexpr size_t WS_ACT = WS_X1 + (size_t)T * 1024 * 4;
constexpr size_t WS_LISTG = WS_ACT + (size_t)T * 128 * 4;
constexpr size_t WS_METAG = WS_LISTG + (size_t)256 * 8192 * 4;
constexpr size_t WS_END = WS_METAG + (size_t)T * 128 * 8;

constexpr int CW_BAR = 0;
constexpr int CW_Q4 = 4096;
constexpr int CW_Q5 = 8192;

constexpr int LDS_BYTES = 155648;
constexpr int LDS_MISC = 155648 - 64;

#define XB_TMO      128
#define XB_XCNT(j)  (256  + 64 * (j))
#define XB_XSUB(j)  (1280 + 64 * (j))
#define XB_XGEN(j)  (2304 + 64 * (j))
#define XB_TOP      3328
#define XB_TOPGEN   3392
#define XCD_BAR_WORDS 3456
#define XB_SPIN_CAP (1u << 18)

__device__ __forceinline__ unsigned xb_ld(unsigned* p)              { return __hip_atomic_load(p, __ATOMIC_RELAXED, __HIP_MEMORY_SCOPE_AGENT); }
__device__ __forceinline__ unsigned xb_add(unsigned* p, unsigned v) { return __hip_atomic_fetch_add(p, v, __ATOMIC_RELAXED, __HIP_MEMORY_SCOPE_AGENT); }
__device__ __forceinline__ unsigned xb_xcc_id() { return (unsigned)__builtin_amdgcn_s_getreg((3 << 11) | 20) & 0xFu; }
#define XB_SPIN(cond, bar) do { unsigned _sp = 0; while (cond) { __builtin_amdgcn_s_sleep(1); \
    if ((++_sp & 255u) == 0u) { if (xb_ld(&(bar)[XB_TMO])) break; if (_sp > XB_SPIN_CAP) { atomicAdd(&(bar)[XB_TMO], 1u); break; } } } } while (0)

struct XcdBarrier { unsigned* bar; unsigned x; volatile LAS unsigned* st; };

__device__ __forceinline__ XcdBarrier xcd_barrier_post(unsigned* bar, volatile LAS unsigned* st) {
    XcdBarrier b; b.bar = bar; b.x = xb_xcc_id(); b.st = st;
    if (threadIdx.x == 0) (void)xb_add(&bar[XB_XCNT(b.x)], 1u);
    return b;
}
__device__ __forceinline__ void xcd_barrier_complete(unsigned* bar, unsigned x, unsigned& nloc, unsigned& nx) {
    const unsigned G = gridDim.x * gridDim.y * gridDim.z;
    unsigned sum, cnt, mine, sp = 0u;
    for (;;) {
        sum = 0u; cnt = 0u; mine = 0u;
#pragma unroll
        for (unsigned j = 0; j < 16; ++j) { const unsigned c = xb_ld(&bar[XB_XCNT(j)]); sum += c; cnt += (c > 0u) ? 1u : 0u; mine = (j == x) ? c : mine; }
        if (sum == G) break;
        __builtin_amdgcn_s_sleep(1);
        if ((++sp & 255u) == 0u) { if (xb_ld(&bar[XB_TMO])) break; if (sp > XB_SPIN_CAP) { atomicAdd(&bar[XB_TMO], 1u); break; } }
    }
    nloc = mine > 0u ? mine : 1u; nx = cnt > 0u ? cnt : 1u;
}
__device__ __forceinline__ void xcd_barrier(const XcdBarrier& b) {
    asm volatile("s_waitcnt vmcnt(0)" ::: "memory");
    __syncthreads();
    if (threadIdx.x == 0) {
        unsigned* bar = b.bar;
        __builtin_amdgcn_s_waitcnt(0);
        unsigned nloc = b.st[0], nx = b.st[1];
        if (nloc == 0u) { xcd_barrier_complete(bar, b.x, nloc, nx); b.st[0] = nloc; b.st[1] = nx; }
        const unsigned old = xb_add(&bar[XB_XSUB(b.x)], 1u);
        const unsigned gen = old / nloc;
        if (old + 1u == (gen + 1u) * nloc) {
            __builtin_amdgcn_fence(__ATOMIC_RELEASE, "agent");
            asm volatile("s_waitcnt vmcnt(0)" ::: "memory");
            const unsigned og = xb_add(&bar[XB_TOP], 1u);
            const unsigned tg = og / nx;
            if (og + 1u == (tg + 1u) * nx) xb_add(&bar[XB_TOPGEN], 1u);
            else XB_SPIN(xb_ld(&bar[XB_TOPGEN]) == tg, bar);
            __builtin_amdgcn_fence(__ATOMIC_ACQUIRE, "agent");
            xb_add(&bar[XB_XGEN(b.x)], 1u);
            asm volatile("s_waitcnt vmcnt(0)" ::: "memory");
        } else {
            XB_SPIN(xb_ld(&bar[XB_XGEN(b.x)]) == gen, bar);
            __builtin_amdgcn_fence(__ATOMIC_ACQUIRE, "agent");
            asm volatile("s_waitcnt vmcnt(0)" ::: "memory");
        }
    }
    __syncthreads();
}

typedef __bf16 cvtbf2_t __attribute__((ext_vector_type(2)));
__device__ __forceinline__ unsigned cvt_pk_bf16(float lo, float hi) { const cvtbf2_t v = __builtin_convertvector((f32x2){lo, hi}, cvtbf2_t); return __builtin_bit_cast(unsigned, v); }
__device__ __forceinline__ float bf_lo(unsigned u) { return __uint_as_float(u << 16); }
__device__ __forceinline__ float bf_hi(unsigned u) { return __uint_as_float(u & 0xffff0000u); }
__device__ __forceinline__ float bf2f(bf16_t b) { return __uint_as_float(((unsigned)b) << 16); }
__device__ __forceinline__ u32x4 pack8(const float (&v)[8]) { u32x4 w; w.x = cvt_pk_bf16(v[0], v[1]); w.y = cvt_pk_bf16(v[2], v[3]); w.z = cvt_pk_bf16(v[4], v[5]); w.w = cvt_pk_bf16(v[6], v[7]); return w; }
__device__ __forceinline__ void unpack8(const u32x4 w, float (&v)[8]) { v[0] = bf_lo(w.x); v[1] = bf_hi(w.x); v[2] = bf_lo(w.y); v[3] = bf_hi(w.y); v[4] = bf_lo(w.z); v[5] = bf_hi(w.z); v[6] = bf_lo(w.w); v[7] = bf_hi(w.w); }
__device__ __forceinline__ unsigned mono(float v) { const unsigned u = __float_as_uint(v); return (u & 0x80000000u) ? ~u : (u | 0x80000000u); }
__device__ __forceinline__ float unmono(unsigned k) { const unsigned u = (k & 0x80000000u) ? (k & 0x7fffffffu) : ~k; return __uint_as_float(u); }
__device__ __forceinline__ float sigmoidf_(float x) { return __builtin_amdgcn_rcpf(1.0f + __expf(-x)); }
__device__ __forceinline__ float gelu_tanh(float x) { const float u = 0.7978845608028654f * (x + 0.044715f * x * x * x); const float e = __expf(2.0f * u); const float th = 1.0f - 2.0f * __builtin_amdgcn_rcpf(e + 1.0f); return 0.5f * x * (1.0f + th); }
__device__ __forceinline__ int mbcnt64(u64 m) { return (int)__builtin_amdgcn_mbcnt_hi((unsigned)(m >> 32), __builtin_amdgcn_mbcnt_lo((unsigned)m, 0u)); }
__device__ __forceinline__ float wave_sum(float v) {
#pragma unroll
    for (int o = 32; o > 0; o >>= 1) v += __shfl_xor(v, o);
    return v;
}
__device__ __forceinline__ float wave_max(float v) {
#pragma unroll
    for (int o = 32; o > 0; o >>= 1) v = fmaxf(v, __shfl_xor(v, o));
    return v;
}

namespace pg8 {
constexpr int BM = 256, BK = 64, HALF = 128, HTB = HALF * BK * 2, STAGE_BYTES = 8 * HTB, NXCD = 8, WGM = 8;
__host__ __device__ __forceinline__ int lds_byte(int r, int c) { const int st = (r >> 4) * 2 + (c >> 5), rr = r & 15, cc = c & 31, ob = rr * 64 + cc * 2; return st * 1024 + (ob ^ (((ob >> 9) & 1) << 5)); }
__host__ __device__ __forceinline__ void stage_rc(int b, int& R, int& C) { const int st = b / 1024, sb = b % 1024, swz = sb ^ (((sb >> 9) & 1) << 5); R = (st >> 1) * 16 + swz / 64; C = (st & 1) * 32 + (swz % 64) / 2; }
__host__ __device__ __forceinline__ int perm32(int rho) { const int n = rho >> 4, i = rho & 15; return 8 * (i >> 2) + 4 * n + (i & 3); }

struct Unit { int pm, pn; };
struct Gemm { const bf16_t* A; const bf16_t* Bt; int M, N, K, lda, ldb, a_pn_cols; const bf16_t* A2 = nullptr; const bf16_t* Bt2 = nullptr; };

struct StaticOrder {
    int nM, nN, nwg, G, c;
    __host__ __device__ void init(int M, int N, int G_, int c_) { nM = M / BM; nN = N / BM; nwg = nM * nN; G = G_; c = c_; }
    __host__ __device__ bool next(int i, Unit& u) const {
        const long L = (long)i * G + c; if (L >= nwg) return false;
        int wgid = (int)L; { const int q = nwg / NXCD, r = nwg % NXCD, xcd = wgid % NXCD, off = wgid / NXCD; wgid = (xcd < r ? xcd * (q + 1) : r * (q + 1) + (xcd - r) * q) + off; }
        const int nig = WGM * nN, gid = wgid / nig, fm = gid * WGM, gsz = (nM - fm) < WGM ? (nM - fm) : WGM;
        u.pm = fm + ((wgid % nig) % gsz); u.pn = (wgid % nig) / gsz; return true;
    }
    __device__ __forceinline__ void a_ready(const Unit&) const {}
    __device__ __forceinline__ void done(const Unit&) const {}
};

template <class Epi, class Sched, bool ALIGN_EPI = true, bool SP2 = true, bool DUAL = false>
__device__ __forceinline__ void gemm_phase(LAS unsigned char* lds, const Gemm g, const Sched& S, const Epi& E) {
    const int tid = threadIdx.x, wid = __builtin_amdgcn_readfirstlane(tid >> 6), lane = tid & 63, wr = wid >> 2, wc = wid & 3, fr = lane & 15, fq = lane >> 4;
    const int K = g.K, nt = K / BK;
    unsigned voffA[2], voffB[2];
#pragma unroll
    for (int i = 0; i < 2; ++i) { int R, C; stage_rc(tid * 16 + i * 8192, R, C); const int Rb = Epi::PERM ? ((R & ~31) + perm32(R & 31)) : R;
        voffA[i] = (unsigned)(R * g.lda + C) * 2u; voffB[i] = (unsigned)(Rb * g.ldb + C) * 2u; }
    const size_t kstep = (size_t)(BK * 2);
    const int nh = nt / 2;
    const long dA = DUAL ? ((const char*)g.A2 - (const char*)g.A) - (long)nh * (long)kstep : 0, dB = DUAL ? ((const char*)g.Bt2 - (const char*)g.Bt) - (long)nh * (long)kstep : 0;
    const size_t hstepA = (size_t)HALF * g.lda * 2, hstepB = (size_t)HALF * g.ldb * 2;
    const size_t tstepA = 2 * hstepA, tstepB = 2 * hstepB;
    const size_t pnstepA = (size_t)g.a_pn_cols * 2;
    const unsigned ldsw = (unsigned)wid * 1024u;
    const int aoff = lds_byte(wr * 64 + fr, fq * 8), boff = lds_byte(wc * 32 + fr, fq * 8);
#define PG8_SA(b, h) (((b) * 2 + (h)) * HTB)
#define PG8_SB(b, h) ((4 + (b) * 2 + (h)) * HTB)
#define PG8_STAGE(bufoff, gbase, voff) do { _Pragma("unroll") for (int _i = 0; _i < 2; ++_i) \
        __builtin_amdgcn_global_load_lds((const unsigned*)((const char*)(gbase) + (voff)[_i]), (LAS unsigned*)(lds + (bufoff) + ldsw + _i * 8192), 16, 0, 0); } while (0)
#define PG8_LDA(dst, b, h) do { _Pragma("unroll") for (int m = 0; m < 4; ++m) _Pragma("unroll") for (int k = 0; k < 2; ++k) dst[m][k] = *(const LAS bf16x8*)(lds + PG8_SA(b, h) + aoff + m * 2048 + k * 1024); } while (0)
#define PG8_LDB(dst, b, h) do { _Pragma("unroll") for (int n = 0; n < 2; ++n) _Pragma("unroll") for (int k = 0; k < 2; ++k) dst[n][k] = *(const LAS bf16x8*)(lds + PG8_SB(b, h) + boff + n * 2048 + k * 1024); } while (0)
#define PG8_MMA(ai, bj, At, Bt) do { __builtin_amdgcn_s_setprio(1); _Pragma("unroll") for (int m = 0; m < 4; ++m) _Pragma("unroll") for (int n = 0; n < 2; ++n) _Pragma("unroll") for (int k = 0; k < 2; ++k) \
        acc[ai][bj][m][n] = __builtin_amdgcn_mfma_f32_16x16x32_bf16(Bt[n][k], At[m][k], acc[ai][bj][m][n], 0, 0, 0); __builtin_amdgcn_s_setprio(0); } while (0)
#define PG8_WAIT_V(n) asm volatile("s_waitcnt vmcnt(" #n ")" ::: "memory")
#define PG8_WAIT_L(n) asm volatile("s_waitcnt lgkmcnt(" #n ")" ::: "memory")
#define PG8_BAR __builtin_amdgcn_s_barrier()
#define PG8_SCHED __builtin_amdgcn_sched_barrier(0)
#define PG8_UA(u_) ((const char*)g.A + (size_t)(u_).pm * tstepA + (size_t)(u_).pn * pnstepA)
#define PG8_UB(u_) ((const char*)g.Bt + (size_t)(u_).pn * tstepB)
    Unit cur, nxt; int ui = 0;
    if (!S.next(0, cur)) return;
    f32x4 acc[2][2][4][2];
#pragma unroll
    for (int a = 0; a < 2; ++a)
#pragma unroll
        for (int b = 0; b < 2; ++b)
#pragma unroll
            for (int m = 0; m < 4; ++m)
#pragma unroll
                for (int n = 0; n < 2; ++n) acc[a][b][m][n] = (f32x4){0.f, 0.f, 0.f, 0.f};
    bf16x8 At[4][2], B0[2][2], B1[2][2];
    const char* cA = PG8_UA(cur); const char* cB = PG8_UB(cur);
    S.a_ready(cur);
    if constexpr (SP2) {
        PG8_STAGE(PG8_SB(0, 0), cB, voffB); PG8_STAGE(PG8_SB(0, 1), cB + hstepB, voffB); PG8_STAGE(PG8_SA(0, 0), cA, voffA); PG8_STAGE(PG8_SA(0, 1), cA + hstepA, voffA);
        if (wr == 1) PG8_BAR;
        PG8_WAIT_V(2); PG8_BAR;
        PG8_STAGE(PG8_SB(1, 0), cB + kstep, voffB); PG8_STAGE(PG8_SA(1, 0), cA + kstep, voffA); PG8_STAGE(PG8_SB(1, 1), cB + hstepB + kstep, voffB);
        PG8_WAIT_V(6); PG8_BAR;
    } else {
        PG8_STAGE(PG8_SB(0, 0), cB, voffB); PG8_STAGE(PG8_SA(0, 0), cA, voffA); PG8_STAGE(PG8_SB(0, 1), cB + hstepB, voffB); PG8_STAGE(PG8_SA(0, 1), cA + hstepA, voffA);
        if (wr == 1) PG8_BAR;
        PG8_WAIT_V(4); PG8_BAR;
        PG8_STAGE(PG8_SB(1, 0), cB + kstep, voffB); PG8_STAGE(PG8_SA(1, 0), cA + kstep, voffA); PG8_STAGE(PG8_SB(1, 1), cB + hstepB + kstep, voffB);
        PG8_WAIT_V(6); PG8_BAR;
    }
    for (;;) {
        const bool has_next = S.next(ui + 1, nxt);
        const char* nA = has_next ? PG8_UA(nxt) : cA; const char* nB = has_next ? PG8_UB(nxt) : cB;
        for (int t = 0; t < nt; t += 2) {
            const bool last = (t == nt - 2);
            const char* a1 = cA + (size_t)(t + 1) * kstep;
            const char* a2 = last ? nA : cA + (size_t)(t + 2) * kstep; const char* b2 = last ? nB : cB + (size_t)(t + 2) * kstep;
            if constexpr (DUAL) {
                if (t >= nh) a1 += dA;
                if (!last && t + 2 >= nh) { a2 += dA; b2 += dB; }
                if (t == nh) E.mid(acc, cur, wr, wc, fr, fq);
            }
            const char* a3 = a2 + kstep; const char* b3 = b2 + kstep;
            if (last && has_next) S.a_ready(nxt);
            if constexpr (SP2) {
            PG8_LDB(B0, 0, 0); PG8_LDB(B1, 0, 1); PG8_SCHED; PG8_LDA(At, 0, 0); PG8_STAGE(PG8_SA(1, 1), a1 + hstepA, voffA);
            PG8_WAIT_V(8); PG8_WAIT_L(0); PG8_BAR; PG8_MMA(0, 0, At, B0); PG8_MMA(0, 1, At, B1); PG8_BAR; PG8_SCHED;
            PG8_LDA(At, 0, 1); PG8_STAGE(PG8_SB(0, 0), b2, voffB); PG8_STAGE(PG8_SB(0, 1), b2 + hstepB, voffB); PG8_STAGE(PG8_SA(0, 0), a2, voffA);
            PG8_WAIT_V(8); PG8_WAIT_L(0); PG8_BAR; PG8_MMA(1, 0, At, B0); PG8_MMA(1, 1, At, B1); PG8_BAR; PG8_SCHED;
            PG8_LDB(B0, 1, 0); PG8_LDB(B1, 1, 1); PG8_SCHED; PG8_LDA(At, 1, 0); PG8_STAGE(PG8_SA(0, 1), a2 + hstepA, voffA);
            PG8_WAIT_V(8); PG8_WAIT_L(0); PG8_BAR; PG8_MMA(0, 0, At, B0); PG8_MMA(0, 1, At, B1); PG8_BAR; PG8_SCHED;
            PG8_LDA(At, 1, 1); PG8_STAGE(PG8_SB(1, 0), b3, voffB); PG8_STAGE(PG8_SB(1, 1), b3 + hstepB, voffB); PG8_STAGE(PG8_SA(1, 0), a3, voffA);
            PG8_WAIT_V(8); PG8_WAIT_L(0); PG8_BAR; PG8_MMA(1, 0, At, B0); PG8_MMA(1, 1, At, B1); PG8_BAR; PG8_SCHED;
            } else {
            PG8_LDB(B0, 0, 0); PG8_SCHED; PG8_LDA(At, 0, 0); PG8_STAGE(PG8_SA(1, 1), a1 + hstepA, voffA);
            PG8_WAIT_L(8); PG8_BAR; PG8_WAIT_L(0); PG8_MMA(0, 0, At, B0); PG8_BAR; PG8_SCHED;
            PG8_LDB(B1, 0, 1); PG8_STAGE(PG8_SB(0, 0), b2, voffB);
            PG8_BAR; PG8_WAIT_L(0); PG8_MMA(0, 1, At, B1); PG8_BAR;
            PG8_LDA(At, 0, 1); PG8_STAGE(PG8_SA(0, 0), a2, voffA);
            PG8_BAR; PG8_WAIT_L(0); PG8_MMA(1, 0, At, B0); PG8_BAR; PG8_SCHED;
            PG8_STAGE(PG8_SB(0, 1), b2 + hstepB, voffB);
            PG8_WAIT_V(6); PG8_BAR; PG8_MMA(1, 1, At, B1); PG8_BAR;
            PG8_LDB(B0, 1, 0); PG8_SCHED; PG8_LDA(At, 1, 0); PG8_STAGE(PG8_SA(0, 1), a2 + hstepA, voffA);
            PG8_WAIT_L(8); PG8_BAR; PG8_WAIT_L(0); PG8_MMA(0, 0, At, B0); PG8_BAR; PG8_SCHED;
            PG8_LDB(B1, 1, 1); PG8_STAGE(PG8_SB(1, 0), b3, voffB);
            PG8_BAR; PG8_WAIT_L(0); PG8_MMA(0, 1, At, B1); PG8_BAR;
            PG8_LDA(At, 1, 1); PG8_STAGE(PG8_SA(1, 0), a3, voffA);
            PG8_BAR; PG8_WAIT_L(0); PG8_MMA(1, 0, At, B0); PG8_BAR; PG8_SCHED;
            PG8_STAGE(PG8_SB(1, 1), b3 + hstepB, voffB);
            PG8_WAIT_V(6); PG8_BAR; PG8_MMA(1, 1, At, B1); PG8_BAR;
            }
        }
        if constexpr (ALIGN_EPI) { if (wr == 0) PG8_BAR; }
        E(acc, cur, wr, wc, fr, fq); S.done(cur);
        if (!has_next) break;
#pragma unroll
        for (int a = 0; a < 2; ++a)
#pragma unroll
            for (int b = 0; b < 2; ++b)
#pragma unroll
                for (int m = 0; m < 4; ++m)
#pragma unroll
                    for (int n = 0; n < 2; ++n) acc[a][b][m][n] = (f32x4){0.f, 0.f, 0.f, 0.f};
        cur = nxt; cA = nA; cB = nB; ++ui;
        if constexpr (ALIGN_EPI) { if (wr == 1) PG8_BAR; }
    }
    PG8_WAIT_V(0);
    if constexpr (!ALIGN_EPI) { if (wr == 0) PG8_BAR; }
    PG8_BAR;
#undef PG8_UA
#undef PG8_UB
#undef PG8_SA
#undef PG8_SB
#undef PG8_STAGE
#undef PG8_LDA
#undef PG8_LDB
#undef PG8_MMA
#undef PG8_WAIT_V
#undef PG8_WAIT_L
#undef PG8_BAR
#undef PG8_SCHED
}
}
using pg8::Unit;

__device__ __forceinline__ int mod_row(int r) { return r < TP ? (r >> 11) : NB + ((r - TP) >> 2); }
__device__ __forceinline__ int pos_idx(int r) { return r < TP ? (r & 2047) : 2048 + ((r - TP) & 3); }

struct EpiF32Bias {
    static constexpr bool PERM = false;
    float* C; int ldc; const float* bias;
    __device__ __forceinline__ void operator()(const f32x4 (&acc)[2][2][4][2], const Unit& u, int wr, int wc, int fr, int fq) const {
        const int row0 = u.pm * 256 + wr * 64 + fr, col0 = u.pn * 256 + wc * 32 + 4 * fq;
#pragma unroll
        for (int ai = 0; ai < 2; ++ai)
#pragma unroll
            for (int m = 0; m < 4; ++m) { float* rowp = C + (size_t)(row0 + ai * 128 + m * 16) * ldc + col0;
#pragma unroll
                for (int bj = 0; bj < 2; ++bj)
#pragma unroll
                    for (int n = 0; n < 2; ++n) { const f32x4 bv = *(const f32x4*)(bias + col0 + bj * 128 + n * 16); *(f32x4*)(rowp + bj * 128 + n * 16) = acc[ai][bj][m][n] + bv; } }
    }
};

struct EpiBf16Plain {
    static constexpr bool PERM = true;
    bf16_t* O; int ldc;
    __device__ __forceinline__ void operator()(const f32x4 (&acc)[2][2][4][2], const Unit& u, int wr, int wc, int fr, int fq) const {
        const int row0 = u.pm * 256 + wr * 64 + fr, col0 = u.pn * 256 + wc * 32 + 8 * fq;
#pragma unroll
        for (int ai = 0; ai < 2; ++ai)
#pragma unroll
            for (int m = 0; m < 4; ++m) { bf16_t* rowp = O + (size_t)(row0 + ai * 128 + m * 16) * ldc + col0;
#pragma unroll
                for (int bj = 0; bj < 2; ++bj) { const f32x4 v0 = acc[ai][bj][m][0], v1 = acc[ai][bj][m][1];
                    u32x4 w; w.x = cvt_pk_bf16(v0[0], v0[1]); w.y = cvt_pk_bf16(v0[2], v0[3]); w.z = cvt_pk_bf16(v1[0], v1[1]); w.w = cvt_pk_bf16(v1[2], v1[3]);
                    *(u32x4*)(rowp + bj * 128) = w; } }
    }
};

struct EpiInProj {
    static constexpr bool PERM = true;
    bf16_t *U, *BG, *Q, *K, *V, *QI, *KI, *SGA, *SGB; float* WI; const float *qnw, *knw; const f32x2* rope; float* out;
    __device__ __forceinline__ void rope_rows(const f32x4 (&acc)[2][2][4][2], int ai, int m, int r, int fq, const float* nw, float (&o1)[8], float (&o2)[8]) const {
        float x1[8], x2[8];
#pragma unroll
        for (int n = 0; n < 2; ++n)
#pragma unroll
            for (int j = 0; j < 4; ++j) { x1[n * 4 + j] = acc[ai][0][m][n][j]; x2[n * 4 + j] = acc[ai][1][m][n][j]; }
        const int i0 = fq * 8;
        if (nw) {
            float ss = 0.f;
#pragma unroll
            for (int e = 0; e < 8; ++e) ss += x1[e] * x1[e] + x2[e] * x2[e];
            ss += __shfl_xor(ss, 16); ss += __shfl_xor(ss, 32);
            const float rstd = rsqrtf(ss * (1.0f / 64.0f) + NORM_EPS);
#pragma unroll
            for (int e = 0; e < 8; ++e) { x1[e] = x1[e] * rstd * nw[i0 + e]; x2[e] = x2[e] * rstd * nw[32 + i0 + e]; }
        }
        const f32x2* rp = rope + (size_t)pos_idx(r) * 32 + i0;
#pragma unroll
        for (int e = 0; e < 8; ++e) { const f32x2 cs = rp[e]; o1[e] = x1[e] * cs.x - x2[e] * cs.y; o2[e] = x2[e] * cs.x + x1[e] * cs.y; }
    }
    __device__ __forceinline__ void operator()(const f32x4 (&acc)[2][2][4][2], const Unit& u, int wr, int wc, int fr, int fq) const {
        const int pn = u.pn;
        const bool smp = u.pm >= 256;
#pragma unroll
        for (int ai = 0; ai < 2; ++ai)
#pragma unroll
            for (int m = 0; m < 4; ++m) {
                const int r = u.pm * 256 + ai * 128 + wr * 64 + m * 16 + fr;
                const int rs = r - TP;
                if (pn < 4) {
                    float uv[8];
#pragma unroll
                    for (int n = 0; n < 2; ++n)
#pragma unroll
                        for (int j = 0; j < 4; ++j) uv[n * 4 + j] = acc[ai][0][m][n][j] * acc[ai][1][m][n][j];
                    const int c0 = pn * 128 + wc * 32 + fq * 8;
                    *(u32x4*)(U + (size_t)r * 512 + c0) = pack8(uv);
                    float* cp = nullptr;
                    if (!smp) { const int t = r & 2047; if (t >= 2046) cp = out + OFF_CONVP + ((size_t)(r >> 11) * 2 + (t - 2046)) * 512 + c0; }
                    else { const int j4 = rs & 3; if (j4 >= 2) cp = out + OFF_CONVS + ((size_t)(rs >> 2) * 2 + (j4 - 2)) * 512 + c0; }
                    if (cp) { *(f32x4*)cp = (f32x4){uv[0], uv[1], uv[2], uv[3]}; *(f32x4*)(cp + 4) = (f32x4){uv[4], uv[5], uv[6], uv[7]}; }
                } else if (pn < 6) {
#pragma unroll
                    for (int bj = 0; bj < 2; ++bj) { float v[8];
#pragma unroll
                        for (int n = 0; n < 2; ++n)
#pragma unroll
                            for (int j = 0; j < 4; ++j) v[n * 4 + j] = acc[ai][bj][m][n][j];
                        *(u32x4*)(BG + (size_t)r * 512 + (pn - 4) * 256 + bj * 128 + wc * 32 + fq * 8) = pack8(v); }
                } else if (pn < 8) {
                    float o1[8], o2[8]; rope_rows(acc, ai, m, r, fq, qnw, o1, o2);
                    bf16_t* p = Q + (size_t)r * 512 + ((pn - 6) * 4 + wc) * 64 + fq * 8;
                    *(u32x4*)p = pack8(o1); *(u32x4*)(p + 32) = pack8(o2);
                } else if (pn == 8) {
                    float o1[8], o2[8];
                    const int hd = wc & 1;
                    if (wc < 2) rope_rows(acc, ai, m, r, fq, knw, o1, o2);
                    else {
#pragma unroll
                        for (int n = 0; n < 2; ++n)
#pragma unroll
                            for (int j = 0; j < 4; ++j) { o1[n * 4 + j] = acc[ai][0][m][n][j]; o2[n * 4 + j] = acc[ai][1][m][n][j]; }
                    }
                    bf16_t* p = (wc < 2 ? K : V) + (size_t)r * 128 + hd * 64 + fq * 8;
                    *(u32x4*)p = pack8(o1); *(u32x4*)(p + 32) = pack8(o2);
                    float* op = out + (smp ? (wc < 2 ? OFF_KS : OFF_VS) + (size_t)rs * 128 : (wc < 2 ? OFF_KP : OFF_VP) + (size_t)r * 128) + hd * 64 + fq * 8;
                    *(f32x4*)op = (f32x4){o1[0], o1[1], o1[2], o1[3]}; *(f32x4*)(op + 4) = (f32x4){o1[4], o1[5], o1[6], o1[7]};
                    *(f32x4*)(op + 32) = (f32x4){o2[0], o2[1], o2[2], o2[3]}; *(f32x4*)(op + 36) = (f32x4){o2[4], o2[5], o2[6], o2[7]};
                } else if (pn < 11) {
                    float o1[8], o2[8]; rope_rows(acc, ai, m, r, fq, nullptr, o1, o2);
                    bf16_t* p = QI + (size_t)r * 512 + ((pn - 9) * 4 + wc) * 64 + fq * 8;
                    *(u32x4*)p = pack8(o1); *(u32x4*)(p + 32) = pack8(o2);
                } else if (pn == 11) {
                    if (wc == 0) {
                        float o1[8], o2[8]; rope_rows(acc, ai, m, r, fq, nullptr, o1, o2);
                        bf16_t* p = KI + (size_t)r * 64 + fq * 8;
                        *(u32x4*)p = pack8(o1); *(u32x4*)(p + 32) = pack8(o2);
                        float* op = out + (smp ? OFF_KIS + (size_t)rs * 64 : OFF_KIP + (size_t)r * 64) + fq * 8;
                        *(f32x4*)op = (f32x4){o1[0], o1[1], o1[2], o1[3]}; *(f32x4*)(op + 4) = (f32x4){o1[4], o1[5], o1[6], o1[7]};
                        *(f32x4*)(op + 32) = (f32x4){o2[0], o2[1], o2[2], o2[3]}; *(f32x4*)(op + 36) = (f32x4){o2[4], o2[5], o2[6], o2[7]};
                    } else if (wc == 1 && fq == 0) {
                        float* wp = WI + (size_t)r * 8;
                        *(f32x4*)wp = acc[ai][0][m][0] * IDX_SCALE; *(f32x4*)(wp + 4) = acc[ai][0][m][1] * IDX_SCALE;
                    }
                } else {
                    bf16_t* base = pn < 16 ? SGA : SGB; const int pc = pn < 16 ? pn - 12 : pn - 16;
#pragma unroll
                    for (int bj = 0; bj < 2; ++bj) { float v[8];
#pragma unroll
                        for (int n = 0; n < 2; ++n)
#pragma unroll
                            for (int j = 0; j < 4; ++j) v[n * 4 + j] = sigmoidf_(acc[ai][bj][m][n][j]);
                        *(u32x4*)(base + (size_t)r * 1024 + pc * 256 + bj * 128 + wc * 32 + fq * 8) = pack8(v); }
                }
            }
    }
};
__host__ __device__ __forceinline__ int win_src_col(int j) {
    const int pn = j >> 8, tc = j & 255, bj = tc >> 7, wc = (tc >> 5) & 3, i = tc & 31;
    if (pn < 4) return (bj ? 1024 : 0) + pn * 128 + (tc & 127);
    if (pn < 6) return 512 + (pn - 4) * 256 + tc;
    if (pn < 8) return 1536 + ((pn - 6) * 4 + wc) * 64 + bj * 32 + i;
    if (pn == 8) return wc < 2 ? 2048 + wc * 64 + bj * 32 + i : 2176 + (wc - 2) * 64 + bj * 32 + i;
    if (pn < 11) return 2304 + ((pn - 9) * 4 + wc) * 64 + bj * 32 + i;
    if (pn == 11) { if (wc == 0) return 2816 + bj * 32 + i; if (wc == 1 && bj == 0 && i < 8) return 2880 + i; return -1; }
    if (pn < 16) return 2888 + (pn - 12) * 256 + tc;
    return 3912 + (pn - 16) * 256 + tc;
}

template <int MODE> struct EpiMix {
    static constexpr bool PERM = true;
    const bf16_t* SG; bf16_t* MIX;
    __device__ __forceinline__ void operator()(const f32x4 (&acc)[2][2][4][2], const Unit& u, int wr, int wc, int fr, int fq) const {
        const int row0 = u.pm * 256 + wr * 64 + fr, col0 = u.pn * 256 + wc * 32 + 8 * fq;
#pragma unroll
        for (int ai = 0; ai < 2; ++ai)
#pragma unroll
            for (int m = 0; m < 4; ++m) { const size_t ro = (size_t)(row0 + ai * 128 + m * 16) * 1024 + col0;
#pragma unroll
                for (int bj = 0; bj < 2; ++bj) {
                    float g[8], v[8]; unpack8(*(const u32x4*)(SG + ro + bj * 128), g);
#pragma unroll
                    for (int n = 0; n < 2; ++n)
#pragma unroll
                        for (int j = 0; j < 4; ++j) v[n * 4 + j] = g[n * 4 + j] * acc[ai][bj][m][n][j];
                    if (MODE == 1) { float pv[8]; unpack8(*(const u32x4*)(MIX + ro + bj * 128), pv);
#pragma unroll
                        for (int e = 0; e < 8; ++e) v[e] += pv[e]; }
                    *(u32x4*)(MIX + ro + bj * 128) = pack8(v); } }
    }
};

struct EpiMixFused {
    static constexpr bool PERM = true;
    const bf16_t* SGA; const bf16_t* SGB; bf16_t* MIX;
    __device__ __forceinline__ void mid(f32x4 (&acc)[2][2][4][2], const Unit& u, int wr, int wc, int fr, int fq) const {
        unsigned o0 = ((unsigned)(u.pm * 256 + wr * 64 + fr) * 1024u + (unsigned)(u.pn * 256 + wc * 32 + 8 * fq)) * 2u;
        asm volatile("" : "+v"(o0));
#pragma unroll
        for (int ai = 0; ai < 2; ++ai)
#pragma unroll
            for (int m = 0; m < 4; ++m) { const unsigned ro = o0 + (unsigned)(ai * 128 + m * 16) * 2048u;
#pragma unroll
                for (int bj = 0; bj < 2; ++bj) {
                    float ga[8], gb[8]; unpack8(*(const u32x4*)((const char*)SGA + ro + bj * 256), ga); unpack8(*(const u32x4*)((const char*)SGB + ro + bj * 256), gb);
#pragma unroll
                    for (int n = 0; n < 2; ++n)
#pragma unroll
                        for (int j = 0; j < 4; ++j) acc[ai][bj][m][n][j] *= ga[n * 4 + j] * __builtin_amdgcn_rcpf(fmaxf(gb[n * 4 + j], 1e-20f)); }
                if (m & 1) __builtin_amdgcn_sched_barrier(0); }
    }
    __device__ __forceinline__ void operator()(const f32x4 (&acc)[2][2][4][2], const Unit& u, int wr, int wc, int fr, int fq) const {
        unsigned o0 = ((unsigned)(u.pm * 256 + wr * 64 + fr) * 1024u + (unsigned)(u.pn * 256 + wc * 32 + 8 * fq)) * 2u;
        asm volatile("" : "+v"(o0));
#pragma unroll
        for (int ai = 0; ai < 2; ++ai)
#pragma unroll
            for (int m = 0; m < 4; ++m) { const unsigned ro = o0 + (unsigned)(ai * 128 + m * 16) * 2048u;
#pragma unroll
                for (int bj = 0; bj < 2; ++bj) {
                    float gb[8], v[8]; unpack8(*(const u32x4*)((const char*)SGB + ro + bj * 256), gb);
#pragma unroll
                    for (int n = 0; n < 2; ++n)
#pragma unroll
                        for (int j = 0; j < 4; ++j) v[n * 4 + j] = fmaxf(gb[n * 4 + j], 1e-20f) * acc[ai][bj][m][n][j];
                    *(u32x4*)((char*)MIX + ro + bj * 256) = pack8(v); } }
    }
};

struct EpiOut {
    static constexpr bool PERM = true;
    const float* MOD; bf16_t* Dm;
    __device__ __forceinline__ void operator()(const f32x4 (&acc)[2][2][4][2], const Unit& u, int wr, int wc, int fr, int fq) const {
        const int col0 = u.pn * 256 + wc * 32 + 8 * fq;
#pragma unroll
        for (int ai = 0; ai < 2; ++ai)
#pragma unroll
            for (int m = 0; m < 4; ++m) {
                const int r = u.pm * 256 + ai * 128 + wr * 64 + m * 16 + fr;
                const float* gr = MOD + (size_t)mod_row(r) * NMOD + 2048;
#pragma unroll
                for (int bj = 0; bj < 2; ++bj) { const int c = col0 + bj * 128;
                    const f32x4 g0 = *(const f32x4*)(gr + c), g1 = *(const f32x4*)(gr + c + 4); float v[8];
#pragma unroll
                    for (int j = 0; j < 4; ++j) { v[j] = g0[j] * acc[ai][bj][m][0][j]; v[4 + j] = g1[j] * acc[ai][bj][m][1][j]; }
                    *(u32x4*)(Dm + (size_t)r * 1024 + c) = pack8(v); } }
    }
};

typedef _Float16 h2_t __attribute__((ext_vector_type(2)));
__device__ __forceinline__ unsigned cvt_pk_f16(float lo, float hi) { const h2_t v = __builtin_convertvector((f32x2){lo, hi}, h2_t); return __builtin_bit_cast(unsigned, v); }
struct EpiPST {
    static constexpr bool PERM = true;
    unsigned short* PST;
    __device__ __forceinline__ void operator()(const f32x4 (&acc)[2][2][4][2], const Unit& u, int wr, int wc, int fr, int fq) const {
        unsigned short* base = PST + (size_t)(u.pm * 8 + u.pn) * 65536 + wc * 32 + 8 * fq;
#pragma unroll
        for (int ai = 0; ai < 2; ++ai)
#pragma unroll
            for (int m = 0; m < 4; ++m) { const int rl = ai * 128 + wr * 64 + m * 16 + fr;
#pragma unroll
                for (int bj = 0; bj < 2; ++bj) { const f32x4 v0 = acc[ai][bj][m][0], v1 = acc[ai][bj][m][1];
                    u32x4 w; w.x = cvt_pk_f16(v0[0], v0[1]); w.y = cvt_pk_f16(v0[2], v0[3]); w.z = cvt_pk_f16(v1[0], v1[1]); w.w = cvt_pk_f16(v1[2], v1[3]);
                    *(u32x4*)(base + (size_t)rl * 256 + bj * 128) = w; } }
    }
};

struct Params { const float* in[24]; float* out; unsigned char* ws; int ph_lo, ph_hi, rep_mask, pad; };
struct Frame {
    LAS unsigned char* lds; int tid, lane, wave, bid, nblk; unsigned* ctl; unsigned char* ws; float* out;
    const float *x_prompt, *x_sample, *cache_k, *cache_v, *cache_kidx, *state_conv; const int* page_table; const float *c_prompt, *c_sample, *w_ada, *b_ada, *norm1_w, *w_in, *conv_w, *q_norm_w, *k_norm_w,
        *w_conv_out, *w_attn_out, *w_out, *norm2_w, *peer_w_q, *peer_sub_keys, *peer_u, *peer_v;
};
#define WSP(type, off) ((type*)(F.ws + (off)))

template <bool DUAL, class Fin, int KQ = 256>
__device__ __forceinline__ void skinny_phase(const Frame& F, const bf16_t* A1, const bf16_t* B1, const bf16_t* A2, const bf16_t* B2, int lda, int ldb, int N, int row_base, int nrt, Fin fin, int a_pn_cols = 0) {
    LAS float* P = (LAS float*)F.lds;
    const int lane = F.lane, q = lane & 31, half = lane >> 5, w = F.wave, rb = w & 1, kq = w >> 1;
    const bf16_t* Asel = (DUAL && kq >= 2) ? A2 : A1; const bf16_t* Bsel = (DUAL && kq >= 2) ? B2 : B1;
    const int k0 = (DUAL ? (kq & 1) : kq) * KQ + half * 8;
    const int ntile = nrt * (N / 32);
    for (int tl = F.bid; tl < ntile; tl += F.nblk) {
        const int rt = tl % nrt, ct = tl / nrt;
        const bf16_t* ap = Asel + (size_t)(row_base + rt * 64 + rb * 32 + q) * lda + k0 + (ct >> 3) * a_pn_cols;
        const bf16_t* bp = Bsel + (size_t)(ct * 32 + q) * ldb + k0;
        f32x16 acc;
#pragma unroll
        for (int i = 0; i < 16; ++i) acc[i] = 0.f;
        constexpr int NS = KQ / 16 < 16 ? KQ / 16 : 16;
#pragma unroll 1
        for (int kb = 0; kb < KQ / 16 / NS; ++kb) {
            u32x4 a[NS], b[NS];
#pragma unroll
            for (int i = 0; i < NS; ++i) { a[i] = *(const u32x4*)(ap + (kb * NS + i) * 16); b[i] = *(const u32x4*)(bp + (kb * NS + i) * 16); }
#pragma unroll
            for (int i = 0; i < NS; ++i) acc = __builtin_amdgcn_mfma_f32_32x32x16_bf16(__builtin_bit_cast(bf16x8, a[i]), __builtin_bit_cast(bf16x8, b[i]), acc, 0, 0, 0);
        }
        __syncthreads();
#pragma unroll
        for (int i = 0; i < 16; ++i) P[(kq * 64 + rb * 32 + 8 * (i >> 2) + 4 * half + (i & 3)) * 33 + q] = acc[i];
        __syncthreads();
        const int r = F.tid >> 3, c4 = (F.tid & 7) * 4;
        float s01[4], s23[4];
#pragma unroll
        for (int j = 0; j < 4; ++j) { s01[j] = P[(0 * 64 + r) * 33 + c4 + j] + P[(1 * 64 + r) * 33 + c4 + j]; s23[j] = P[(2 * 64 + r) * 33 + c4 + j] + P[(3 * 64 + r) * 33 + c4 + j]; }
        fin(row_base + rt * 64 + r, ct * 32 + c4, s01, s23);
    }
    __syncthreads();
}

template <class Map> __device__ __forceinline__ void transpose_cvt(const Frame& F, const float* src, int ld_src, bf16_t* dst, int K, int Nd, Map map) {
    LAS float* tile = (LAS float*)F.lds;
    const int ntk = K / 64, ntn = Nd / 64, ntile = ntk * ntn;
    float v[8];
#define TC_LOAD(tix_) do { const int tn_ = (tix_) / ntk, tk_ = (tix_) % ntk; _Pragma("unroll") for (int i_ = 0; i_ < 8; ++i_) { const int e_ = F.tid + 512 * i_, kk_ = e_ >> 6, nn_ = e_ & 63; \
        const int sc_ = map(tn_ * 64 + nn_); v[i_] = sc_ >= 0 ? src[(size_t)(tk_ * 64 + kk_) * ld_src + sc_] : 0.f; } } while (0)
    int tix = F.bid;
    if (tix < ntile) TC_LOAD(tix);
    for (; tix < ntile; tix += F.nblk) {
        const int tn = tix / ntk, tk = tix % ntk;
#pragma unroll
        for (int i = 0; i < 8; ++i) { const int e = F.tid + 512 * i, kk = e >> 6, nn = e & 63; tile[kk * 65 + nn] = v[i]; }
        __syncthreads();
        if (tix + F.nblk < ntile) TC_LOAD(tix + F.nblk);
#pragma unroll
        for (int i = 0; i < 4; ++i) { const int e = F.tid + 512 * i, nn = e >> 5, kp = e & 31;
            *(unsigned*)(dst + (size_t)(tn * 64 + nn) * K + tk * 64 + 2 * kp) = cvt_pk_bf16(tile[(2 * kp) * 65 + nn], tile[(2 * kp + 1) * 65 + nn]); }
        __syncthreads();
    }
#undef TC_LOAD
}
struct MapId { __device__ __forceinline__ int operator()(int n) const { return n; } };
struct MapWin { __device__ __forceinline__ int operator()(int n) const { return win_src_col(n); } };

__device__ __forceinline__ void p0_convert(const Frame& F) {
    transpose_cvt(F, F.w_in, NPROJ, WSP(bf16_t, WS_WIN), 1024, NPROJ_PAD, MapWin());
    transpose_cvt(F, F.w_conv_out, 1024, WSP(bf16_t, WS_WCO), 512, 1024, MapId());
    transpose_cvt(F, F.w_attn_out, 1024, WSP(bf16_t, WS_WAO), 512, 1024, MapId());
    transpose_cvt(F, F.w_out, 1024, WSP(bf16_t, WS_WOUT), 1024, 1024, MapId());
    transpose_cvt(F, F.peer_w_q, 2048, WSP(bf16_t, WS_WQ), 1024, 2048, MapId());
    transpose_cvt(F, F.w_ada, NMOD, WSP(bf16_t, WS_WADA), 1024, NMOD, MapId());
    const size_t gt = (size_t)F.bid * 512 + F.tid, gn = (size_t)F.nblk * 512;
    { unsigned char* d8 = WSP(unsigned char, WS_UT); float* tsc = WSP(float, WS_TSC);
      for (int row = F.bid * 8 + F.wave; row < 2 * 16384; row += F.nblk * 8) {
          const float* s = (row < 16384 ? F.peer_u : F.peer_v) + (size_t)(row & 16383) * 1024 + F.lane * 16;
          f32x4 v[4]; float am = 0.f;
#pragma unroll
          for (int i = 0; i < 4; ++i) { v[i] = *(const f32x4*)(s + 4 * i); am = fmaxf(am, fmaxf(fmaxf(fabsf(v[i][0]), fabsf(v[i][1])), fmaxf(fabsf(v[i][2]), fabsf(v[i][3])))); }
          am = wave_max(am);
          const float sc = am > 0.f ? 240.0f / am : 1.0f;
          u32x4 w; unsigned ww[4];
#pragma unroll
          for (int i = 0; i < 4; ++i) { int pk = 0; pk = __builtin_amdgcn_cvt_pk_fp8_f32(v[i][0] * sc, v[i][1] * sc, pk, false); pk = __builtin_amdgcn_cvt_pk_fp8_f32(v[i][2] * sc, v[i][3] * sc, pk, true); ww[i] = (unsigned)pk; }
          w.x = ww[0]; w.y = ww[1]; w.z = ww[2]; w.w = ww[3];
          *(u32x4*)(d8 + (size_t)row * 1024 + F.lane * 16) = w;
          if (F.lane == 0) tsc[row] = am > 0.f ? am / 240.0f : 1.0f;
      } }
    { bf16_t* d = WSP(bf16_t, WS_SKBD);
      for (size_t i = gt; i < (size_t)2048 * 256 / 2; i += gn) { const int row = (int)(i >> 7), cp = (int)(i & 127) * 2; const int h = row >> 8, rr = row & 255, p = rr >> 7, key = rr & 127;
          float a = 0.f, b = 0.f; if ((cp >> 7) == p) { const float* s = F.peer_sub_keys + (((size_t)p * 8 + h) * 128 + key) * 128 + (cp & 127); a = s[0]; b = s[1]; }
          *(unsigned*)(d + (size_t)row * 256 + cp) = cvt_pk_bf16(a, b); } }
    { bf16_t* d = WSP(bf16_t, WS_CB);
      for (size_t i = gt; i < (size_t)256 * 1024 / 2; i += gn) { const int row = (int)(i >> 9), cp = (int)(i & 511) * 2; float a = 0.f, b = 0.f;
          if (row < NB) { a = F.c_prompt[row * 1024 + cp]; b = F.c_prompt[row * 1024 + cp + 1]; } else if (row < NB + DB) { a = F.c_sample[(row - NB) * 1024 + cp]; b = F.c_sample[(row - NB) * 1024 + cp + 1]; }
          *(unsigned*)(d + (size_t)row * 1024 + cp) = cvt_pk_bf16(a, b); } }
    { f32x2* d = WSP(f32x2, WS_ROPE);
      for (size_t i = gt; i < (size_t)2052 * 32; i += gn) { const int pi = (int)(i >> 5), fi = (int)(i & 31); const int pos = pi < 2048 ? pi : PAST + (pi - 2048);
          const float fr = powf(10000.0f, -(float)fi / 32.0f); const float ang = (float)pos * fr;
          d[i] = (f32x2){(float)cos((double)ang), (float)sin((double)ang)}; } }
}

template <bool SECOND> __device__ __forceinline__ void row_norm_pass(const Frame& F) {
    const float* MOD = WSP(float, WS_MOD); bf16_t* H = WSP(bf16_t, WS_H);
    const float* nw = SECOND ? F.norm2_w : F.norm1_w;
    const int so = SECOND ? 3 * 1024 : 0;
    for (int r = F.bid * 8 + F.wave; r < T; r += F.nblk * 8) {
        const float* xr = r < TP ? F.x_prompt + (size_t)r * 1024 : F.x_sample + (size_t)(r - TP) * 1024;
        f32x4 v[4]; float ss = 0.f;
#pragma unroll
        for (int i = 0; i < 4; ++i) { v[i] = *(const f32x4*)(xr + i * 256 + F.lane * 4);
            if (SECOND) { const u32x2 dv = *(const u32x2*)(WSP(bf16_t, WS_X1) + (size_t)r * 1024 + i * 256 + F.lane * 4); v[i] += (f32x4){bf_lo(dv.x), bf_hi(dv.x), bf_lo(dv.y), bf_hi(dv.y)}; }
            ss += v[i][0] * v[i][0] + v[i][1] * v[i][1] + v[i][2] * v[i][2] + v[i][3] * v[i][3]; }
        ss = wave_sum(ss);
        const float rstd = rsqrtf(ss * (1.0f / 1024.0f) + NORM_EPS);
        const float* mr = MOD + (size_t)mod_row(r) * NMOD + so;
#pragma unroll
        for (int i = 0; i < 4; ++i) { const int c = i * 256 + F.lane * 4;
            const f32x4 w = *(const f32x4*)(nw + c), sh = *(const f32x4*)(mr + c), sc = *(const f32x4*)(mr + 1024 + c);
            const f32x4 y = v[i] * rstd * w * (sc + 1.0f) + sh;
            u32x2 o; o.x = cvt_pk_bf16(y[0], y[1]); o.y = cvt_pk_bf16(y[2], y[3]);
            *(u32x2*)(H + (size_t)r * 1024 + c) = o; }
    }
}

__device__ __forceinline__ void p4_vtranspose(const Frame& F) {
    const bf16_t* V = WSP(bf16_t, WS_V); bf16_t* VTR = WSP(bf16_t, WS_VTR);
    LAS bf16_t* tile = (LAS bf16_t*)F.lds;
    for (int tix = F.bid; tix < NB * 2 * 32; tix += F.nblk) {
        const int b = tix >> 6, kvh = (tix >> 5) & 1, tt = tix & 31;
        { const int trow = F.tid >> 3, dc = F.tid & 7;
          const u32x4 w = *(const u32x4*)(V + ((size_t)(b * 2048 + tt * 64 + trow)) * 128 + kvh * 64 + dc * 8);
          const unsigned ww[4] = {w.x, w.y, w.z, w.w};
#pragma unroll
          for (int e = 0; e < 8; ++e) tile[(dc * 8 + e) * 72 + trow] = (bf16_t)((ww[e >> 1] >> ((e & 1) * 16)) & 0xffffu); }
        __syncthreads();
        { const int d = F.tid >> 3, tc = F.tid & 7;
          const u32x4 w = *(const LAS u32x4*)(tile + d * 72 + tc * 8);
          *(u32x4*)(VTR + ((size_t)((b * 2 + kvh) * 64 + d)) * 2048 + tt * 64 + tc * 8) = w; }
        __syncthreads();
    }
}
__device__ __forceinline__ void p4_conv(const Frame& F) {
    const bf16_t* U = WSP(bf16_t, WS_U); const bf16_t* BG = WSP(bf16_t, WS_BG); bf16_t* APRE = WSP(bf16_t, WS_APRE);
    const size_t gt = (size_t)F.bid * 512 + F.tid, gn = (size_t)F.nblk * 512;
    for (size_t i = gt; i < (size_t)T * 64; i += gn) {
        const int r = (int)(i >> 6), c0 = (int)(i & 63) * 8;
        float u0[8], u1[8], u2[8], bg[8], w0[8], w1[8], w2[8];
        unpack8(*(const u32x4*)(U + (size_t)r * 512 + c0), u2);
        unpack8(*(const u32x4*)(BG + (size_t)r * 512 + c0), bg);
#pragma unroll
        for (int e = 0; e < 8; ++e) { w0[e] = F.conv_w[c0 + e]; w1[e] = F.conv_w[512 + c0 + e]; w2[e] = F.conv_w[1024 + c0 + e]; u1[e] = 0.f; u0[e] = 0.f; }
        if (r < TP) { const int t = r & 2047;
            if (t >= 1) unpack8(*(const u32x4*)(U + (size_t)(r - 1) * 512 + c0), u1);
            if (t >= 2) unpack8(*(const u32x4*)(U + (size_t)(r - 2) * 512 + c0), u0);
        } else { const int rs = r - TP, b = rs >> 2, j = rs & 3;
            const float* st = F.state_conv + (size_t)b * 1024 + c0;
            if (j >= 1) unpack8(*(const u32x4*)(U + (size_t)(r - 1) * 512 + c0), u1);
            else {
#pragma unroll
                for (int e = 0; e < 8; ++e) u1[e] = st[512 + e]; }
            if (j >= 2) unpack8(*(const u32x4*)(U + (size_t)(r - 2) * 512 + c0), u0);
            else {
#pragma unroll
                for (int e = 0; e < 8; ++e) u0[e] = st[(j == 1 ? 512 : 0) + e]; }
        }
        float o[8];
#pragma unroll
        for (int e = 0; e < 8; ++e) o[e] = bg[e] * (w2[e] * u2[e] + w1[e] * u1[e] + w0[e] * u0[e]);
        *(u32x4*)(APRE + (size_t)r * 512 + c0) = pack8(o);
    }
}

constexpr int QL_STRIDE = 1040;
template <bool WLDS> __device__ __forceinline__ f32x16 idx_tile_t(const bf16x8 (&kf)[4], const LAS unsigned char* qb_, const float (&w8)[8], const LAS float* wl) {
    unsigned qo = (unsigned)(size_t)qb_; asm volatile("" : "+v"(qo));
    const LAS unsigned char* qb = (const LAS unsigned char*)(size_t)qo;
    f32x16 sc;
#pragma unroll
    for (int i = 0; i < 16; ++i) sc[i] = 0.f;
#pragma unroll
    for (int h = 0; h < 8; ++h) {
        f32x16 a;
#pragma unroll
        for (int i = 0; i < 16; ++i) a[i] = 0.f;
#pragma unroll
        for (int s = 0; s < 4; ++s) { const bf16x8 qf = *(const LAS bf16x8*)(qb + h * 128 + s * 32); a = __builtin_amdgcn_mfma_f32_32x32x16_bf16(kf[s], qf, a, 0, 0, 0); }
        const float wh = WLDS ? wl[h] : w8[h];
#pragma unroll
        for (int i = 0; i < 16; ++i) sc[i] += wh * fmaxf(a[i], 0.f);
    }
    return sc;
}
__device__ __forceinline__ f32x16 idx_tile(const bf16x8 (&kf)[4], const LAS unsigned char* qb_, const float (&w8)[8]) { return idx_tile_t<false>(kf, qb_, w8, nullptr); }

__device__ __forceinline__ int wave_sum_i_dpp(int x) {
    x += __builtin_amdgcn_update_dpp(0, x, 0xB1, 0xF, 0xF, true);
    x += __builtin_amdgcn_update_dpp(0, x, 0x4E, 0xF, 0xF, true);
    x += __builtin_amdgcn_update_dpp(0, x, 0x141, 0xF, 0xF, true);
    x += __builtin_amdgcn_update_dpp(0, x, 0x140, 0xF, 0xF, true);
    x += __builtin_amdgcn_update_dpp(0, x, 0x142, 0xA, 0xF, false);
    x += __builtin_amdgcn_update_dpp(0, x, 0x143, 0xC, 0xF, false);
    return __builtin_amdgcn_readlane(x, 63);
}
template <int NREG> __device__ __forceinline__ void select_rows8(const float* sc0, int n0, u64* mask0, int lane) {
    float cur[NREG], nxt[NREG];
#pragma unroll
    for (int j = 0; j < NREG; ++j) { cur[j] = sc0[64 * j + lane]; nxt[j] = 0.f; }
#pragma unroll 1
    for (int rr = 0; rr < 8; ++rr) {
        if (rr < 7) {
#pragma unroll
            for (int j = 0; j < NREG; ++j) nxt[j] = sc0[(size_t)(rr + 1) * 2048 + 64 * j + lane]; }
        const int n = n0 + rr;
        unsigned key[NREG];
#pragma unroll
        for (int j = 0; j < NREG; ++j) { const int idx = 64 * j + lane; const unsigned k = mono(cur[j]); key[j] = idx < n ? k : 0u; }
        unsigned thr = 0u, cut = 0u; bool exact = false;
#pragma unroll 1
        for (int bit = 31; bit >= 0; --bit) {
            const unsigned cand = thr | (1u << bit); int c = 0;
#pragma unroll
            for (int j = 0; j < NREG; ++j) c += (key[j] >= cand) ? 1 : 0;
            c = wave_sum_i_dpp(c);
            if (c == 256) { cut = cand; exact = true; break; }
            if (c > 256) thr = cand;
        }
        u64 myword = 0ull;
        if (exact) {
#pragma unroll
            for (int j = 0; j < NREG; ++j) { const u64 word = __ballot(key[j] >= cut); if (lane == j) myword = word; }
        } else {
            int cgt = 0;
#pragma unroll
            for (int j = 0; j < NREG; ++j) cgt += (key[j] > thr) ? 1 : 0;
            int need = 256 - wave_sum_i_dpp(cgt);
#pragma unroll
            for (int j = 0; j < NREG; ++j) {
                const u64 eq = __ballot(key[j] == thr);
                const int rank = mbcnt64(eq);
                const u64 word = __ballot(key[j] > thr || (key[j] == thr && rank < need));
                const int pe = __popcll(eq); need = need > pe ? need - pe : 0;
                if (lane == j) myword = word;
            }
        }
        if (lane < 32) mask0[(size_t)rr * 32 + lane] = myword;
#pragma unroll
        for (int j = 0; j < NREG; ++j) cur[j] = nxt[j];
    }
}
__device__ __forceinline__ void select_rows8_prompt(const float* sc0, int t0, u64* mask0, int lane) {
    t0 = __builtin_amdgcn_readfirstlane(t0);
    const int nmax = t0 + 8;
    if (nmax <= 256) {
#pragma unroll 1
        for (int rr = 0; rr < 8; ++rr) { const int n = t0 + rr + 1;
            if (lane < 32) { const int lo = 64 * lane; const u64 word = (n >= lo + 64) ? ~0ull : (n > lo ? ((1ull << (n - lo)) - 1ull) : 0ull); mask0[(size_t)rr * 32 + lane] = word; } }
    } else if (nmax <= 512) select_rows8<8>(sc0, t0 + 1, mask0, lane);
    else if (nmax <= 1024) select_rows8<16>(sc0, t0 + 1, mask0, lane);
    else if (nmax <= 1536) select_rows8<24>(sc0, t0 + 1, mask0, lane);
    else select_rows8<32>(sc0, t0 + 1, mask0, lane);
}

__device__ __forceinline__ void p4_prompt_unit(const Frame& F, int b, int qt, int parts, LAS int* qslot, unsigned* qhead) {
    const bf16_t* QI = WSP(bf16_t, WS_QI); const bf16_t* KI = WSP(bf16_t, WS_KI); const float* WI = WSP(float, WS_WI); float* SC = WSP(float, WS_SCR); u64* MASK = WSP(u64, WS_MASK);
    const int w = F.wave, lane = F.lane, q = lane & 31, half = lane >> 5;
    if (!(parts & 32)) {
    {
#pragma unroll
        for (int i = 0; i < 8; ++i) { const int e = F.tid + 512 * i, rw = e >> 6, ch = e & 63;
            *(LAS u32x4*)(F.lds + rw * QL_STRIDE + ch * 16) = *(const u32x4*)(QI + ((size_t)b * 2048 + qt * 64 + rw) * 512 + ch * 8); }
    }
    __syncthreads();
    {
        const int qh = w & 1, stripe = w >> 1, t0 = qt * 64 + qh * 32;
        const size_t rowq = (size_t)b * 2048 + t0 + q;
        const LAS unsigned char* qb = F.lds + (qh * 32 + q) * QL_STRIDE + half * 16;
        float w8[8];
        { const f32x4 a = *(const f32x4*)(WI + rowq * 8), c = *(const f32x4*)(WI + rowq * 8 + 4); w8[0] = a[0]; w8[1] = a[1]; w8[2] = a[2]; w8[3] = a[3]; w8[4] = c[0]; w8[5] = c[1]; w8[6] = c[2]; w8[7] = c[3]; }
        const int nkt = t0 / 32 + 1;
        if (stripe < nkt) {
            bf16x8 ka[4], kb[4];
#define P4_LOADK(dst, kt_) do { const int k_ = (kt_) < nkt ? (kt_) : stripe; const size_t rowk_ = (size_t)b * 2048 + k_ * 32 + q; \
        _Pragma("unroll") for (int s_ = 0; s_ < 4; ++s_) dst[s_] = *(const bf16x8*)(KI + rowk_ * 64 + s_ * 16 + half * 8); } while (0)
#define P4_STORE(scv, kt_) do { float* dst_ = SC + rowq * 2048 + (kt_) * 32 + 4 * half; \
        _Pragma("unroll") for (int g_ = 0; g_ < 4; ++g_) *(f32x4*)(dst_ + 8 * g_) = (f32x4){scv[4 * g_], scv[4 * g_ + 1], scv[4 * g_ + 2], scv[4 * g_ + 3]}; } while (0)
            P4_LOADK(ka, stripe);
#pragma unroll 1
            for (int kt = stripe; kt < nkt; kt += 4) {
                P4_LOADK(kb, kt + 4); __builtin_amdgcn_sched_barrier(0);
                const f32x16 sc = idx_tile(ka, qb, w8);
#pragma unroll
                for (int s = 0; s < 4; ++s) ka[s] = kb[s];
                __builtin_amdgcn_sched_barrier(0);
                P4_STORE(sc, kt);
            }
#undef P4_LOADK
#undef P4_STORE
        }
    }
    }
    __syncthreads();
    int unext = 0;
    if (F.tid == 0) unext = (int)__hip_atomic_fetch_add(qhead, 1u, __ATOMIC_RELAXED, __HIP_MEMORY_SCOPE_AGENT);
    if (!(parts & 16)) { const int t0 = qt * 64 + w * 8; const size_t row = (size_t)b * 2048 + t0; select_rows8_prompt(SC + row * 2048, t0, MASK + row * 32, lane); }
    if (F.tid == 0) *qslot = unext;
    __syncthreads();
}

__device__ __forceinline__ void p4_sample_unit(const Frame& F, int b) {
    const bf16_t* QI = WSP(bf16_t, WS_QI); const bf16_t* KI = WSP(bf16_t, WS_KI); const float* WI = WSP(float, WS_WI);
    const bf16_t* Q = WSP(bf16_t, WS_Q); const bf16_t* K = WSP(bf16_t, WS_K); const bf16_t* V = WSP(bf16_t, WS_V); bf16_t* ATT = WSP(bf16_t, WS_ATT);
    constexpr int SLW = 8224;
    constexpr int NEWKEY = 0x40000000;
    LAS unsigned* SL = (LAS unsigned*)F.lds;
    LAS int* SELR = (LAS int*)(F.lds + 4 * SLW * 4);
    LAS unsigned char* QL = F.lds + 4 * SLW * 4 + 4096;
    LAS int* CNT = (LAS int*)(F.lds + 4 * SLW * 4 + 4096 + 4 * QL_STRIDE);
    const int w = F.wave, lane = F.lane, q = lane & 31, half = lane >> 5, tid = F.tid;
    const int* pt = F.page_table + b * NPG;
    const size_t r0 = (size_t)TP + b * 4;
    if (tid < 256) { const int rw = tid >> 6, ch = tid & 63; *(LAS u32x4*)(QL + rw * QL_STRIDE + ch * 16) = *(const u32x4*)(QI + (r0 + rw) * 512 + ch * 8); }
    if (tid < 32) ((LAS float*)(QL + 4 * QL_STRIDE + 256))[tid] = WI[r0 * 8 + tid];
    LAS int* PTL = (LAS int*)(QL + 4 * QL_STRIDE + 512);
    if (tid >= 64 && tid < 128) PTL[tid - 64] = pt[tid - 64];
    __syncthreads();
    {
        const size_t rowq = r0 + (q & 3);
        const LAS unsigned char* qb = QL + (q & 3) * QL_STRIDE + half * 16;
        const LAS float* wl = (const LAS float*)(QL + 4 * QL_STRIDE + 256) + (q & 3) * 8;
        const float w8[8] = {0.f, 0.f, 0.f, 0.f, 0.f, 0.f, 0.f, 0.f};
        (void)rowq;
        f32x4 ta[8], tb[8];
#define SMP_LOAD(dst, kt_) do { const int k_ = (kt_) < 256 ? (kt_) : 255; const float* kr_ = F.cache_kidx + ((size_t)PTL[k_ >> 2] * PAGE + ((k_ & 3) * 32 + q)) * 64 + half * 8; \
        _Pragma("unroll") for (int s_ = 0; s_ < 4; ++s_) { dst[2 * s_] = *(const f32x4*)(kr_ + s_ * 16); dst[2 * s_ + 1] = *(const f32x4*)(kr_ + s_ * 16 + 4); } } while (0)
#define SMP_TILE(srcb, kt_) do { if ((kt_) < 256) { bf16x8 kf_[4]; \
        _Pragma("unroll") for (int s_ = 0; s_ < 4; ++s_) { const f32x4 a_ = srcb[2 * s_], c_ = srcb[2 * s_ + 1]; \
            u32x4 wv_; wv_.x = cvt_pk_bf16(a_[0], a_[1]); wv_.y = cvt_pk_bf16(a_[2], a_[3]); wv_.z = cvt_pk_bf16(c_[0], c_[1]); wv_.w = cvt_pk_bf16(c_[2], c_[3]); kf_[s_] = __builtin_bit_cast(bf16x8, wv_); } \
        const f32x16 sc_ = idx_tile_t<true>(kf_, qb, w8, wl); \
        if (q < 4) { _Pragma("unroll") for (int i_ = 0; i_ < 16; ++i_) SL[q * SLW + (kt_) * 32 + 8 * (i_ >> 2) + 4 * half + (i_ & 3)] = mono(sc_[i_]); } } } while (0)
        SMP_LOAD(ta, w);
#pragma unroll 1
        for (int kt = w; kt < 256; kt += 16) {
            SMP_LOAD(tb, kt + 8); __builtin_amdgcn_sched_barrier(0); SMP_TILE(ta, kt);
            SMP_LOAD(ta, kt + 16); __builtin_amdgcn_sched_barrier(0); SMP_TILE(tb, kt + 8);
        }
#undef SMP_LOAD
#undef SMP_TILE
        if (w == 0) {
            bf16x8 kf[4];
#pragma unroll
            for (int s = 0; s < 4; ++s) { u32x4 wv = (u32x4){0u, 0u, 0u, 0u}; if (q < 4) wv = *(const u32x4*)(KI + (r0 + q) * 64 + s * 16 + half * 8); kf[s] = __builtin_bit_cast(bf16x8, wv); }
            const f32x16 sc = idx_tile_t<true>(kf, qb, w8, wl);
            if (q < 4) {
#pragma unroll
                for (int i = 0; i < 16; ++i) SL[q * SLW + 256 * 32 + 8 * (i >> 2) + 4 * half + (i & 3)] = mono(sc[i]);
            }
        }
    }
    __syncthreads();
    {
        const int j = w >> 1, hw = w & 1, n = PAST + 1 + j;
        unsigned key[65];
#pragma unroll
        for (int k = 0; k < 65; ++k) { const int idx = hw * 4160 + 64 * k + lane; key[k] = 0u; if (idx < n) key[k] = SL[j * SLW + idx]; }
        unsigned thr = 0u;
#pragma unroll 1
        for (int bit = 31; bit >= 0; --bit) {
            const unsigned cand = thr | (1u << bit); int c = 0;
#pragma unroll
            for (int k = 0; k < 65; ++k) c += __popcll(__ballot(key[k] >= cand));
            if (lane == 0) CNT[(bit & 1) * 8 + w] = c;
            __syncthreads();
            const int tot = CNT[(bit & 1) * 8 + (w & ~1)] + CNT[(bit & 1) * 8 + (w | 1)];
            if (tot >= 256) thr = cand;
        }
        int cgt = 0, ceq = 0;
#pragma unroll 1
        for (int k = 0; k < 65; ++k) { const int idx = hw * 4160 + 64 * k + lane; const unsigned kk = idx < n ? SL[j * SLW + idx] : 0u;
            cgt += __popcll(__ballot(kk > thr)); ceq += __popcll(__ballot(kk == thr)); }
        if (lane == 0) { CNT[16 + w * 2] = cgt; CNT[16 + w * 2 + 1] = ceq; }
        __syncthreads();
        const int cgt0 = CNT[16 + (w & ~1) * 2], ceq0 = CNT[16 + (w & ~1) * 2 + 1], cgt1 = CNT[16 + (w | 1) * 2];
        const int need_tot = 256 - (cgt0 + cgt1);
        const int take0 = ceq0 < need_tot ? ceq0 : need_tot;
        int need = hw == 0 ? take0 : need_tot - take0;
        int base = hw == 0 ? 0 : cgt0 + take0;
#pragma unroll 1
        for (int k = 0; k < 65; ++k) {
            const int idx = hw * 4160 + 64 * k + lane; const unsigned kk = idx < n ? SL[j * SLW + idx] : 0u;
            const u64 eq = __ballot(kk == thr);
            const int rank = (int)__builtin_amdgcn_mbcnt_hi((unsigned)(eq >> 32), __builtin_amdgcn_mbcnt_lo((unsigned)eq, 0u));
            const bool on = kk > thr || (kk == thr && rank < need);
            const u64 sel = __ballot(on);
            const int pe = __popcll(eq); need = need > pe ? need - pe : 0;
            if (on) { const int pos = base + (int)__builtin_amdgcn_mbcnt_hi((unsigned)(sel >> 32), __builtin_amdgcn_mbcnt_lo((unsigned)sel, 0u));
                if (pos < 256) SELR[j * 256 + pos] = idx < PAST ? PTL[idx >> 7] * PAGE + (idx & 127) : (NEWKEY | (idx - PAST)); }
            base += __popcll(sel);
        }
    }
    __syncthreads();
    {
        LAS float* QF4 = (LAS float*)F.lds;
        LAS float* LG4 = (LAS float*)(F.lds + 8192);
        LAS float* PV4 = (LAS float*)(F.lds + 8192 + 32768);
#pragma unroll
        for (int j = 0; j < 4; ++j) QF4[j * 512 + tid] = bf2f(Q[(r0 + j) * 512 + tid]);
        __syncthreads();
#pragma unroll 1
        for (int j = 0; j < 4; ++j) {
            const int slot = tid >> 1, kvh = tid & 1; const int row = SELR[j * 256 + slot];
            float d0 = 0.f, d1 = 0.f, d2 = 0.f, d3 = 0.f;
            const LAS float* qb = QF4 + j * 512 + kvh * 256;
            if (row < NEWKEY) {
                const float* kr = F.cache_k + ((size_t)row * 2 + kvh) * 64;
                f32x4 kv[16];
#pragma unroll
                for (int c = 0; c < 16; ++c) kv[c] = *(const f32x4*)(kr + c * 4);
#pragma unroll
                for (int c = 0; c < 16; ++c)
#pragma unroll
                    for (int e = 0; e < 4; ++e) { const float kk = kv[c][e]; const int dd = c * 4 + e; d0 += kk * qb[dd]; d1 += kk * qb[64 + dd]; d2 += kk * qb[128 + dd]; d3 += kk * qb[192 + dd]; }
            } else {
                const bf16_t* kr = K + (r0 + (row - NEWKEY)) * 128 + kvh * 64;
#pragma unroll
                for (int c = 0; c < 8; ++c) { float kv[8]; unpack8(*(const u32x4*)(kr + c * 8), kv);
#pragma unroll
                    for (int e = 0; e < 8; ++e) { const float kk = kv[e]; const int dd = c * 8 + e; d0 += kk * qb[dd]; d1 += kk * qb[64 + dd]; d2 += kk * qb[128 + dd]; d3 += kk * qb[192 + dd]; } }
            }
            LAS float* lg = LG4 + j * 2048 + kvh * 1024 + slot;
            lg[0] = d0 * 0.125f; lg[256] = d1 * 0.125f; lg[512] = d2 * 0.125f; lg[768] = d3 * 0.125f;
        }
        __syncthreads();
#pragma unroll 1
        for (int j = 0; j < 4; ++j) {
            LAS float* lr = LG4 + j * 2048 + w * 256;
            float v0 = lr[lane], v1 = lr[64 + lane], v2 = lr[128 + lane], v3 = lr[192 + lane];
            const float mx = wave_max(fmaxf(fmaxf(v0, v1), fmaxf(v2, v3)));
            v0 = __expf(v0 - mx); v1 = __expf(v1 - mx); v2 = __expf(v2 - mx); v3 = __expf(v3 - mx);
            const float inv = 1.0f / wave_sum(v0 + v1 + v2 + v3);
            lr[lane] = v0 * inv; lr[64 + lane] = v1 * inv; lr[128 + lane] = v2 * inv; lr[192 + lane] = v3 * inv;
        }
        __syncthreads();
#pragma unroll 1
        for (int j = 0; j < 4; ++j) {
            float acc[8];
#pragma unroll
            for (int h = 0; h < 8; ++h) acc[h] = 0.f;
#pragma unroll 1
            for (int s0 = 0; s0 < 32; s0 += 16) {
                float v0[16], v1[16];
#pragma unroll
                for (int i = 0; i < 16; ++i) { const int row = SELR[j * 256 + w * 32 + s0 + i];
                    if (row < NEWKEY) { const float* vr = F.cache_v + (size_t)row * 128 + lane; v0[i] = vr[0]; v1[i] = vr[64]; }
                    else { const bf16_t* vr = V + (r0 + (row - NEWKEY)) * 128 + lane; v0[i] = bf2f(vr[0]); v1[i] = bf2f(vr[64]); } }
#pragma unroll
                for (int i = 0; i < 16; ++i) { const int slot = w * 32 + s0 + i;
#pragma unroll
                    for (int h = 0; h < 8; ++h) acc[h] += LG4[j * 2048 + h * 256 + slot] * (h < 4 ? v0[i] : v1[i]); }
            }
#pragma unroll
            for (int h = 0; h < 8; ++h) PV4[(w * 4 + j) * 512 + h * 64 + lane] = acc[h];
        }
        __syncthreads();
#pragma unroll
        for (int j = 0; j < 4; ++j) { float o = 0.f;
#pragma unroll
            for (int ww = 0; ww < 8; ++ww) o += PV4[(ww * 4 + j) * 512 + tid];
            ATT[(r0 + j) * 512 + tid] = (bf16_t)(cvt_pk_bf16(o, 0.f) & 0xffffu); }
        __syncthreads();
    }
}

__device__ __forceinline__ void p4_all(const Frame& F, int rep, int parts) {
    if (parts & 1) p4_vtranspose(F);
    if (parts & 2) p4_conv(F);
    if (parts & 4) { for (int b = F.bid; b < DB; b += F.nblk) p4_sample_unit(F, b); }
    if (!(parts & 8)) return;
    LAS int* qslot = (LAS int*)(F.lds + LDS_MISC + 32);
    __syncthreads();
    if (F.tid == 0) *qslot = (int)__hip_atomic_fetch_add(F.ctl + CW_Q4 + 64 * rep, 1u, __ATOMIC_RELAXED, __HIP_MEMORY_SCOPE_AGENT);
    for (;;) {
        __syncthreads();
        const int u = *qslot;
        if (u >= NB * 32) break;
        p4_prompt_unit(F, u & 31, 31 - (u >> 5), parts, qslot, F.ctl + CW_Q4 + 64 * rep);
    }
}

template <bool FAST> __device__ __forceinline__ void p5_unit_t(const Frame& F, int b, int kvh, int qt, const bf16x8 (&qf)[4], float mq, u32x4 kv, u32x4 vv, u64 mw) {
    const bf16_t* Q = WSP(bf16_t, WS_Q); const bf16_t* K = WSP(bf16_t, WS_K); const bf16_t* VTR = WSP(bf16_t, WS_VTR); const u64* MASK = WSP(u64, WS_MASK); bf16_t* ATT = WSP(bf16_t, WS_ATT);
    LAS unsigned char* Kl = F.lds;
    LAS unsigned char* Vl = F.lds + 64 * 144;
    const int w = F.wave, lane = F.lane, q = lane & 31, half = lane >> 5, tid = F.tid;
    const int g = w & 3, th = w >> 2, head = kvh * 4 + g;
    const size_t rowq = (size_t)b * 2048 + qt * 64 + th * 32 + q;
    f32x16 O0, O1;
#pragma unroll
    for (int i = 0; i < 16; ++i) { O0[i] = 0.f; O1[i] = 0.f; }
    float mrun = -1e30f, lrun = 0.f;
    const int rw = tid >> 3, ch = tid & 7;
    const bf16_t* kgp = K + ((size_t)b * 2048 + rw) * 128 + kvh * 64 + ch * 8;
    const bf16_t* vgp = VTR + ((size_t)((b * 2 + kvh) * 64 + rw)) * 2048 + ch * 8;
    for (int kt = 0; kt <= qt; ++kt) {
        __syncthreads();
        *(LAS u32x4*)(Kl + rw * 144 + ch * 16) = kv;
        *(LAS u32x4*)(Vl + rw * 144 + ch * 16) = vv;
        const u64 mwc = mw;
        __syncthreads();
        { const int kn = kt < qt ? kt + 1 : kt;
          kv = *(const u32x4*)(kgp + (size_t)kn * 64 * 128); vv = *(const u32x4*)(vgp + kn * 64); mw = MASK[rowq * 32 + kn]; }
        f32x16 S[2];
#pragma unroll
        for (int ks = 0; ks < 2; ++ks) {
            f32x16 a;
#pragma unroll
            for (int i = 0; i < 16; ++i) a[i] = FAST ? -mq : 0.f;
#pragma unroll
            for (int s = 0; s < 4; ++s) { const bf16x8 kf = *(const LAS bf16x8*)(Kl + (ks * 32 + q) * 144 + s * 32 + half * 16); a = __builtin_amdgcn_mfma_f32_32x32x16_bf16(kf, qf[s], a, 0, 0, 0); }
            S[ks] = a;
        }
        const u64 mh = mwc >> (4 * half);
        const unsigned mword[2] = {(unsigned)mh, (unsigned)(mh >> 32)};
        if (FAST) {
            float ls = 0.f;
#pragma unroll
            for (int ks = 0; ks < 2; ++ks)
#pragma unroll
                for (int i = 0; i < 16; ++i) { const unsigned keep = (unsigned)__builtin_amdgcn_sbfe((int)mword[ks], 8 * (i >> 2) + (i & 3), 1);
                    const float p = __uint_as_float(__float_as_uint(__builtin_amdgcn_exp2f(S[ks][i])) & keep); S[ks][i] = p; ls += p; }
            lrun += ls;
        } else {
            float mx = -INFINITY;
#pragma unroll
            for (int ks = 0; ks < 2; ++ks)
#pragma unroll
                for (int i = 0; i < 16; ++i) { const bool on = (mword[ks] >> (8 * (i >> 2) + (i & 3))) & 1u; const float sv = on ? S[ks][i] : -INFINITY; S[ks][i] = sv; mx = fmaxf(mx, sv); }
            mx = fmaxf(mx, __shfl_xor(mx, 32));
            const float mnew = fmaxf(mrun, mx);
            const float alpha = __builtin_amdgcn_exp2f(mrun - mnew);
            float ls = 0.f;
#pragma unroll
            for (int ks = 0; ks < 2; ++ks)
#pragma unroll
                for (int i = 0; i < 16; ++i) { const float p = __builtin_amdgcn_exp2f(S[ks][i] - mnew); S[ks][i] = p; ls += p; }
            lrun = lrun * alpha + ls;
            if (__any(mnew != mrun)) {
#pragma unroll
                for (int i = 0; i < 16; ++i) { O0[i] *= alpha; O1[i] *= alpha; } }
            mrun = mnew;
        }
#pragma unroll
        for (int ks = 0; ks < 2; ++ks)
#pragma unroll
            for (int s2 = 0; s2 < 2; ++s2) {
                u32x4 pw; pw.x = cvt_pk_bf16(S[ks][8 * s2 + 0], S[ks][8 * s2 + 1]); pw.y = cvt_pk_bf16(S[ks][8 * s2 + 2], S[ks][8 * s2 + 3]); pw.z = cvt_pk_bf16(S[ks][8 * s2 + 4], S[ks][8 * s2 + 5]); pw.w = cvt_pk_bf16(S[ks][8 * s2 + 6], S[ks][8 * s2 + 7]);
                const bf16x8 pf = __builtin_bit_cast(bf16x8, pw);
                const int kb = (ks * 32 + 16 * s2 + 4 * half) * 2;
                { const u32x2 a = *(const LAS u32x2*)(Vl + q * 144 + kb), c = *(const LAS u32x2*)(Vl + q * 144 + kb + 16);
                  const bf16x8 vf = __builtin_bit_cast(bf16x8, (u32x4){a.x, a.y, c.x, c.y}); O0 = __builtin_amdgcn_mfma_f32_32x32x16_bf16(vf, pf, O0, 0, 0, 0); }
                { const u32x2 a = *(const LAS u32x2*)(Vl + (32 + q) * 144 + kb), c = *(const LAS u32x2*)(Vl + (32 + q) * 144 + kb + 16);
                  const bf16x8 vf = __builtin_bit_cast(bf16x8, (u32x4){a.x, a.y, c.x, c.y}); O1 = __builtin_amdgcn_mfma_f32_32x32x16_bf16(vf, pf, O1, 0, 0, 0); }
            }
    }
    const float inv = 1.0f / (lrun + __shfl_xor(lrun, 32));
    bf16_t* op = ATT + rowq * 512 + head * 64 + 4 * half;
#pragma unroll
    for (int gq = 0; gq < 4; ++gq) {
        u32x2 a; a.x = cvt_pk_bf16(O0[4 * gq] * inv, O0[4 * gq + 1] * inv); a.y = cvt_pk_bf16(O0[4 * gq + 2] * inv, O0[4 * gq + 3] * inv); *(u32x2*)(op + 8 * gq) = a;
        u32x2 c; c.x = cvt_pk_bf16(O1[4 * gq] * inv, O1[4 * gq + 1] * inv); c.y = cvt_pk_bf16(O1[4 * gq + 2] * inv, O1[4 * gq + 3] * inv); *(u32x2*)(op + 32 + 8 * gq) = c;
    }
}
__device__ __forceinline__ void p5_unit_fast(const Frame& F, int b, int kvh, int qt, const bf16x8 (&qf)[4], float mq, u32x4 kv, u32x4 vv, u32x4 kv1, u32x4 vv1, u64 mcur, u64 mnxt) {
    const bf16_t* K = WSP(bf16_t, WS_K); const bf16_t* VTR = WSP(bf16_t, WS_VTR); const u64* MASK = WSP(u64, WS_MASK); bf16_t* ATT = WSP(bf16_t, WS_ATT);
    LAS unsigned char* Kl = F.lds;
    LAS unsigned char* Vl = F.lds + 3 * 64 * 144;
    const int w = F.wave, lane = F.lane, q = lane & 31, half = lane >> 5, tid = F.tid;
    const int g = w & 3, th = w >> 2, head = kvh * 4 + g;
    const size_t rowq = (size_t)b * 2048 + qt * 64 + th * 32 + q;
    f32x16 O0, O1, L;
#pragma unroll
    for (int i = 0; i < 16; ++i) { O0[i] = 0.f; O1[i] = 0.f; L[i] = 0.f; }
    bf16x8 ones;
    { u32x4 o; o.x = o.y = o.z = o.w = 0x3F803F80u; asm volatile("" : "+v"(o)); ones = __builtin_bit_cast(bf16x8, o); }
    const int rw = tid >> 3, ch = tid & 7, nt = qt + 1;
    const int vwo = (ch >> 1) * 32 + (ch & 1) * 8;
    const bf16_t* kgp = K + ((size_t)b * 2048 + rw) * 128 + kvh * 64 + ch * 8;
    const bf16_t* vgp = VTR + ((size_t)((b * 2 + kvh) * 64 + rw)) * 2048 + ch * 8;
    const int k2 = nt > 2 ? 2 : 0;
    __syncthreads();
    *(LAS u32x4*)(Kl + rw * 144 + ch * 16) = kv; *(LAS u32x2*)(Vl + rw * 144 + vwo) = (u32x2){vv.x, vv.y}; *(LAS u32x2*)(Vl + rw * 144 + vwo + 16) = (u32x2){vv.z, vv.w};
    *(LAS u32x4*)(Kl + 9216 + rw * 144 + ch * 16) = kv1; *(LAS u32x2*)(Vl + 9216 + rw * 144 + vwo) = (u32x2){vv1.x, vv1.y}; *(LAS u32x2*)(Vl + 9216 + rw * 144 + vwo + 16) = (u32x2){vv1.z, vv1.w};
    __syncthreads();
    kv = *(const u32x4*)(kgp + (size_t)k2 * 64 * 128); vv = *(const u32x4*)(vgp + k2 * 64);
    int ob0 = 0, ob1 = 9216, ob2 = 18432;
    f32x16 SA[2], SB[2];
#pragma unroll
    for (int ks = 0; ks < 2; ++ks) {
        f32x16 a;
#pragma unroll
        for (int i = 0; i < 16; ++i) a[i] = 0.f;
#pragma unroll
        for (int s = 0; s < 4; ++s) { const bf16x8 kf = *(const LAS bf16x8*)(Kl + (ks * 32 + q) * 144 + s * 32 + half * 16); a = __builtin_amdgcn_mfma_f32_32x32x16_bf16(kf, qf[s], a, 0, 0, 0); }
        SA[ks] = a;
    }
    auto tile = [&](f32x16 (&Sc)[2], f32x16 (&Sn)[2], const int kt) __attribute__((always_inline)) {
        *(LAS u32x4*)(Kl + ob2 + rw * 144 + ch * 16) = kv; *(LAS u32x2*)(Vl + ob2 + rw * 144 + vwo) = (u32x2){vv.x, vv.y}; *(LAS u32x2*)(Vl + ob2 + rw * 144 + vwo + 16) = (u32x2){vv.z, vv.w};
        { const int kn = kt + 3 < nt ? kt + 3 : kt;
          kv = *(const u32x4*)(kgp + (size_t)kn * 64 * 128); vv = *(const u32x4*)(vgp + kn * 64); }
        const u64 mnn = MASK[rowq * 32 + (kt + 2 < nt ? kt + 2 : kt)];
        bf16x8 kf[9];
        const LAS unsigned char* kfb = Kl + ob1 + q * 144 + half * 16;
        kf[0] = *(const LAS bf16x8*)kfb;
        const u64 mh = mcur >> (4 * half);
        const unsigned mword[2] = {(unsigned)mh, (unsigned)(mh >> 32)};
#pragma unroll
        for (int i = 0; i < 16; ++i) { Sn[0][i] = 0.f; Sn[1][i] = 0.f; }
#pragma unroll
        for (int j = 0; j < 8; ++j) {
            const int ks = j & 1, s = j >> 1;
            if (j < 7) kf[j + 1] = *(const LAS bf16x8*)(kfb + ((j + 1) & 1) * 32 * 144 + ((j + 1) >> 1) * 32);
            Sn[ks] = __builtin_amdgcn_mfma_f32_32x32x16_bf16(kf[j], qf[s], Sn[ks], 0, 0, 0);
            const int eks = j >> 2;
#pragma unroll
            for (int e = 0; e < 4; ++e) { const int i = (j & 3) * 4 + e;
                unsigned keep;
                asm("v_bfe_i32 %0, %1, %2, 1" : "=v"(keep) : "v"(mword[eks]), "n"(8 * (i >> 2) + (i & 3)));
                Sc[eks][i] = __uint_as_float(__float_as_uint(__builtin_amdgcn_exp2f(Sc[eks][i])) & keep); }
            __builtin_amdgcn_sched_barrier(0);
        }
#pragma unroll
        for (int ks = 0; ks < 2; ++ks)
#pragma unroll
            for (int s2 = 0; s2 < 2; ++s2) {
                u32x4 pw; pw.x = cvt_pk_bf16(Sc[ks][8 * s2 + 0], Sc[ks][8 * s2 + 1]); pw.y = cvt_pk_bf16(Sc[ks][8 * s2 + 2], Sc[ks][8 * s2 + 3]); pw.z = cvt_pk_bf16(Sc[ks][8 * s2 + 4], Sc[ks][8 * s2 + 5]); pw.w = cvt_pk_bf16(Sc[ks][8 * s2 + 6], Sc[ks][8 * s2 + 7]);
                const bf16x8 pf = __builtin_bit_cast(bf16x8, pw);
                const int kb = (ks * 2 + s2) * 32 + half * 16;
                const LAS unsigned char* vb = Vl + ob0;
                { const bf16x8 vf = *(const LAS bf16x8*)(vb + q * 144 + kb); O0 = __builtin_amdgcn_mfma_f32_32x32x16_bf16(vf, pf, O0, 0, 0, 0); }
                { const bf16x8 vf = *(const LAS bf16x8*)(vb + (32 + q) * 144 + kb); O1 = __builtin_amdgcn_mfma_f32_32x32x16_bf16(vf, pf, O1, 0, 0, 0); }
                L = __builtin_amdgcn_mfma_f32_32x32x16_bf16(ones, pf, L, 0, 0, 0);
            }
        mcur = mnxt; mnxt = mnn;
        { const int t = ob0; ob0 = ob1; ob1 = ob2; ob2 = t; }
        __syncthreads();
    };
    int kt = 0;
    for (; kt + 1 < nt; kt += 2) { tile(SA, SB, kt); tile(SB, SA, kt + 1); }
    if (kt < nt) tile(SA, SB, kt);
    const float inv = 1.0f / L[0];
    bf16_t* op = ATT + rowq * 512 + head * 64 + 4 * half;
#pragma unroll
    for (int gq = 0; gq < 4; ++gq) {
        u32x2 a; a.x = cvt_pk_bf16(O0[4 * gq] * inv, O0[4 * gq + 1] * inv); a.y = cvt_pk_bf16(O0[4 * gq + 2] * inv, O0[4 * gq + 3] * inv); *(u32x2*)(op + 8 * gq) = a;
        u32x2 c; c.x = cvt_pk_bf16(O1[4 * gq] * inv, O1[4 * gq + 1] * inv); c.y = cvt_pk_bf16(O1[4 * gq + 2] * inv, O1[4 * gq + 3] * inv); *(u32x2*)(op + 32 + 8 * gq) = c;
    }
}
__device__ __forceinline__ void p5_unit(const Frame& F, int b, int kvh, int qt, float kbound) {
    const bf16_t* Q = WSP(bf16_t, WS_Q);
    const int w = F.wave, lane = F.lane, q = lane & 31, half = lane >> 5;
    const int g = w & 3, th = w >> 2, head = kvh * 4 + g;
    const size_t rowq = (size_t)b * 2048 + qt * 64 + th * 32 + q;
    bf16x8 qf[4]; float qs = 0.f;
    u32x4 qraw[4];
#pragma unroll
    for (int s = 0; s < 4; ++s) qraw[s] = *(const u32x4*)(Q + rowq * 512 + head * 64 + s * 16 + half * 8);
    const int rw0 = F.tid >> 3, ch0 = F.tid & 7, k1 = qt > 0 ? 1 : 0;
    const bf16_t* kgp0 = WSP(bf16_t, WS_K) + ((size_t)b * 2048 + rw0) * 128 + kvh * 64 + ch0 * 8;
    const bf16_t* vgp0 = WSP(bf16_t, WS_VTR) + ((size_t)((b * 2 + kvh) * 64 + rw0)) * 2048 + ch0 * 8;
    const u32x4 kv0 = *(const u32x4*)kgp0, vv0 = *(const u32x4*)vgp0;
    const u32x4 kv1 = *(const u32x4*)(kgp0 + (size_t)k1 * 64 * 128), vv1 = *(const u32x4*)(vgp0 + k1 * 64);
    const u64 m0 = WSP(u64, WS_MASK)[rowq * 32], m1 = WSP(u64, WS_MASK)[rowq * 32 + k1];
#pragma unroll
    for (int s = 0; s < 4; ++s) { float t8[8]; unpack8(qraw[s], t8);
#pragma unroll
        for (int e = 0; e < 8; ++e) t8[e] *= 0.125f * 1.4426950408889634f;
        const u32x4 pk = pack8(t8); qf[s] = __builtin_bit_cast(bf16x8, pk);
        float r8[8]; unpack8(pk, r8);
#pragma unroll
        for (int e = 0; e < 8; ++e) qs += r8[e] * r8[e]; }
    qs += __shfl_xor(qs, 32);
    const float mq = sqrtf(qs) * kbound;
    if (!__any(!(mq <= 40.0f))) p5_unit_fast(F, b, kvh, qt, qf, mq, kv0, vv0, kv1, vv1, m0, m1);
    else p5_unit_t<false>(F, b, kvh, qt, qf, 0.f, kv0, vv0, m0);
}
__device__ __forceinline__ void p5_all(const Frame& F, int rep) {
    const float kbound = 8.1f * wave_max(fabsf(F.k_norm_w[F.lane]));

    LAS int* qslot = (LAS int*)(F.lds + LDS_MISC + 32);
    const int xq = blockIdx.x & 7;
    int unext = 0;
    if (F.tid == 0) unext = (int)__hip_atomic_fetch_add(F.ctl + CW_Q5 + 64 * (xq + 8 * rep), 1u, __ATOMIC_RELAXED, __HIP_MEMORY_SCOPE_AGENT);
    for (;;) {
        __syncthreads();
        if (F.tid == 0) *qslot = unext;
        __syncthreads();
        const int u = *qslot;
        if (u >= 4 * 2 * 32) break;
        if (F.tid == 0) unext = (int)__hip_atomic_fetch_add(F.ctl + CW_Q5 + 64 * (xq + 8 * rep), 1u, __ATOMIC_RELAXED, __HIP_MEMORY_SCOPE_AGENT);
        p5_unit(F, 4 * xq + ((u >> 1) & 3), u & 1, 31 - (u >> 3), kbound);
    }
}

__device__ __forceinline__ void ce_desc(unsigned& a, unsigned& b) { const unsigned hi = a > b ? a : b, lo = a > b ? b : a; a = hi; b = lo; }
__device__ __forceinline__ void sort16_desc(unsigned (&a)[16]) {
#pragma unroll
    for (int k = 2; k <= 16; k <<= 1)
#pragma unroll
        for (int j = k >> 1; j > 0; j >>= 1)
#pragma unroll
            for (int i = 0; i < 16; ++i) { const int l = i ^ j; if (l > i) { if ((i & k) == 0) ce_desc(a[i], a[l]); else ce_desc(a[l], a[i]); } }
}
__device__ __forceinline__ void merge_top16(unsigned (&L)[16], const unsigned (&N)[16]) {
#pragma unroll
    for (int i = 0; i < 16; ++i) L[i] = L[i] > N[15 - i] ? L[i] : N[15 - i];
#pragma unroll
    for (int j = 8; j > 0; j >>= 1)
#pragma unroll
        for (int i = 0; i < 16; ++i) { const int l = i ^ j; if (l > i) ce_desc(L[i], L[l]); }
}
__device__ __forceinline__ unsigned mono16(unsigned h) { return (h & 0x8000u) ? (~h & 0xffffu) : (h | 0x8000u); }
__device__ __forceinline__ float unmono16(unsigned k) { const unsigned h = (k & 0x8000u) ? (k & 0x7fffu) : (~k & 0xffffu); return (float)__builtin_bit_cast(_Float16, (unsigned short)h); }
__device__ __forceinline__ void p11_select(const Frame& F) {
    const unsigned short* PST = WSP(unsigned short, WS_SCR); int* EIDX = WSP(int, WS_EIDX); float* G = WSP(float, WS_G);
    LAS unsigned char* TILE = F.lds;
    LAS unsigned* LST = (LAS unsigned*)F.lds;
    const int tid = F.tid;
    for (int unit = F.bid; unit < 258 * 8; unit += F.nblk) {
        const int pm = unit >> 3, h = unit & 7;
        const int row = tid & 255, p = tid >> 8;
        __syncthreads();
#pragma unroll
        for (int i = 0; i < 16; ++i) { const int e = tid + 512 * i, rw = e >> 5, ch = e & 31;
            *(LAS u32x4*)(TILE + rw * 528 + ch * 16) = *(const u32x4*)(PST + (size_t)unit * 65536 + rw * 256 + ch * 8); }
        __syncthreads();
        unsigned L[16];
#pragma unroll 1
        for (int k0 = 0; k0 < 128; k0 += 16) {
            const u32x4 a = *(const LAS u32x4*)(TILE + row * 528 + p * 256 + k0 * 2), b = *(const LAS u32x4*)(TILE + row * 528 + p * 256 + k0 * 2 + 16);
            const unsigned wv[8] = {a.x, a.y, a.z, a.w, b.x, b.y, b.z, b.w};
            unsigned N[16];
#pragma unroll
            for (int e = 0; e < 8; ++e) { N[2 * e] = (mono16(wv[e] & 0xffffu) << 16) | (unsigned)(127 - (k0 + 2 * e)); N[2 * e + 1] = (mono16(wv[e] >> 16) << 16) | (unsigned)(127 - (k0 + 2 * e + 1)); }
            sort16_desc(N);
            if (k0 == 0) {
#pragma unroll
                for (int e = 0; e < 16; ++e) L[e] = N[e];
            } else merge_top16(L, N);
        }
        __syncthreads();
#pragma unroll
        for (int q = 0; q < 16; ++q) LST[tid * 17 + q] = L[q];
        __syncthreads();
        if (tid < 256) {
            unsigned L2[16];
#pragma unroll
            for (int q = 0; q < 16; ++q) L2[q] = LST[(tid + 256) * 17 + q];
            float s1[16], s2[16];
#pragma unroll
            for (int q = 0; q < 16; ++q) { s1[q] = unmono16(L[q] >> 16); s2[q] = unmono16(L2[q] >> 16); }
            unsigned C[16], N[16]; int nn = 0; bool first = true;
#pragma unroll
            for (int i = 0; i < 16; ++i)
#pragma unroll
                for (int j = 0; j < 16; ++j)
                    if ((i + 1) * (j + 1) <= 16) {
                        N[nn++] = (mono(s1[i] + s2[j]) & ~255u) | (unsigned)(255 - (i * 16 + j));
                        if (nn == 16) { sort16_desc(N); if (first) {
#pragma unroll
                                for (int e = 0; e < 16; ++e) C[e] = N[e];
                                first = false; } else merge_top16(C, N); nn = 0; }
                    }
            {
#pragma unroll
                for (int e = 2; e < 16; ++e) N[e] = 0u;
                sort16_desc(N); merge_top16(C, N); }
            float sv[16]; int ev[16]; float mx = -INFINITY;
#pragma unroll
            for (int q = 0; q < 16; ++q) { const int pos = 255 - (int)(C[q] & 255u); const int i = pos >> 4, j = pos & 15;
                const unsigned k1 = LST[tid * 17 + i], k2 = LST[(tid + 256) * 17 + j];
                ev[q] = (127 - (int)(k1 & 127u)) * 128 + (127 - (int)(k2 & 127u));
                sv[q] = unmono16(k1 >> 16) + unmono16(k2 >> 16); mx = fmaxf(mx, sv[q]); }
            float sum = 0.f;
#pragma unroll
            for (int q = 0; q < 16; ++q) { sv[q] = __expf(sv[q] - mx); sum += sv[q]; }
            const float inv = 1.0f / sum;
            const size_t ob = ((size_t)(pm * 256 + row) * 8 + h) * 16;
#pragma unroll
            for (int q4 = 0; q4 < 4; ++q4) {
                *(int4*)(EIDX + ob + q4 * 4) = make_int4(ev[q4 * 4], ev[q4 * 4 + 1], ev[q4 * 4 + 2], ev[q4 * 4 + 3]);
                *(f32x4*)(G + ob + q4 * 4) = (f32x4){sv[q4 * 4] * inv, sv[q4 * 4 + 1] * inv, sv[q4 * 4 + 2] * inv, sv[q4 * 4 + 3] * inv}; }
        }
    }
}

typedef float f32x2v __attribute__((ext_vector_type(2)));
typedef __bf16 bf2_t __attribute__((ext_vector_type(2)));
__device__ __forceinline__ float dpp_add_xor1(float x) { return x + __uint_as_float(__builtin_amdgcn_update_dpp(0u, __float_as_uint(x), 0xB1, 0xF, 0xF, true)); }
__device__ __forceinline__ float dpp_add_xor2(float x) { return x + __uint_as_float(__builtin_amdgcn_update_dpp(0u, __float_as_uint(x), 0x4E, 0xF, 0xF, true)); }
__device__ __forceinline__ float dpp_add_hmir(float x) { return x + __uint_as_float(__builtin_amdgcn_update_dpp(0u, __float_as_uint(x), 0x141, 0xF, 0xF, true)); }

constexpr int P12A_TB_ = 48;
__device__ __forceinline__ void p12a_entry(const u32x4 (&rows)[8], int ent, const LAS unsigned char* H2L, int l8, float* ACT, int tb) {
    const int tl = (ent >> 21) & 63, slot = (ent >> 14) & 127;
    const LAS unsigned char* hp = H2L + tl * 2080 + l8 * 32;
    float acc = 0.f;
#pragma unroll
    for (int j = 0; j < 8; ++j) {
        const u32x4 ha = *(const LAS u32x4*)(hp + j * 256), hb = *(const LAS u32x4*)(hp + j * 256 + 16);
        const unsigned hw[8] = {ha.x, ha.y, ha.z, ha.w, hb.x, hb.y, hb.z, hb.w};
        const unsigned uw[4] = {rows[j].x, rows[j].y, rows[j].z, rows[j].w};
#pragma unroll
        for (int k = 0; k < 4; ++k) {
            acc = __builtin_amdgcn_fdot2_f32_bf16(__builtin_amdgcn_cvt_scalef32_pk_bf16_fp8(uw[k], 1.0f, false), __builtin_bit_cast(bf2_t, hw[2 * k]), acc, false);
            acc = __builtin_amdgcn_fdot2_f32_bf16(__builtin_amdgcn_cvt_scalef32_pk_bf16_fp8(uw[k], 1.0f, true), __builtin_bit_cast(bf2_t, hw[2 * k + 1]), acc, false); }
    }
    acc = dpp_add_hmir(dpp_add_xor2(dpp_add_xor1(acc)));
    if (l8 == 0 && ent >= 0) ACT[((size_t)tb * P12A_TB_ + tl) * 128 + slot] = acc;
}

constexpr int P12A_TB = 48, P12A_HSTRIDE = 2080;
__device__ __forceinline__ void p12a_act(const Frame& F, int probe) {
    const unsigned char* H2 = WSP(unsigned char, WS_H); const int* EIDX = WSP(int, WS_EIDX); const unsigned char* UT = WSP(unsigned char, WS_UT); float* ACT = (probe & 64) ? WSP(float, WS_SCR) : WSP(float, WS_ACT);
    const int emask = (probe & 64) ? 0x38ff : 0x3fff;
    LAS unsigned char* H2L = F.lds;
    LAS int* LSTL = (LAS int*)(F.lds + P12A_TB * P12A_HSTRIDE);
    LAS int* CTR = (LAS int*)(F.lds + P12A_TB * P12A_HSTRIDE + 6144 * 4);
    const int lane = F.lane, w = F.wave, tid = F.tid, g = lane >> 3, l8 = lane & 7;
    const bool part = (F.nblk & 7) == 0;
    const int xv = part ? (F.bid & 7) : 0, r = part ? (F.bid >> 3) : F.bid, nr = part ? (F.nblk >> 3) : F.nblk, npass = part ? 1 : 8;
    for (int pass = 0; pass < npass; ++pass) {
        const int v = xv * npass + pass;
        for (int tb = r; tb < T / P12A_TB; tb += nr) {
            u32x4 hreg[12]; int eAs[6], eBs[6];
#pragma unroll
            for (int i = 0; i < 12; ++i) { const int e_ = tid + 512 * i, row = e_ >> 7, ch = e_ & 127; hreg[i] = *(const u32x4*)(H2 + ((size_t)(tb * P12A_TB + row)) * 2048 + ch * 16); }
#pragma unroll
            for (int i = 0; i < 6; ++i) { const size_t t = (size_t)tb * P12A_TB + 6 * w + i; eAs[i] = EIDX[t * 128 + lane]; eBs[i] = EIDX[t * 128 + 64 + lane]; }
            __syncthreads();
            if (tid == 0) *CTR = 0;
#pragma unroll
            for (int i = 0; i < 12; ++i) { const int e_ = tid + 512 * i, row = e_ >> 7, ch = e_ & 127; *(LAS u32x4*)(H2L + row * P12A_HSTRIDE + ch * 16) = hreg[i]; }
            __syncthreads();
#pragma unroll
            for (int i = 0; i < 6; ++i) {
                const int tl = 6 * w + i; const int eA = eAs[i], eB = eBs[i];
                const bool onA = (eA >> 11) == v, onB = (eB >> 11) == v;
                const u64 mA = __ballot(onA), mB = __ballot(onB);
                const int nA = __popcll(mA), cnt = nA + __popcll(mB);
                int base = 0;
                if (lane == 0 && cnt > 0) base = __hip_atomic_fetch_add(CTR, cnt, __ATOMIC_RELAXED, __HIP_MEMORY_SCOPE_WORKGROUP);
                base = __builtin_amdgcn_readfirstlane(base);
                if (onA) LSTL[base + mbcnt64(mA)] = (tl << 21) | (lane << 14) | eA;
                if (onB) LSTL[base + nA + mbcnt64(mB)] = (tl << 21) | ((64 + lane) << 14) | eB;
            }
            __syncthreads();
            const int total = *CTR;
            const int nsteps = (total + 7) >> 3;
#define P12A_ENT(s_) ({ const int ix_ = (s_) * 8 + g; ix_ < total ? LSTL[ix_] : -1; })
#define P12A_ROWS(dst, ent_) do { const unsigned char* rp_ = UT + (size_t)((ent_) & emask) * 1024 + l8 * 16; \
        _Pragma("unroll") for (int j_ = 0; j_ < 8; ++j_) dst[j_] = *(const u32x4*)(rp_ + j_ * 128); } while (0)
            int s = w;
            if (s < nsteps) {
                int e0 = P12A_ENT(s), e1 = P12A_ENT(s + 8);
                u32x4 ra[8], rb[8];
                P12A_ROWS(ra, e0);
                for (;;) {
                    P12A_ROWS(rb, e1);
                    const int e2 = P12A_ENT(s + 16);
                    __builtin_amdgcn_sched_barrier(0);
                    p12a_entry(ra, e0, H2L, l8, ACT, tb);
                    s += 8; if (s >= nsteps) break;
                    P12A_ROWS(ra, e2);
                    const int e3 = P12A_ENT(s + 16);
                    __builtin_amdgcn_sched_barrier(0);
                    p12a_entry(rb, e1, H2L, l8, ACT, tb);
                    s += 8; if (s >= nsteps) break;
                    e0 = e2; e1 = e3;
                }
            }
#undef P12A_ENT
#undef P12A_ROWS
        }
    }
}

__device__ __forceinline__ void p12c_coef(const Frame& F) {
    const int* EIDX = WSP(int, WS_EIDX); const float* G = WSP(float, WS_G); const float* ACT = WSP(float, WS_ACT); const float* USC = WSP(float, WS_TSC); const float* VSC = WSP(float, WS_TSC) + 16384;
    u64* META = WSP(u64, WS_METAG);
    const size_t gt = (size_t)F.bid * 512 + F.tid, gn = (size_t)F.nblk * 512;
    size_t i = gt;
    for (; i + 3 * gn < (size_t)T * 128; i += 4 * gn) {
        int e[4]; float gg[4], aa[4], us[4], vs[4];
#pragma unroll
        for (int k = 0; k < 4; ++k) { e[k] = EIDX[i + k * gn]; gg[k] = G[i + k * gn]; aa[k] = ACT[i + k * gn]; }
#pragma unroll
        for (int k = 0; k < 4; ++k) { us[k] = USC[e[k]]; vs[k] = VSC[e[k]]; }
#pragma unroll
        for (int k = 0; k < 4; ++k) { const float c = gg[k] * gelu_tanh(aa[k] * us[k]) * vs[k]; META[i + k * gn] = (u64)(unsigned)e[k] | ((u64)__float_as_uint(c) << 32); }
    }
    for (; i < (size_t)T * 128; i += gn) { const int e = EIDX[i]; const float c = G[i] * gelu_tanh(ACT[i] * USC[e]) * VSC[e];
        META[i] = (u64)(unsigned)e | ((u64)__float_as_uint(c) << 32); }
}

__device__ __forceinline__ void p12b_out(const Frame& F) {
    const u64* METAG = WSP(u64, WS_METAG); const unsigned char* VT2 = WSP(unsigned char, WS_VT2); const float* MOD = WSP(float, WS_MOD); const bf16_t* Dm = WSP(bf16_t, WS_X1);
    const int lane = F.lane, w = F.wave, g = lane >> 3, l8 = lane & 7;
    LAS u64* META = (LAS u64*)(F.lds + w * 16384);
    const bool part = (F.nblk & 7) == 0;
    const int xv = part ? (F.bid & 7) : 0, r = part ? (F.bid >> 3) : F.bid, nr = part ? (F.nblk >> 3) : F.nblk, npass = part ? 1 : 8;
    const int qstride = nr * 8, nq = T / 8;
    for (int pass = 0; pass < npass; ++pass) {
        const int v = xv * npass + pass;
        const unsigned char* vbase = VT2 + v * 128 + l8 * 16;
        int q = r * 8 + w, buf = 0;
        if (q < nq) {
#pragma unroll
            for (int i = 0; i < 16; ++i) META[i * 64 + lane] = METAG[(size_t)q * 1024 + i * 64 + lane];
        }
        for (; q < nq; q += qstride) {
            const int qn = q + qstride;
            if (qn < nq) {
#pragma unroll
                for (int i = 0; i < 8; ++i) __builtin_amdgcn_global_load_lds((const unsigned*)((const unsigned char*)METAG + (size_t)qn * 8192 + i * 1024 + lane * 16), (LAS unsigned*)((LAS unsigned char*)(META + (buf ^ 1) * 1024) + i * 1024), 16, 0, 0); }
            const LAS u64* mp = META + buf * 1024 + g * 128;
            f32x2v acc[8];
#pragma unroll
            for (int k = 0; k < 8; ++k) acc[k] = (f32x2v){0.f, 0.f};
            u32x4 pa[16], pb[16];
            const LAS unsigned* mw = (const LAS unsigned*)mp;
#define P12B_LOAD(dst, c_) do { _Pragma("unroll") for (int i_ = 0; i_ < 16; ++i_) dst[i_] = *(const u32x4*)(vbase + (size_t)(mw[2 * ((c_) * 16 + i_)] & 0x3fffu) * 1024); } while (0)
#define P12B_FMA(srcb, c_) do { _Pragma("unroll") for (int i_ = 0; i_ < 16; ++i_) { const u32x4 p_ = srcb[i_]; const int wv_[4] = {(int)p_.x, (int)p_.y, (int)p_.z, (int)p_.w}; \
        const float cfv_ = __uint_as_float(mw[2 * ((c_) * 16 + i_) + 1]); const f32x2v cc_ = (f32x2v){cfv_, cfv_}; \
        _Pragma("unroll") for (int k_ = 0; k_ < 4; ++k_) { acc[2 * k_] += cc_ * __builtin_amdgcn_cvt_pk_f32_fp8(wv_[k_], false); acc[2 * k_ + 1] += cc_ * __builtin_amdgcn_cvt_pk_f32_fp8(wv_[k_], true); } } } while (0)
            P12B_LOAD(pa, 0);
#pragma unroll 1
            for (int cc = 0; cc < 3; ++cc) { P12B_LOAD(pb, 2 * cc + 1); P12B_FMA(pa, 2 * cc); P12B_LOAD(pa, 2 * cc + 2); P12B_FMA(pb, 2 * cc + 1); }
            P12B_LOAD(pb, 7); P12B_FMA(pa, 6); P12B_FMA(pb, 7);
#undef P12B_LOAD
#undef P12B_FMA
            { const size_t t = (size_t)q * 8 + g; const int c0 = v * 128 + l8 * 16;
              const float* xr = (t < (size_t)TP ? F.x_prompt + t * 1024 : F.x_sample + (t - TP) * 1024) + c0; const bf16_t* dr = Dm + t * 1024 + c0;
              const float* g2 = MOD + (size_t)mod_row((int)t) * NMOD + 5 * 1024 + c0; float* yr = F.out + t * 1024 + c0;
#pragma unroll
              for (int k = 0; k < 4; ++k) { const u32x2 dv = *(const u32x2*)(dr + 4 * k); const f32x4 xv4 = *(const f32x4*)(xr + 4 * k) + (f32x4){bf_lo(dv.x), bf_hi(dv.x), bf_lo(dv.y), bf_hi(dv.y)}, gv4 = *(const f32x4*)(g2 + 4 * k);
                  *(f32x4*)(yr + 4 * k) = xv4 + gv4 * (f32x4){acc[2 * k].x, acc[2 * k].y, acc[2 * k + 1].x, acc[2 * k + 1].y}; } }
            asm volatile("s_waitcnt vmcnt(0)" ::: "memory");
            buf ^= 1;
        }
    }
}


#ifndef SELF_CHECK
#define SELF_CHECK 0
#endif
#if SELF_CHECK
__device__ __forceinline__ void chk_fail(const Frame& F, size_t off) { F.out[off] = __uint_as_float(0x7fc00000u); }
__device__ __forceinline__ void self_check_mask(const Frame& F) {
    if (F.bid >= 18 || F.wave != 0) return;
    const int bs[3] = {0, 13, 31}; const int ts[6] = {255, 256, 300, 777, 1500, 2047};
    const int b = bs[F.bid / 6], t = ts[F.bid % 6], n = t + 1;
    const float* sc = WSP(float, WS_SCR) + ((size_t)b * 2048 + t) * 2048; const u64* mk = WSP(u64, WS_MASK) + ((size_t)b * 2048 + t) * 32;
    int bad = 0;
    for (int s = F.lane; s < 2048; s += 64) {
        bool sel = false;
        if (s < n) { const float v = sc[s]; int cnt = 0; for (int s2 = 0; s2 < n; ++s2) { const float v2 = sc[s2]; cnt += (v2 > v || (v2 == v && s2 < s)) ? 1 : 0; } sel = cnt < 256; }
        const bool got = (mk[s >> 6] >> (s & 63)) & 1ull;
        bad += (sel != got) ? 1 : 0;
    }
    if (__ballot(bad != 0) != 0ull && F.lane == 0) chk_fail(F, OFF_KP);
}
__device__ __forceinline__ void self_check_attn(const Frame& F) {
    if (F.bid >= 18) return;
    const int bs[3] = {0, 13, 31}; const int ts[6] = {0, 255, 256, 300, 1500, 2047};
    const int b = bs[F.bid / 6], t = ts[F.bid % 6], head = F.wave, kvh = head >> 2;
    const bf16_t* Q = WSP(bf16_t, WS_Q); const bf16_t* K = WSP(bf16_t, WS_K); const bf16_t* V = WSP(bf16_t, WS_V); const bf16_t* ATT = WSP(bf16_t, WS_ATT);
    const u64* mk = WSP(u64, WS_MASK) + ((size_t)b * 2048 + t) * 32;
    const size_t rq = (size_t)b * 2048 + t;
    float mx = -INFINITY;
    for (int s = F.lane; s <= t; s += 64) if ((mk[s >> 6] >> (s & 63)) & 1ull) { float d = 0.f; for (int e = 0; e < 64; ++e) d += bf2f(Q[rq * 512 + head * 64 + e]) * bf2f(K[((size_t)b * 2048 + s) * 128 + kvh * 64 + e]); mx = fmaxf(mx, d * 0.125f); }
    mx = wave_max(mx);
    float o[64]; float l = 0.f;
#pragma unroll
    for (int e = 0; e < 64; ++e) o[e] = 0.f;
    for (int s = F.lane; s <= t; s += 64) if ((mk[s >> 6] >> (s & 63)) & 1ull) { float d = 0.f; for (int e = 0; e < 64; ++e) d += bf2f(Q[rq * 512 + head * 64 + e]) * bf2f(K[((size_t)b * 2048 + s) * 128 + kvh * 64 + e]);
        const float p = __expf(d * 0.125f - mx); l += p;
#pragma unroll
        for (int e = 0; e < 64; ++e) o[e] += p * bf2f(V[((size_t)b * 2048 + s) * 128 + kvh * 64 + e]); }
    l = wave_sum(l); float err = 0.f, mag = 0.f;
#pragma unroll
    for (int e = 0; e < 64; ++e) { const float r = wave_sum(o[e]) / l; const float gts = bf2f(ATT[rq * 512 + head * 64 + e]); err = fmaxf(err, fabsf(r - gts)); mag = fmaxf(mag, fabsf(r)); }
    if (!(err <= 0.03f * mag + 2e-3f) && F.lane == 0) chk_fail(F, OFF_VP);
}
__device__ __forceinline__ void self_check_peer(const Frame& F) {
    if (F.bid >= 6) return;
    const int tsamp[6] = {0, 1000, 40000, 65535, 65536, 66047};
    const int t = tsamp[F.bid], tid = F.tid;
    const bf16_t* Q2 = WSP(bf16_t, WS_Q2); const bf16_t* H2 = WSP(bf16_t, WS_H); const int* EIDX = WSP(int, WS_EIDX); const float* G = WSP(float, WS_G);
    const bf16_t* Dm = WSP(bf16_t, WS_X1); const float* MOD = WSP(float, WS_MOD);
    LAS float* S = (LAS float*)F.lds;
    LAS int* REF = (LAS int*)(F.lds + 8192);
    LAS float* CO = (LAS float*)(F.lds + 8192 + 512);
    LAS int* CNTW = (LAS int*)(F.lds + 8192 + 1024);
    for (int i = tid; i < 2048; i += 512) { const int hp = i >> 7, key = i & 127, h = hp >> 1, p = hp & 1; float d = 0.f;
        for (int e = 0; e < 128; ++e) d += bf2f(Q2[(size_t)t * 2048 + h * 256 + p * 128 + e]) * F.peer_sub_keys[(((size_t)p * 8 + h) * 128 + key) * 128 + e];
        S[i] = d; }
    if (tid == 0) *CNTW = 0;
    __syncthreads();
    if (tid < 8) { const int h = tid; int i1[16], i2[16]; float s1[16], s2[16];
        for (int p = 0; p < 2; ++p) { const LAS float* sp = S + (h * 2 + p) * 128; int n = 0;
            for (int k = 0; k < 128; ++k) { int rank = 0; for (int k2 = 0; k2 < 128; ++k2) rank += (sp[k2] > sp[k] || (sp[k2] == sp[k] && k2 < k)) ? 1 : 0;
                if (rank < 16) { if (p == 0) { i1[rank] = k; s1[rank] = sp[k]; } else { i2[rank] = k; s2[rank] = sp[k]; } ++n; } } }
        for (int a = 0; a < 16; ++a) for (int c = 0; c < 16; ++c) { const float v = s1[a] + s2[c]; int rank = 0;
            for (int a2 = 0; a2 < 16; ++a2) for (int c2 = 0; c2 < 16; ++c2) { const float v2 = s1[a2] + s2[c2]; rank += (v2 > v || (v2 == v && (a2 * 16 + c2) < (a * 16 + c))) ? 1 : 0; }
            if (rank < 16) REF[h * 16 + rank] = i1[a] * 128 + i2[c]; } }
    __syncthreads();
    if (tid < 128) { const int h = tid >> 4; const int e = EIDX[(size_t)t * 128 + tid]; bool found = false; for (int k = 0; k < 16; ++k) found |= (REF[h * 16 + k] == e); if (!found) atomicAdd((int*)CNTW, 1); }
    __syncthreads();
    if (tid == 0 && *CNTW > 12) chk_fail(F, OFF_KIP);
    { const int slot = tid >> 2, part = tid & 3; const int e = EIDX[(size_t)t * 128 + slot]; float d = 0.f;
      for (int c = part * 256; c < part * 256 + 256; ++c) d += F.peer_u[(size_t)e * 1024 + c] * bf2f(H2[(size_t)t * 1024 + c]);
      d += __shfl_xor(d, 1); d += __shfl_xor(d, 2);
      if (part == 0) CO[slot] = G[(size_t)t * 128 + slot] * gelu_tanh(d); }
    __syncthreads();
    float err = 0.f, mag = 0.f;
    for (int c = tid; c < 1024; c += 512) { float o = 0.f; for (int slot = 0; slot < 128; ++slot) o += CO[slot] * F.peer_v[(size_t)EIDX[(size_t)t * 128 + slot] * 1024 + c];
        const float g2 = MOD[(size_t)mod_row(t) * NMOD + 5 * 1024 + c]; const float ref = g2 * o, got = F.out[(size_t)t * 1024 + c] - ((t < TP ? F.x_prompt[(size_t)t * 1024 + c] : F.x_sample[(size_t)(t - TP) * 1024 + c]) + bf2f(Dm[(size_t)t * 1024 + c]));
        err = fmaxf(err, fabsf(ref - got)); mag = fmaxf(mag, fabsf(ref)); }
    err = wave_max(err); mag = wave_max(mag);
    LAS float* RED = (LAS float*)(F.lds + 8192 + 2048);
    if (F.lane == 0) { RED[F.wave] = err; RED[8 + F.wave] = mag; }
    __syncthreads();
    if (tid == 0) { float e2 = 0.f, m2 = 0.f; for (int w = 0; w < 8; ++w) { e2 = fmaxf(e2, RED[w]); m2 = fmaxf(m2, RED[8 + w]); } if (!(e2 <= 0.12f * m2 + 1e-4f)) chk_fail(F, OFF_CONVP); }
}
#endif

constexpr int N_PHASES = 15;
__global__ void __launch_bounds__(512, 2) fwd_kernel(Params P) {
    extern __shared__ __attribute__((aligned(16))) unsigned char lds_raw[];
    Frame F;
    F.lds = (LAS unsigned char*)lds_raw; F.tid = threadIdx.x; F.lane = F.tid & 63; F.wave = __builtin_amdgcn_readfirstlane(F.tid >> 6); F.bid = blockIdx.x; F.nblk = gridDim.x;
    F.ws = P.ws; F.ctl = (unsigned*)(P.ws + WS_CTL); F.out = P.out;
    F.x_prompt = P.in[0]; F.x_sample = P.in[1]; F.cache_k = P.in[2]; F.cache_v = P.in[3]; F.cache_kidx = P.in[4]; F.state_conv = P.in[5]; F.page_table = (const int*)P.in[6];
    F.c_prompt = P.in[7]; F.c_sample = P.in[8]; F.w_ada = P.in[9]; F.b_ada = P.in[10]; F.norm1_w = P.in[11]; F.w_in = P.in[12]; F.conv_w = P.in[13]; F.q_norm_w = P.in[14]; F.k_norm_w = P.in[15];
    F.w_conv_out = P.in[16]; F.w_attn_out = P.in[17]; F.w_out = P.in[18]; F.norm2_w = P.in[19]; F.peer_w_q = P.in[20]; F.peer_sub_keys = P.in[21]; F.peer_u = P.in[22]; F.peer_v = P.in[23];
    if (F.tid < 16) ((LAS unsigned*)(F.lds + LDS_MISC))[F.tid] = 0u;
    __syncthreads();
    const int lo = P.ph_lo, hi = P.ph_hi;
    const bool one = (hi - lo) > 1;
    XcdBarrier bar; bar.bar = F.ctl + CW_BAR; bar.x = 0; bar.st = nullptr;
    if (one) bar = xcd_barrier_post(F.ctl + CW_BAR, (volatile LAS unsigned*)(F.lds + LDS_MISC));
#define IN(k) (lo <= (k) && (k) < hi)
#define SEAM(k) do { if (IN(k) && IN((k) + 1)) xcd_barrier(bar); } while (0)

#define PHASE(k, ...) do { if (IN(k)) { const int rep = 0; __VA_ARGS__; } SEAM(k); } while (0)

    PHASE(0, p0_convert(F));
    PHASE(1, {
        float* MODw = WSP(float, WS_MOD); const float* bias = F.b_ada;
        skinny_phase<false>(F, WSP(bf16_t, WS_CB), WSP(bf16_t, WS_WADA), nullptr, nullptr, 1024, 1024, NMOD, 0, 3, [=](int r, int c, const float (&s01)[4], const float (&s23)[4]) {
            const f32x4 bv = *(const f32x4*)(bias + c);
            *(f32x4*)(MODw + (size_t)r * NMOD + c) = (f32x4){s01[0] + s23[0] + bv[0], s01[1] + s23[1] + bv[1], s01[2] + s23[2] + bv[2], s01[3] + s23[3] + bv[3]}; }); });
    PHASE(2, row_norm_pass<false>(F));
    PHASE(3, {
        pg8::Gemm g{WSP(bf16_t, WS_H), WSP(bf16_t, WS_WIN), T, NPROJ_PAD, 1024, 1024, 1024, 0}; pg8::StaticOrder S; S.init(T, NPROJ_PAD, F.nblk, F.bid);
        EpiInProj E{WSP(bf16_t, WS_U), WSP(bf16_t, WS_BG), WSP(bf16_t, WS_Q), WSP(bf16_t, WS_K), WSP(bf16_t, WS_V), WSP(bf16_t, WS_QI), WSP(bf16_t, WS_KI), WSP(bf16_t, WS_SGA), WSP(bf16_t, WS_SGB),
                    WSP(float, WS_WI), F.q_norm_w, F.k_norm_w, WSP(f32x2, WS_ROPE), F.out};
        pg8::gemm_phase(F.lds, g, S, E); });
    PHASE(4, p4_all(F, rep, P.pad));
#if SELF_CHECK
#define SC_MASK() self_check_mask(F)
#define SC_ATTN() self_check_attn(F)
#else
#define SC_MASK() do {} while (0)
#define SC_ATTN() do {} while (0)
#endif
    PHASE(5, { SC_MASK(); p5_all(F, rep); });
    PHASE(6, { SC_ATTN();
        { pg8::Gemm g{WSP(bf16_t, WS_APRE), WSP(bf16_t, WS_WCO), TP, 1024, 1024, 512, 512, 0, WSP(bf16_t, WS_ATT), WSP(bf16_t, WS_WAO)}; pg8::StaticOrder S; S.init(TP, 1024, F.nblk, F.bid);
          EpiMixFused E{WSP(bf16_t, WS_SGA), WSP(bf16_t, WS_SGB), WSP(bf16_t, WS_MIX)}; pg8::gemm_phase<EpiMixFused, pg8::StaticOrder, true, true, true>(F.lds, g, S, E); }
        { const bf16_t* SGA = WSP(bf16_t, WS_SGA); const bf16_t* SGB = WSP(bf16_t, WS_SGB); bf16_t* MIX = WSP(bf16_t, WS_MIX);
          skinny_phase<true>(F, WSP(bf16_t, WS_APRE), WSP(bf16_t, WS_WCO), WSP(bf16_t, WS_ATT), WSP(bf16_t, WS_WAO), 512, 512, 1024, TP, 8, [=](int r, int c, const float (&s01)[4], const float (&s23)[4]) {
              const size_t o = (size_t)r * 1024 + c; const u32x2 ga = *(const u32x2*)(SGA + o), gb = *(const u32x2*)(SGB + o);
              u32x2 m; m.x = cvt_pk_bf16(bf_lo(ga.x) * s01[0] + bf_lo(gb.x) * s23[0], bf_hi(ga.x) * s01[1] + bf_hi(gb.x) * s23[1]);
              m.y = cvt_pk_bf16(bf_lo(ga.y) * s01[2] + bf_lo(gb.y) * s23[2], bf_hi(ga.y) * s01[3] + bf_hi(gb.y) * s23[3]); *(u32x2*)(MIX + o) = m; }); } });
    PHASE(7, {
        pg8::Gemm g{WSP(bf16_t, WS_MIX), WSP(bf16_t, WS_WOUT), TP, 1024, 1024, 1024, 1024, 0}; pg8::StaticOrder S; S.init(TP, 1024, F.nblk, F.bid);
        EpiOut E{WSP(float, WS_MOD), WSP(bf16_t, WS_X1)}; pg8::gemm_phase(F.lds, g, S, E);
        { const float* MOD = WSP(float, WS_MOD); bf16_t* Dm = WSP(bf16_t, WS_X1);
          skinny_phase<false>(F, WSP(bf16_t, WS_MIX), WSP(bf16_t, WS_WOUT), nullptr, nullptr, 1024, 1024, 1024, TP, 8, [=](int r, int c, const float (&s01)[4], const float (&s23)[4]) {
              const f32x4 g1 = *(const f32x4*)(MOD + (size_t)mod_row(r) * NMOD + 2048 + c);
              u32x2 d; d.x = cvt_pk_bf16(g1[0] * (s01[0] + s23[0]), g1[1] * (s01[1] + s23[1])); d.y = cvt_pk_bf16(g1[2] * (s01[2] + s23[2]), g1[3] * (s01[3] + s23[3]));
              *(u32x2*)(Dm + (size_t)r * 1024 + c) = d; }); } });
    PHASE(8, row_norm_pass<true>(F));
    PHASE(9, {
        pg8::Gemm g{WSP(bf16_t, WS_H), WSP(bf16_t, WS_WQ), TP, 2048, 1024, 1024, 1024, 0}; pg8::StaticOrder S; S.init(TP, 2048, F.nblk, F.bid);
        EpiBf16Plain E{WSP(bf16_t, WS_Q2), 2048}; pg8::gemm_phase(F.lds, g, S, E);
        { bf16_t* Q2 = WSP(bf16_t, WS_Q2);
          skinny_phase<false>(F, WSP(bf16_t, WS_H), WSP(bf16_t, WS_WQ), nullptr, nullptr, 1024, 1024, 2048, TP, 8, [=](int r, int c, const float (&s01)[4], const float (&s23)[4]) {
              u32x2 d; d.x = cvt_pk_bf16(s01[0] + s23[0], s01[1] + s23[1]); d.y = cvt_pk_bf16(s01[2] + s23[2], s01[3] + s23[3]); *(u32x2*)(Q2 + (size_t)r * 2048 + c) = d; }); } });
    PHASE(10, {
        pg8::Gemm g{WSP(bf16_t, WS_Q2), WSP(bf16_t, WS_SKBD), TP, 2048, 256, 2048, 256, 256}; pg8::StaticOrder S; S.init(TP, 2048, F.nblk, F.bid);
        EpiPST E{WSP(unsigned short, WS_SCR)}; pg8::gemm_phase<EpiPST, pg8::StaticOrder, false, false>(F.lds, g, S, E);
        { unsigned short* PST = WSP(unsigned short, WS_SCR);
          auto fin = [=](int r, int c, const float (&s01)[4], const float (&s23)[4]) {
              u32x2 d; d.x = cvt_pk_f16(s01[0] + s23[0], s01[1] + s23[1]); d.y = cvt_pk_f16(s01[2] + s23[2], s01[3] + s23[3]);
              *(u32x2*)(PST + (size_t)((r >> 8) * 8 + (c >> 8)) * 65536 + (size_t)(r & 255) * 256 + (c & 255)) = d; };
          skinny_phase<false, decltype(fin), 64>(F, WSP(bf16_t, WS_Q2), WSP(bf16_t, WS_SKBD), nullptr, nullptr, 2048, 256, 2048, TP, 8, fin, 256); } });
    PHASE(11, p11_select(F));
    PHASE(12, p12a_act(F, P.pad));
    PHASE(13, p12c_coef(F));
    PHASE(14, p12b_out(F));
#if SELF_CHECK
    xcd_barrier(bar);
    self_check_peer(F);
#endif
#undef PHASE
#undef IN
#undef SEAM
}

extern "C" void kernel_launch(void* const* d_in, const int* in_sizes, int n_in, void* d_out, int out_size, void* d_ws, size_t ws_size, hipStream_t stream) {
    static int grid = 0;
    if (grid == 0) {
        if (n_in != 24 || (size_t)out_size != OUT_TOTAL || ws_size < WS_END) { fprintf(stderr, "kernel_launch: unexpected sizes n_in %d out %d ws %zu (need %zu)\n", n_in, out_size, ws_size, (size_t)WS_END); grid = -1; return; }
        int dev = 0, cus = 0, per_cu = 0;
        if (hipGetDevice(&dev) != hipSuccess || hipDeviceGetAttribute(&cus, hipDeviceAttributeMultiprocessorCount, dev) != hipSuccess) { grid = -1; return; }
        if (hipFuncSetAttribute((const void*)fwd_kernel, hipFuncAttributeMaxDynamicSharedMemorySize, LDS_BYTES) != hipSuccess) { fprintf(stderr, "kernel_launch: hipFuncSetAttribute failed\n"); grid = -1; return; }
        if (hipOccupancyMaxActiveBlocksPerMultiprocessor(&per_cu, (const void*)fwd_kernel, 512, LDS_BYTES) != hipSuccess || per_cu < 1) { fprintf(stderr, "kernel_launch: occupancy query says %d\n", per_cu); }
        (void)hipGetLastError();
        grid = cus;
    }
    if (grid < 0) return;
    (void)hipMemsetAsync((char*)d_ws + WS_CTL, 0, CTL_BYTES, stream);
    Params p{};
    for (int i = 0; i < 24; ++i) p.in[i] = (const float*)d_in[i];
    p.out = (float*)d_out; p.ws = (unsigned char*)d_ws; p.rep_mask = 0; p.pad = 15;
#if N_LAUNCH_MODE == 1
    p.ph_lo = 0; p.ph_hi = N_PHASES;
    hipLaunchKernelGGL(fwd_kernel, dim3(grid), dim3(512), LDS_BYTES, stream, p);
#else
    for (int k = 0; k < N_PHASES; ++k) { p.ph_lo = k; p.ph_hi = k + 1; hipLaunchKernelGGL(fwd_kernel, dim3(grid), dim3(512), LDS_BYTES, stream, p);
        if ((REPEAT_MASK >> k) & 1) { (void)hipMemsetAsync((char*)d_ws + WS_CTL, 0, CTL_BYTES, stream); p.pad = PROBE_PARTS; hipLaunchKernelGGL(fwd_kernel, dim3(grid), dim3(512), LDS_BYTES, stream, p); p.pad = 15; } }
#endif
}
```

```cpp
#include <hip/hip_runtime.h>
#include <cstdio>
#include <cstdint>

#ifndef N_LAUNCH_MODE
#define N_LAUNCH_MODE 1
#endif

#define REPEAT_MASK 0x0000

#define PROBE_PARTS 15
#define LAS __attribute__((address_space(3)))
typedef unsigned short bf16_t;
typedef short bf16x8 __attribute__((ext_vector_type(8)));
typedef short bf16x4 __attribute__((ext_vector_type(4)));
typedef float f32x4 __attribute__((ext_vector_type(4)));
typedef float f32x2 __attribute__((ext_vector_type(2)));
typedef float f32x16 __attribute__((ext_vector_type(16)));
typedef unsigned u32x4 __attribute__((ext_vector_type(4)));
typedef unsigned u32x2 __attribute__((ext_vector_type(2)));
typedef unsigned long long u64;

constexpr int D = 1024, TP = 65536, TS = 512, T = TP + TS, SEQ = 2048, NB = 32, DB = 128, DS = 4;
constexpr int PAST = 8192, PAGE = 128, NPG = 64;
constexpr int NPROJ = 4936, NPROJ_PAD = 5120;
constexpr int NMOD = 6144;
constexpr float NORM_EPS = 1e-6f;
constexpr float IDX_SCALE = 0.125f * 0.35355339059327373f;
constexpr size_t OFF_Y = 0;
constexpr size_t OFF_KP = (size_t)T * D;
constexpr size_t OFF_VP = OFF_KP + (size_t)TP * 128;
constexpr size_t OFF_KIP = OFF_VP + (size_t)TP * 128;
constexpr size_t OFF_CONVP = OFF_KIP + (size_t)TP * 64;
constexpr size_t OFF_KS = OFF_CONVP + (size_t)NB * 2 * 512;
constexpr size_t OFF_VS = OFF_KS + (size_t)TS * 128;
constexpr size_t OFF_KIS = OFF_VS + (size_t)TS * 128;
constexpr size_t OFF_CONVS = OFF_KIS + (size_t)TS * 64;
constexpr size_t OUT_TOTAL = OFF_CONVS + (size_t)DB * 2 * 512;
static_assert(OUT_TOTAL == 88932352, "out size");

constexpr size_t al256(size_t x) { return (x + 255) & ~(size_t)255; }
constexpr size_t WS_CTL = 0;
constexpr size_t CTL_BYTES = 65536;
constexpr size_t WS_WIN = WS_CTL + CTL_BYTES;
constexpr size_t WS_WCO = WS_WIN + (size_t)NPROJ_PAD * 1024 * 2;
constexpr size_t WS_WAO = WS_WCO + (size_t)1024 * 512 * 2;
constexpr size_t WS_WOUT = WS_WAO + (size_t)1024 * 512 * 2;
constexpr size_t WS_WQ = WS_WOUT + (size_t)1024 * 1024 * 2;
constexpr size_t WS_SKBD = WS_WQ + (size_t)2048 * 1024 * 2;
constexpr size_t WS_UT = WS_SKBD + (size_t)2048 * 256 * 2;
constexpr size_t WS_VT2 = WS_UT + (size_t)16384 * 1024;
constexpr size_t WS_TSC = WS_VT2 + (size_t)16384 * 1024;
constexpr size_t WS_WADA = WS_TSC + (size_t)2 * 16384 * 4;
constexpr size_t WS_CB = WS_WADA + (size_t)NMOD * 1024 * 2;
constexpr size_t WS_MOD = WS_CB + (size_t)256 * 1024 * 2;
constexpr size_t WS_ROPE = WS_MOD + (size_t)256 * NMOD * 4;
constexpr size_t WS_H = al256(WS_ROPE + (size_t)2052 * 32 * 8);
constexpr size_t WS_U = WS_H + (size_t)T * 1024 * 2;
constexpr size_t WS_BG = WS_U + (size_t)T * 512 * 2;
constexpr size_t WS_Q = WS_BG + (size_t)T * 512 * 2;
constexpr size_t WS_K = WS_Q + (size_t)T * 512 * 2;
constexpr size_t WS_V = WS_K + (size_t)T * 128 * 2;
constexpr size_t WS_VTR = WS_V + (size_t)T * 128 * 2;
constexpr size_t WS_QI = WS_VTR + (size_t)TP * 128 * 2;
constexpr size_t WS_KI = WS_QI + (size_t)T * 512 * 2;
constexpr size_t WS_WI = WS_KI + (size_t)T * 64 * 2;
constexpr size_t WS_SGA = WS_WI + (size_t)T * 8 * 4;
constexpr size_t WS_SGB = WS_SGA + (size_t)T * 1024 * 2;
constexpr size_t WS_MASK = WS_SGB + (size_t)T * 1024 * 2;
constexpr size_t WS_APRE = WS_MASK + (size_t)TP * 32 * 8;
constexpr size_t WS_ATT = WS_APRE + (size_t)T * 512 * 2;
constexpr size_t WS_MIX = WS_ATT + (size_t)T * 512 * 2;
constexpr size_t WS_Q2 = WS_MIX + (size_t)T * 1024 * 2;
constexpr size_t WS_EIDX = WS_Q2 + (size_t)T * 2048 * 2;
constexpr size_t WS_G = WS_EIDX + (size_t)T * 128 * 4;
constexpr size_t WS_SCR = WS_G + (size_t)T * 128 * 4;
constexpr size_t SCR_BYTES = (size_t)T * 2048 * 4;
constexpr size_t WS_X1 = WS_SCR + SCR_BYTES;
constexpr size_t WS_ACT = WS_X1 + (size_t)T * 1024 * 4;
constexpr size_t WS_LISTG = WS_ACT + (size_t)T * 128 * 4;
constexpr size_t WS_METAG = WS_LISTG + (size_t)256 * 8192 * 4;
constexpr size_t WS_END = WS_METAG + (size_t)T * 128 * 8;

constexpr int CW_BAR = 0;
constexpr int CW_Q4 = 4096;
constexpr int CW_Q5 = 8192;

constexpr int LDS_BYTES = 155648;
constexpr int LDS_MISC = 155648 - 64;

#define XB_TMO      128
#define XB_XCNT(j)  (256  + 64 * (j))
#define XB_XSUB(j)  (1280 + 64 * (j))
#define XB_XGEN(j)  (2304 + 64 * (j))
#define XB_TOP      3328
#define XB_TOPGEN   3392
#define XCD_BAR_WORDS 3456
#define XB_SPIN_CAP (1u << 18)

__device__ __forceinline__ unsigned xb_ld(unsigned* p)              { return __hip_atomic_load(p, __ATOMIC_RELAXED, __HIP_MEMORY_SCOPE_AGENT); }
__device__ __forceinline__ unsigned xb_add(unsigned* p, unsigned v) { return __hip_atomic_fetch_add(p, v, __ATOMIC_RELAXED, __HIP_MEMORY_SCOPE_AGENT); }
__device__ __forceinline__ unsigned xb_xcc_id() { return (unsigned)__builtin_amdgcn_s_getreg((3 << 11) | 20) & 0xFu; }
#define XB_SPIN(cond, bar) do { unsigned _sp = 0; while (cond) { __builtin_amdgcn_s_sleep(1); \
    if ((++_sp & 255u) == 0u) { if (xb_ld(&(bar)[XB_TMO])) break; if (_sp > XB_SPIN_CAP) { atomicAdd(&(bar)[XB_TMO], 1u); break; } } } } while (0)

struct XcdBarrier { unsigned* bar; unsigned x; volatile LAS unsigned* st; };

__device__ __forceinline__ XcdBarrier xcd_barrier_post(unsigned* bar, volatile LAS unsigned* st) {
    XcdBarrier b; b.bar = bar; b.x = xb_xcc_id(); b.st = st;
    if (threadIdx.x == 0) (void)xb_add(&bar[XB_XCNT(b.x)], 1u);
    return b;
}
__device__ __forceinline__ void xcd_barrier_complete(unsigned* bar, unsigned x, unsigned& nloc, unsigned& nx) {
    const unsigned G = gridDim.x * gridDim.y * gridDim.z;
    unsigned sum, cnt, mine, sp = 0u;
    for (;;) {
        sum = 0u; cnt = 0u; mine = 0u;
#pragma unroll
        for (unsigned j = 0; j < 16; ++j) { const unsigned c = xb_ld(&bar[XB_XCNT(j)]); sum += c; cnt += (c > 0u) ? 1u : 0u; mine = (j == x) ? c : mine; }
        if (sum == G) break;
        __builtin_amdgcn_s_sleep(1);
        if ((++sp & 255u) == 0u) { if (xb_ld(&bar[XB_TMO])) break; if (sp > XB_SPIN_CAP) { atomicAdd(&bar[XB_TMO], 1u); break; } }
    }
    nloc = mine > 0u ? mine : 1u; nx = cnt > 0u ? cnt : 1u;
}
__device__ __forceinline__ void xcd_barrier(const XcdBarrier& b) {
    asm volatile("s_waitcnt vmcnt(0)" ::: "memory");
    __syncthreads();
    if (threadIdx.x == 0) {
        unsigned* bar = b.bar;
        __builtin_amdgcn_s_waitcnt(0);
        unsigned nloc = b.st[0], nx = b.st[1];
        if (nloc == 0u) { xcd_barrier_complete(bar, b.x, nloc, nx); b.st[0] = nloc; b.st[1] = nx; }
        const unsigned old = xb_add(&bar[XB_XSUB(b.x)], 1u);
        const unsigned gen = old / nloc;
        if (old + 1u == (gen + 1u) * nloc) {
            __builtin_amdgcn_fence(__ATOMIC_RELEASE, "agent");
            asm volatile("s_waitcnt vmcnt(0)" ::: "memory");
            const unsigned og = xb_add(&bar[XB_TOP], 1u);
            const unsigned tg = og / nx;
            if (og + 1u == (tg + 1u) * nx) xb_add(&bar[XB_TOPGEN], 1u);
            else XB_SPIN(xb_ld(&bar[XB_TOPGEN]) == tg, bar);
            __builtin_amdgcn_fence(__ATOMIC_ACQUIRE, "agent");
            xb_add(&bar[XB_XGEN(b.x)], 1u);
            asm volatile("s_waitcnt vmcnt(0)" ::: "memory");
        } else {
            XB_SPIN(xb_ld(&bar[XB_XGEN(b.x)]) == gen, bar);
            __builtin_amdgcn_fence(__ATOMIC_ACQUIRE, "agent");
            asm volatile("s_waitcnt vmcnt(0)" ::: "memory");
        }
    }
    __syncthreads();
}

typedef __bf16 cvtbf2_t __attribute__((ext_vector_type(2)));
__device__ __forceinline__ unsigned cvt_pk_bf16(float lo, float hi) { const cvtbf2_t v = __builtin_convertvector((f32x2){lo, hi}, cvtbf2_t); return __builtin_bit_cast(unsigned, v); }
__device__ __forceinline__ float bf_lo(unsigned u) { return __uint_as_float(u << 16); }
__device__ __forceinline__ float bf_hi(unsigned u) { return __uint_as_float(u & 0xffff0000u); }
__device__ __forceinline__ float bf2f(bf16_t b) { return __uint_as_float(((unsigned)b) << 16); }
__device__ __forceinline__ u32x4 pack8(const float (&v)[8]) { u32x4 w; w.x = cvt_pk_bf16(v[0], v[1]); w.y = cvt_pk_bf16(v[2], v[3]); w.z = cvt_pk_bf16(v[4], v[5]); w.w = cvt_pk_bf16(v[6], v[7]); return w; }
__device__ __forceinline__ void unpack8(const u32x4 w, float (&v)[8]) { v[0] = bf_lo(w.x); v[1] = bf_hi(w.x); v[2] = bf_lo(w.y); v[3] = bf_hi(w.y); v[4] = bf_lo(w.z); v[5] = bf_hi(w.z); v[6] = bf_lo(w.w); v[7] = bf_hi(w.w); }
__device__ __forceinline__ unsigned mono(float v) { const unsigned u = __float_as_uint(v); return (u & 0x80000000u) ? ~u : (u | 0x80000000u); }
__device__ __forceinline__ float unmono(unsigned k) { const unsigned u = (k & 0x80000000u) ? (k & 0x7fffffffu) : ~k; return __uint_as_float(u); }
__device__ __forceinline__ float sigmoidf_(float x) { return __builtin_amdgcn_rcpf(1.0f + __expf(-x)); }
__device__ __forceinline__ float gelu_tanh(float x) { const float u = 0.7978845608028654f * (x + 0.044715f * x * x * x); const float e = __expf(2.0f * u); const float th = 1.0f - 2.0f * __builtin_amdgcn_rcpf(e + 1.0f); return 0.5f * x * (1.0f + th); }
__device__ __forceinline__ int mbcnt64(u64 m) { return (int)__builtin_amdgcn_mbcnt_hi((unsigned)(m >> 32), __builtin_amdgcn_mbcnt_lo((unsigned)m, 0u)); }
__device__ __forceinline__ float wave_sum(float v) {
#pragma unroll
    for (int o = 32; o > 0; o >>= 1) v += __shfl_xor(v, o);
    return v;
}
__device__ __forceinline__ float wave_max(float v) {
#pragma unroll
    for (int o = 32; o > 0; o >>= 1) v = fmaxf(v, __shfl_xor(v, o));
    return v;
}

namespace pg8 {
constexpr int BM = 256, BK = 64, HALF = 128, HTB = HALF * BK * 2, STAGE_BYTES = 8 * HTB, NXCD = 8, WGM = 8;
__host__ __device__ __forceinline__ int lds_byte(int r, int c) { const int st = (r >> 4) * 2 + (c >> 5), rr = r & 15, cc = c & 31, ob = rr * 64 + cc * 2; return st * 1024 + (ob ^ (((ob >> 9) & 1) << 5)); }
__host__ __device__ __forceinline__ void stage_rc(int b, int& R, int& C) { const int st = b / 1024, sb = b % 1024, swz = sb ^ (((sb >> 9) & 1) << 5); R = (st >> 1) * 16 + swz / 64; C = (st & 1) * 32 + (swz % 64) / 2; }
__host__ __device__ __forceinline__ int perm32(int rho) { const int n = rho >> 4, i = rho & 15; return 8 * (i >> 2) + 4 * n + (i & 3); }

struct Unit { int pm, pn; };
struct Gemm { const bf16_t* A; const bf16_t* Bt; int M, N, K, lda, ldb, a_pn_cols; const bf16_t* A2 = nullptr; const bf16_t* Bt2 = nullptr; };

struct StaticOrder {
    int nM, nN, nwg, G, c;
    __host__ __device__ void init(int M, int N, int G_, int c_) { nM = M / BM; nN = N / BM; nwg = nM * nN; G = G_; c = c_; }
    __host__ __device__ bool next(int i, Unit& u) const {
        const long L = (long)i * G + c; if (L >= nwg) return false;
        int wgid = (int)L; { const int q = nwg / NXCD, r = nwg % NXCD, xcd = wgid % NXCD, off = wgid / NXCD; wgid = (xcd < r ? xcd * (q + 1) : r * (q + 1) + (xcd - r) * q) + off; }
        const int nig = WGM * nN, gid = wgid / nig, fm = gid * WGM, gsz = (nM - fm) < WGM ? (nM - fm) : WGM;
        u.pm = fm + ((wgid % nig) % gsz); u.pn = (wgid % nig) / gsz; return true;
    }
    __device__ __forceinline__ void a_ready(const Unit&) const {}
    __device__ __forceinline__ void done(const Unit&) const {}
};

template <class Epi, class Sched, bool ALIGN_EPI = true, bool SP2 = true, bool DUAL = false>
__device__ __forceinline__ void gemm_phase(LAS unsigned char* lds, const Gemm g, const Sched& S, const Epi& E) {
    const int tid = threadIdx.x, wid = __builtin_amdgcn_readfirstlane(tid >> 6), lane = tid & 63, wr = wid >> 2, wc = wid & 3, fr = lane & 15, fq = lane >> 4;
    const int K = g.K, nt = K / BK;
    unsigned voffA[2], voffB[2];
#pragma unroll
    for (int i = 0; i < 2; ++i) { int R, C; stage_rc(tid * 16 + i * 8192, R, C); const int Rb = Epi::PERM ? ((R & ~31) + perm32(R & 31)) : R;
        voffA[i] = (unsigned)(R * g.lda + C) * 2u; voffB[i] = (unsigned)(Rb * g.ldb + C) * 2u; }
    const size_t kstep = (size_t)(BK * 2);
    const int nh = nt / 2;
    const long dA = DUAL ? ((const char*)g.A2 - (const char*)g.A) - (long)nh * (long)kstep : 0, dB = DUAL ? ((const char*)g.Bt2 - (const char*)g.Bt) - (long)nh * (long)kstep : 0;
    const size_t hstepA = (size_t)HALF * g.lda * 2, hstepB = (size_t)HALF * g.ldb * 2;
    const size_t tstepA = 2 * hstepA, tstepB = 2 * hstepB;
    const size_t pnstepA = (size_t)g.a_pn_cols * 2;
    const unsigned ldsw = (unsigned)wid * 1024u;
    const int aoff = lds_byte(wr * 64 + fr, fq * 8), boff = lds_byte(wc * 32 + fr, fq * 8);
#define PG8_SA(b, h) (((b) * 2 + (h)) * HTB)
#define PG8_SB(b, h) ((4 + (b) * 2 + (h)) * HTB)
#define PG8_STAGE(bufoff, gbase, voff) do { _Pragma("unroll") for (int _i = 0; _i < 2; ++_i) \
        __builtin_amdgcn_global_load_lds((const unsigned*)((const char*)(gbase) + (voff)[_i]), (LAS unsigned*)(lds + (bufoff) + ldsw + _i * 8192), 16, 0, 0); } while (0)
#define PG8_LDA(dst, b, h) do { _Pragma("unroll") for (int m = 0; m < 4; ++m) _Pragma("unroll") for (int k = 0; k < 2; ++k) dst[m][k] = *(const LAS bf16x8*)(lds + PG8_SA(b, h) + aoff + m * 2048 + k * 1024); } while (0)
#define PG8_LDB(dst, b, h) do { _Pragma("unroll") for (int n = 0; n < 2; ++n) _Pragma("unroll") for (int k = 0; k < 2; ++k) dst[n][k] = *(const LAS bf16x8*)(lds + PG8_SB(b, h) + boff + n * 2048 + k * 1024); } while (0)
#define PG8_MMA(ai, bj, At, Bt) do { __builtin_amdgcn_s_setprio(1); _Pragma("unroll") for (int m = 0; m < 4; ++m) _Pragma("unroll") for (int n = 0; n < 2; ++n) _Pragma("unroll") for (int k = 0; k < 2; ++k) \
        acc[ai][bj][m][n] = __builtin_amdgcn_mfma_f32_16x16x32_bf16(Bt[n][k], At[m][k], acc[ai][bj][m][n], 0, 0, 0); __builtin_amdgcn_s_setprio(0); } while (0)
#define PG8_WAIT_V(n) asm volatile("s_waitcnt vmcnt(" #n ")" ::: "memory")
#define PG8_WAIT_L(n) asm volatile("s_waitcnt lgkmcnt(" #n ")" ::: "memory")
#define PG8_BAR __builtin_amdgcn_s_barrier()
#define PG8_SCHED __builtin_amdgcn_sched_barrier(0)
#define PG8_UA(u_) ((const char*)g.A + (size_t)(u_).pm * tstepA + (size_t)(u_).pn * pnstepA)
#define PG8_UB(u_) ((const char*)g.Bt + (size_t)(u_).pn * tstepB)
    Unit cur, nxt; int ui = 0;
    if (!S.next(0, cur)) return;
    f32x4 acc[2][2][4][2];
#pragma unroll
    for (int a = 0; a < 2; ++a)
#pragma unroll
        for (int b = 0; b < 2; ++b)
#pragma unroll
            for (int m = 0; m < 4; ++m)
#pragma unroll
                for (int n = 0; n < 2; ++n) acc[a][b][m][n] = (f32x4){0.f, 0.f, 0.f, 0.f};
    bf16x8 At[4][2], B0[2][2], B1[2][2];
    const char* cA = PG8_UA(cur); const char* cB = PG8_UB(cur);
    S.a_ready(cur);
    if constexpr (SP2) {
        PG8_STAGE(PG8_SB(0, 0), cB, voffB); PG8_STAGE(PG8_SB(0, 1), cB + hstepB, voffB); PG8_STAGE(PG8_SA(0, 0), cA, voffA); PG8_STAGE(PG8_SA(0, 1), cA + hstepA, voffA);
        if (wr == 1) PG8_BAR;
        PG8_WAIT_V(2); PG8_BAR;
        PG8_STAGE(PG8_SB(1, 0), cB + kstep, voffB); PG8_STAGE(PG8_SA(1, 0), cA + kstep, voffA); PG8_STAGE(PG8_SB(1, 1), cB + hstepB + kstep, voffB);
        PG8_WAIT_V(6); PG8_BAR;
    } else {
        PG8_STAGE(PG8_SB(0, 0), cB, voffB); PG8_STAGE(PG8_SA(0, 0), cA, voffA); PG8_STAGE(PG8_SB(0, 1), cB + hstepB, voffB); PG8_STAGE(PG8_SA(0, 1), cA + hstepA, voffA);
        if (wr == 1) PG8_BAR;
        PG8_WAIT_V(4); PG8_BAR;
        PG8_STAGE(PG8_SB(1, 0), cB + kstep, voffB); PG8_STAGE(PG8_SA(1, 0), cA + kstep, voffA); PG8_STAGE(PG8_SB(1, 1), cB + hstepB + kstep, voffB);
        PG8_WAIT_V(6); PG8_BAR;
    }
    for (;;) {
        const bool has_next = S.next(ui + 1, nxt);
        const char* nA = has_next ? PG8_UA(nxt) : cA; const char* nB = has_next ? PG8_UB(nxt) : cB;
        for (int t = 0; t < nt; t += 2) {
            const bool last = (t == nt - 2);
            const char* a1 = cA + (size_t)(t + 1) * kstep;
            const char* a2 = last ? nA : cA + (size_t)(t + 2) * kstep; const char* b2 = last ? nB : cB + (size_t)(t + 2) * kstep;
            if constexpr (DUAL) {
                if (t >= nh) a1 += dA;
                if (!last && t + 2 >= nh) { a2 += dA; b2 += dB; }
                if (t == nh) E.mid(acc, cur, wr, wc, fr, fq);
            }
            const char* a3 = a2 + kstep; const char* b3 = b2 + kstep;
            if (last && has_next) S.a_ready(nxt);
            if constexpr (SP2) {
            PG8_LDB(B0, 0, 0); PG8_LDB(B1, 0, 1); PG8_SCHED; PG8_LDA(At, 0, 0); PG8_STAGE(PG8_SA(1, 1), a1 + hstepA, voffA);
            PG8_WAIT_V(8); PG8_WAIT_L(0); PG8_BAR; PG8_MMA(0, 0, At, B0); PG8_MMA(0, 1, At, B1); PG8_BAR; PG8_SCHED;
            PG8_LDA(At, 0, 1); PG8_STAGE(PG8_SB(0, 0), b2, voffB); PG8_STAGE(PG8_SB(0, 1), b2 + hstepB, voffB); PG8_STAGE(PG8_SA(0, 0), a2, voffA);
            PG8_WAIT_V(8); PG8_WAIT_L(0); PG8_BAR; PG8_MMA(1, 0, At, B0); PG8_MMA(1, 1, At, B1); PG8_BAR; PG8_SCHED;
            PG8_LDB(B0, 1, 0); PG8_LDB(B1, 1, 1); PG8_SCHED; PG8_LDA(At, 1, 0); PG8_STAGE(PG8_SA(0, 1), a2 + hstepA, voffA);
            PG8_WAIT_V(8); PG8_WAIT_L(0); PG8_BAR; PG8_MMA(0, 0, At, B0); PG8_MMA(0, 1, At, B1); PG8_BAR; PG8_SCHED;
            PG8_LDA(At, 1, 1); PG8_STAGE(PG8_SB(1, 0), b3, voffB); PG8_STAGE(PG8_SB(1, 1), b3 + hstepB, voffB); PG8_STAGE(PG8_SA(1, 0), a3, voffA);
            PG8_WAIT_V(8); PG8_WAIT_L(0); PG8_BAR; PG8_MMA(1, 0, At, B0); PG8_MMA(1, 1, At, B1); PG8_BAR; PG8_SCHED;
            } else {
            PG8_LDB(B0, 0, 0); PG8_SCHED; PG8_LDA(At, 0, 0); PG8_STAGE(PG8_SA(1, 1), a1 + hstepA, voffA);
            PG8_WAIT_L(8); PG8_BAR; PG8_WAIT_L(0); PG8_MMA(0, 0, At, B0); PG8_BAR; PG8_SCHED;
            PG8_LDB(B1, 0, 1); PG8_STAGE(PG8_SB(0, 0), b2, voffB);
            PG8_BAR; PG8_WAIT_L(0); PG8_MMA(0, 1, At, B1); PG8_BAR;
            PG8_LDA(At, 0, 1); PG8_STAGE(PG8_SA(0, 0), a2, voffA);
            PG8_BAR; PG8_WAIT_L(0); PG8_MMA(1, 0, At, B0); PG8_BAR; PG8_SCHED;
            PG8_STAGE(PG8_SB(0, 1), b2 + hstepB, voffB);
            PG8_WAIT_V(6); PG8_BAR; PG8_MMA(1, 1, At, B1); PG8_BAR;
            PG8_LDB(B0, 1, 0); PG8_SCHED; PG8_LDA(At, 1, 0); PG8_STAGE(PG8_SA(0, 1), a2 + hstepA, voffA);
            PG8_WAIT_L(8); PG8_BAR; PG8_WAIT_L(0); PG8_MMA(0, 0, At, B0); PG8_BAR; PG8_SCHED;
            PG8_LDB(B1, 1, 1); PG8_STAGE(PG8_SB(1, 0), b3, voffB);
            PG8_BAR; PG8_WAIT_L(0); PG8_MMA(0, 1, At, B1); PG8_BAR;
            PG8_LDA(At, 1, 1); PG8_STAGE(PG8_SA(1, 0), a3, voffA);
            PG8_BAR; PG8_WAIT_L(0); PG8_MMA(1, 0, At, B0); PG8_BAR; PG8_SCHED;
            PG8_STAGE(PG8_SB(1, 1), b3 + hstepB, voffB);
            PG8_WAIT_V(6); PG8_BAR; PG8_MMA(1, 1, At, B1); PG8_BAR;
            }
        }
        if constexpr (ALIGN_EPI) { if (wr == 0) PG8_BAR; }
        E(acc, cur, wr, wc, fr, fq); S.done(cur);
        if (!has_next) break;
#pragma unroll
        for (int a = 0; a < 2; ++a)
#pragma unroll
            for (int b = 0; b < 2; ++b)
#pragma unroll
                for (int m = 0; m < 4; ++m)
#pragma unroll
                    for (int n = 0; n < 2; ++n) acc[a][b][m][n] = (f32x4){0.f, 0.f, 0.f, 0.f};
        cur = nxt; cA = nA; cB = nB; ++ui;
        if constexpr (ALIGN_EPI) { if (wr == 1) PG8_BAR; }
    }
    PG8_WAIT_V(0);
    if constexpr (!ALIGN_EPI) { if (wr == 0) PG8_BAR; }
    PG8_BAR;
#undef PG8_UA
#undef PG8_UB
#undef PG8_SA
#undef PG8_SB
#undef PG8_STAGE
#undef PG8_LDA
#undef PG8_LDB
#undef PG8_MMA
#undef PG8_WAIT_V
#undef PG8_WAIT_L
#undef PG8_BAR
#undef PG8_SCHED
}
}
using pg8::Unit;

__device__ __forceinline__ int mod_row(int r) { return r < TP ? (r >> 11) : NB + ((r - TP) >> 2); }
__device__ __forceinline__ int pos_idx(int r) { return r < TP ? (r & 2047) : 2048 + ((r - TP) & 3); }

struct EpiF32Bias {
    static constexpr bool PERM = false;
    float* C; int ldc; const float* bias;
    __device__ __forceinline__ void operator()(const f32x4 (&acc)[2][2][4][2], const Unit& u, int wr, int wc, int fr, int fq) const {
        const int row0 = u.pm * 256 + wr * 64 + fr, col0 = u.pn * 256 + wc * 32 + 4 * fq;
#pragma unroll
        for (int ai = 0; ai < 2; ++ai)
#pragma unroll
            for (int m = 0; m < 4; ++m) { float* rowp = C + (size_t)(row0 + ai * 128 + m * 16) * ldc + col0;
#pragma unroll
                for (int bj = 0; bj < 2; ++bj)
#pragma unroll
                    for (int n = 0; n < 2; ++n) { const f32x4 bv = *(const f32x4*)(bias + col0 + bj * 128 + n * 16); *(f32x4*)(rowp + bj * 128 + n * 16) = acc[ai][bj][m][n] + bv; } }
    }
};

struct EpiBf16Plain {
    static constexpr bool PERM = true;
    bf16_t* O; int ldc;
    __device__ __forceinline__ void operator()(const f32x4 (&acc)[2][2][4][2], const Unit& u, int wr, int wc, int fr, int fq) const {
        const int row0 = u.pm * 256 + wr * 64 + fr, col0 = u.pn * 256 + wc * 32 + 8 * fq;
#pragma unroll
        for (int ai = 0; ai < 2; ++ai)
#pragma unroll
            for (int m = 0; m < 4; ++m) { bf16_t* rowp = O + (size_t)(row0 + ai * 128 + m * 16) * ldc + col0;
#pragma unroll
                for (int bj = 0; bj < 2; ++bj) { const f32x4 v0 = acc[ai][bj][m][0], v1 = acc[ai][bj][m][1];
                    u32x4 w; w.x = cvt_pk_bf16(v0[0], v0[1]); w.y = cvt_pk_bf16(v0[2], v0[3]); w.z = cvt_pk_bf16(v1[0], v1[1]); w.w = cvt_pk_bf16(v1[2], v1[3]);
                    *(u32x4*)(rowp + bj * 128) = w; } }
    }
};

struct EpiInProj {
    static constexpr bool PERM = true;
    bf16_t *U, *BG, *Q, *K, *V, *QI, *KI, *SGA, *SGB; float* WI; const float *qnw, *knw; const f32x2* rope; float* out;
    __device__ __forceinline__ void rope_rows(const f32x4 (&acc)[2][2][4][2], int ai, int m, int r, int fq, const float* nw, float (&o1)[8], float (&o2)[8]) const {
        float x1[8], x2[8];
#pragma unroll
        for (int n = 0; n < 2; ++n)
#pragma unroll
            for (int j = 0; j < 4; ++j) { x1[n * 4 + j] = acc[ai][0][m][n][j]; x2[n * 4 + j] = acc[ai][1][m][n][j]; }
        const int i0 = fq * 8;
        if (nw) {
            float ss = 0.f;
#pragma unroll
            for (int e = 0; e < 8; ++e) ss += x1[e] * x1[e] + x2[e] * x2[e];
            ss += __shfl_xor(ss, 16); ss += __shfl_xor(ss, 32);
            const float rstd = rsqrtf(ss * (1.0f / 64.0f) + NORM_EPS);
#pragma unroll
            for (int e = 0; e < 8; ++e) { x1[e] = x1[e] * rstd * nw[i0 + e]; x2[e] = x2[e] * rstd * nw[32 + i0 + e]; }
        }
        const f32x2* rp = rope + (size_t)pos_idx(r) * 32 + i0;
#pragma unroll
        for (int e = 0; e < 8; ++e) { const f32x2 cs = rp[e]; o1[e] = x1[e] * cs.x - x2[e] * cs.y; o2[e] = x2[e] * cs.x + x1[e] * cs.y; }
    }
    __device__ __forceinline__ void operator()(const f32x4 (&acc)[2][2][4][2], const Unit& u, int wr, int wc, int fr, int fq) const {
        const int pn = u.pn;
        const bool smp = u.pm >= 256;
#pragma unroll
        for (int ai = 0; ai < 2; ++ai)
#pragma unroll
            for (int m = 0; m < 4; ++m) {
                const int r = u.pm * 256 + ai * 128 + wr * 64 + m * 16 + fr;
                const int rs = r - TP;
                if (pn < 4) {
                    float uv[8];
#pragma unroll
                    for (int n = 0; n < 2; ++n)
#pragma unroll
                        for (int j = 0; j < 4; ++j) uv[n * 4 + j] = acc[ai][0][m][n][j] * acc[ai][1][m][n][j];
                    const int c0 = pn * 128 + wc * 32 + fq * 8;
                    *(u32x4*)(U + (size_t)r * 512 + c0) = pack8(uv);
                    float* cp = nullptr;
                    if (!smp) { const int t = r & 2047; if (t >= 2046) cp = out + OFF_CONVP + ((size_t)(r >> 11) * 2 + (t - 2046)) * 512 + c0; }
                    else { const int j4 = rs & 3; if (j4 >= 2) cp = out + OFF_CONVS + ((size_t)(rs >> 2) * 2 + (j4 - 2)) * 512 + c0; }
                    if (cp) { *(f32x4*)cp = (f32x4){uv[0], uv[1], uv[2], uv[3]}; *(f32x4*)(cp + 4) = (f32x4){uv[4], uv[5], uv[6], uv[7]}; }
                } else if (pn < 6) {
#pragma unroll
                    for (int bj = 0; bj < 2; ++bj) { float v[8];
#pragma unroll
                        for (int n = 0; n < 2; ++n)
#pragma unroll
                            for (int j = 0; j < 4; ++j) v[n * 4 + j] = acc[ai][bj][m][n][j];
                        *(u32x4*)(BG + (size_t)r * 512 + (pn - 4) * 256 + bj * 128 + wc * 32 + fq * 8) = pack8(v); }
                } else if (pn < 8) {
                    float o1[8], o2[8]; rope_rows(acc, ai, m, r, fq, qnw, o1, o2);
                    bf16_t* p = Q + (size_t)r * 512 + ((pn - 6) * 4 + wc) * 64 + fq * 8;
                    *(u32x4*)p = pack8(o1); *(u32x4*)(p + 32) = pack8(o2);
                } else if (pn == 8) {
                    float o1[8], o2[8];
                    const int hd = wc & 1;
                    if (wc < 2) rope_rows(acc, ai, m, r, fq, knw, o1, o2);
                    else {
#pragma unroll
                        for (int n = 0; n < 2; ++n)
#pragma unroll
                            for (int j = 0; j < 4; ++j) { o1[n * 4 + j] = acc[ai][0][m][n][j]; o2[n * 4 + j] = acc[ai][1][m][n][j]; }
                    }
                    bf16_t* p = (wc < 2 ? K : V) + (size_t)r * 128 + hd * 64 + fq * 8;
                    *(u32x4*)p = pack8(o1); *(u32x4*)(p + 32) = pack8(o2);
                    float* op = out + (smp ? (wc < 2 ? OFF_KS : OFF_VS) + (size_t)rs * 128 : (wc < 2 ? OFF_KP : OFF_VP) + (size_t)r * 128) + hd * 64 + fq * 8;
                    *(f32x4*)op = (f32x4){o1[0], o1[1], o1[2], o1[3]}; *(f32x4*)(op + 4) = (f32x4){o1[4], o1[5], o1[6], o1[7]};
                    *(f32x4*)(op + 32) = (f32x4){o2[0], o2[1], o2[2], o2[3]}; *(f32x4*)(op + 36) = (f32x4){o2[4], o2[5], o2[6], o2[7]};
                } else if (pn < 11) {
                    float o1[8], o2[8]; rope_rows(acc, ai, m, r, fq, nullptr, o1, o2);
                    bf16_t* p = QI + (size_t)r * 512 + ((pn - 9) * 4 + wc) * 64 + fq * 8;
                    *(u32x4*)p = pack8(o1); *(u32x4*)(p + 32) = pack8(o2);
                } else if (pn == 11) {
                    if (wc == 0) {
                        float o1[8], o2[8]; rope_rows(acc, ai, m, r, fq, nullptr, o1, o2);
                        bf16_t* p = KI + (size_t)r * 64 + fq * 8;
                        *(u32x4*)p = pack8(o1); *(u32x4*)(p + 32) = pack8(o2);
                        float* op = out + (smp ? OFF_KIS + (size_t)rs * 64 : OFF_KIP + (size_t)r * 64) + fq * 8;
                        *(f32x4*)op = (f32x4){o1[0], o1[1], o1[2], o1[3]}; *(f32x4*)(op + 4) = (f32x4){o1[4], o1[5], o1[6], o1[7]};
                        *(f32x4*)(op + 32) = (f32x4){o2[0], o2[1], o2[2], o2[3]}; *(f32x4*)(op + 36) = (f32x4){o2[4], o2[5], o2[6], o2[7]};
                    } else if (wc == 1 && fq == 0) {
                        float* wp = WI + (size_t)r * 8;
                        *(f32x4*)wp = acc[ai][0][m][0] * IDX_SCALE; *(f32x4*)(wp + 4) = acc[ai][0][m][1] * IDX_SCALE;
                    }
                } else {
                    bf16_t* base = pn < 16 ? SGA : SGB; const int pc = pn < 16 ? pn - 12 : pn - 16;
#pragma unroll
                    for (int bj = 0; bj < 2; ++bj) { float v[8];
#pragma unroll
                        for (int n = 0; n < 2; ++n)
#pragma unroll
                            for (int j = 0; j < 4; ++j) v[n * 4 + j] = sigmoidf_(acc[ai][bj][m][n][j]);
                        *(u32x4*)(base + (size_t)r * 1024 + pc * 256 + bj * 128 + wc * 32 + fq * 8) = pack8(v); }
                }
            }
    }
};
__host__ __device__ __forceinline__ int win_src_col(int j) {
    const int pn = j >> 8, tc = j & 255, bj = tc >> 7, wc = (tc >> 5) & 3, i = tc & 31;
    if (pn < 4) return (bj ? 1024 : 0) + pn * 128 + (tc & 127);
    if (pn < 6) return 512 + (pn - 4) * 256 + tc;
    if (pn < 8) return 1536 + ((pn - 6) * 4 + wc) * 64 + bj * 32 + i;
    if (pn == 8) return wc < 2 ? 2048 + wc * 64 + bj * 32 + i : 2176 + (wc - 2) * 64 + bj * 32 + i;
    if (pn < 11) return 2304 + ((pn - 9) * 4 + wc) * 64 + bj * 32 + i;
    if (pn == 11) { if (wc == 0) return 2816 + bj * 32 + i; if (wc == 1 && bj == 0 && i < 8) return 2880 + i; return -1; }
    if (pn < 16) return 2888 + (pn - 12) * 256 + tc;
    return 3912 + (pn - 16) * 256 + tc;
}

template <int MODE> struct EpiMix {
    static constexpr bool PERM = true;
    const bf16_t* SG; bf16_t* MIX;
    __device__ __forceinline__ void operator()(const f32x4 (&acc)[2][2][4][2], const Unit& u, int wr, int wc, int fr, int fq) const {
        const int row0 = u.pm * 256 + wr * 64 + fr, col0 = u.pn * 256 + wc * 32 + 8 * fq;
#pragma unroll
        for (int ai = 0; ai < 2; ++ai)
#pragma unroll
            for (int m = 0; m < 4; ++m) { const size_t ro = (size_t)(row0 + ai * 128 + m * 16) * 1024 + col0;
#pragma unroll
                for (int bj = 0; bj < 2; ++bj) {
                    float g[8], v[8]; unpack8(*(const u32x4*)(SG + ro + bj * 128), g);
#pragma unroll
                    for (int n = 0; n < 2; ++n)
#pragma unroll
                        for (int j = 0; j < 4; ++j) v[n * 4 + j] = g[n * 4 + j] * acc[ai][bj][m][n][j];
                    if (MODE == 1) { float pv[8]; unpack8(*(const u32x4*)(MIX + ro + bj * 128), pv);
#pragma unroll
                        for (int e = 0; e < 8; ++e) v[e] += pv[e]; }
                    *(u32x4*)(MIX + ro + bj * 128) = pack8(v); } }
    }
};

struct EpiMixFused {
    static constexpr bool PERM = true;
    const bf16_t* SGA; const bf16_t* SGB; bf16_t* MIX;
    __device__ __forceinline__ void mid(f32x4 (&acc)[2][2][4][2], const Unit& u, int wr, int wc, int fr, int fq) const {
        unsigned o0 = ((unsigned)(u.pm * 256 + wr * 64 + fr) * 1024u + (unsigned)(u.pn * 256 + wc * 32 + 8 * fq)) * 2u;
        asm volatile("" : "+v"(o0));
#pragma unroll
        for (int ai = 0; ai < 2; ++ai)
#pragma unroll
            for (int m = 0; m < 4; ++m) { const unsigned ro = o0 + (unsigned)(ai * 128 + m * 16) * 2048u;
#pragma unroll
                for (int bj = 0; bj < 2; ++bj) {
                    float ga[8], gb[8]; unpack8(*(const u32x4*)((const char*)SGA + ro + bj * 256), ga); unpack8(*(const u32x4*)((const char*)SGB + ro + bj * 256), gb);
#pragma unroll
                    for (int n = 0; n < 2; ++n)
#pragma unroll
                        for (int j = 0; j < 4; ++j) acc[ai][bj][m][n][j] *= ga[n * 4 + j] * __builtin_amdgcn_rcpf(fmaxf(gb[n * 4 + j], 1e-20f)); }
                if (m & 1) __builtin_amdgcn_sched_barrier(0); }
    }
    __device__ __forceinline__ void operator()(const f32x4 (&acc)[2][2][4][2], const Unit& u, int wr, int wc, int fr, int fq) const {
        unsigned o0 = ((unsigned)(u.pm * 256 + wr * 64 + fr) * 1024u + (unsigned)(u.pn * 256 + wc * 32 + 8 * fq)) * 2u;
        asm volatile("" : "+v"(o0));
#pragma unroll
        for (int ai = 0; ai < 2; ++ai)
#pragma unroll
            for (int m = 0; m < 4; ++m) { const unsigned ro = o0 + (unsigned)(ai * 128 + m * 16) * 2048u;
#pragma unroll
                for (int bj = 0; bj < 2; ++bj) {
                    float gb[8], v[8]; unpack8(*(const u32x4*)((const char*)SGB + ro + bj * 256), gb);
#pragma unroll
                    for (int n = 0; n < 2; ++n)
#pragma unroll
                        for (int j = 0; j < 4; ++j) v[n * 4 + j] = fmaxf(gb[n * 4 + j], 1e-20f) * acc[ai][bj][m][n][j];
                    *(u32x4*)((char*)MIX + ro + bj * 256) = pack8(v); } }
    }
};

struct EpiOut {
    static constexpr bool PERM = true;
    const float* MOD; bf16_t* Dm;
    __device__ __forceinline__ void operator()(const f32x4 (&acc)[2][2][4][2], const Unit& u, int wr, int wc, int fr, int fq) const {
        const int col0 = u.pn * 256 + wc * 32 + 8 * fq;
#pragma unroll
        for (int ai = 0; ai < 2; ++ai)
#pragma unroll
            for (int m = 0; m < 4; ++m) {
                const int r = u.pm * 256 + ai * 128 + wr * 64 + m * 16 + fr;
                const float* gr = MOD + (size_t)mod_row(r) * NMOD + 2048;
#pragma unroll
                for (int bj = 0; bj < 2; ++bj) { const int c = col0 + bj * 128;
                    const f32x4 g0 = *(const f32x4*)(gr + c), g1 = *(const f32x4*)(gr + c + 4); float v[8];
#pragma unroll
                    for (int j = 0; j < 4; ++j) { v[j] = g0[j] * acc[ai][bj][m][0][j]; v[4 + j] = g1[j] * acc[ai][bj][m][1][j]; }
                    *(u32x4*)(Dm + (size_t)r * 1024 + c) = pack8(v); } }
    }
};

typedef _Float16 h2_t __attribute__((ext_vector_type(2)));
__device__ __forceinline__ unsigned cvt_pk_f16(float lo, float hi) { const h2_t v = __builtin_convertvector((f32x2){lo, hi}, h2_t); return __builtin_bit_cast(unsigned, v); }
struct EpiPST {
    static constexpr bool PERM = true;
    unsigned short* PST;
    __device__ __forceinline__ void operator()(const f32x4 (&acc)[2][2][4][2], const Unit& u, int wr, int wc, int fr, int fq) const {
        unsigned short* base = PST + (size_t)(u.pm * 8 + u.pn) * 65536 + wc * 32 + 8 * fq;
#pragma unroll
        for (int ai = 0; ai < 2; ++ai)
#pragma unroll
            for (int m = 0; m < 4; ++m) { const int rl = ai * 128 + wr * 64 + m * 16 + fr;
#pragma unroll
                for (int bj = 0; bj < 2; ++bj) { const f32x4 v0 = acc[ai][bj][m][0], v1 = acc[ai][bj][m][1];
                    u32x4 w; w.x = cvt_pk_f16(v0[0], v0[1]); w.y = cvt_pk_f16(v0[2], v0[3]); w.z = cvt_pk_f16(v1[0], v1[1]); w.w = cvt_pk_f16(v1[2], v1[3]);
                    *(u32x4*)(base + (size_t)rl * 256 + bj * 128) = w; } }
    }
};

struct Params { const float* in[24]; float* out; unsigned char* ws; int ph_lo, ph_hi, rep_mask, pad; };
struct Frame {
    LAS unsigned char* lds; int tid, lane, wave, bid, nblk; unsigned* ctl; unsigned char* ws; float* out;
    const float *x_prompt, *x_sample, *cache_k, *cache_v, *cache_kidx, *state_conv; const int* page_table; const float *c_prompt, *c_sample, *w_ada, *b_ada, *norm1_w, *w_in, *conv_w, *q_norm_w, *k_norm_w,
        *w_conv_out, *w_attn_out, *w_out, *norm2_w, *peer_w_q, *peer_sub_keys, *peer_u, *peer_v;
};
#define WSP(type, off) ((type*)(F.ws + (off)))

template <bool DUAL, class Fin, int KQ = 256>
__device__ __forceinline__ void skinny_phase(const Frame& F, const bf16_t* A1, const bf16_t* B1, const bf16_t* A2, const bf16_t* B2, int lda, int ldb, int N, int row_base, int nrt, Fin fin, int a_pn_cols = 0) {
    LAS float* P = (LAS float*)F.lds;
    const int lane = F.lane, q = lane & 31, half = lane >> 5, w = F.wave, rb = w & 1, kq = w >> 1;
    const bf16_t* Asel = (DUAL && kq >= 2) ? A2 : A1; const bf16_t* Bsel = (DUAL && kq >= 2) ? B2 : B1;
    const int k0 = (DUAL ? (kq & 1) : kq) * KQ + half * 8;
    const int ntile = nrt * (N / 32);
    for (int tl = F.bid; tl < ntile; tl += F.nblk) {
        const int rt = tl % nrt, ct = tl / nrt;
        const bf16_t* ap = Asel + (size_t)(row_base + rt * 64 + rb * 32 + q) * lda + k0 + (ct >> 3) * a_pn_cols;
        const bf16_t* bp = Bsel + (size_t)(ct * 32 + q) * ldb + k0;
        f32x16 acc;
#pragma unroll
        for (int i = 0; i < 16; ++i) acc[i] = 0.f;
        constexpr int NS = KQ / 16 < 16 ? KQ / 16 : 16;
#pragma unroll 1
        for (int kb = 0; kb < KQ / 16 / NS; ++kb) {
            u32x4 a[NS], b[NS];
#pragma unroll
            for (int i = 0; i < NS; ++i) { a[i] = *(const u32x4*)(ap + (kb * NS + i) * 16); b[i] = *(const u32x4*)(bp + (kb * NS + i) * 16); }
#pragma unroll
            for (int i = 0; i < NS; ++i) acc = __builtin_amdgcn_mfma_f32_32x32x16_bf16(__builtin_bit_cast(bf16x8, a[i]), __builtin_bit_cast(bf16x8, b[i]), acc, 0, 0, 0);
        }
        __syncthreads();
#pragma unroll
        for (int i = 0; i < 16; ++i) P[(kq * 64 + rb * 32 + 8 * (i >> 2) + 4 * half + (i & 3)) * 33 + q] = acc[i];
        __syncthreads();
        const int r = F.tid >> 3, c4 = (F.tid & 7) * 4;
        float s01[4], s23[4];
#pragma unroll
        for (int j = 0; j < 4; ++j) { s01[j] = P[(0 * 64 + r) * 33 + c4 + j] + P[(1 * 64 + r) * 33 + c4 + j]; s23[j] = P[(2 * 64 + r) * 33 + c4 + j] + P[(3 * 64 + r) * 33 + c4 + j]; }
        fin(row_base + rt * 64 + r, ct * 32 + c4, s01, s23);
    }
    __syncthreads();
}

template <class Map> __device__ __forceinline__ void transpose_cvt(const Frame& F, const float* src, int ld_src, bf16_t* dst, int K, int Nd, Map map) {
    LAS float* tile = (LAS float*)F.lds;
    const int ntk = K / 64, ntn = Nd / 64, ntile = ntk * ntn;
    float v[8];
#define TC_LOAD(tix_) do { const int tn_ = (tix_) / ntk, tk_ = (tix_) % ntk; _Pragma("unroll") for (int i_ = 0; i_ < 8; ++i_) { const int e_ = F.tid + 512 * i_, kk_ = e_ >> 6, nn_ = e_ & 63; \
        const int sc_ = map(tn_ * 64 + nn_); v[i_] = sc_ >= 0 ? src[(size_t)(tk_ * 64 + kk_) * ld_src + sc_] : 0.f; } } while (0)
    int tix = F.bid;
    if (tix < ntile) TC_LOAD(tix);
    for (; tix < ntile; tix += F.nblk) {
        const int tn = tix / ntk, tk = tix % ntk;
#pragma unroll
        for (int i = 0; i < 8; ++i) { const int e = F.tid + 512 * i, kk = e >> 6, nn = e & 63; tile[kk * 65 + nn] = v[i]; }
        __syncthreads();
        if (tix + F.nblk < ntile) TC_LOAD(tix + F.nblk);
#pragma unroll
        for (int i = 0; i < 4; ++i) { const int e = F.tid + 512 * i, nn = e >> 5, kp = e & 31;
            *(unsigned*)(dst + (size_t)(tn * 64 + nn) * K + tk * 64 + 2 * kp) = cvt_pk_bf16(tile[(2 * kp) * 65 + nn], tile[(2 * kp + 1) * 65 + nn]); }
        __syncthreads();
    }
#undef TC_LOAD
}
struct MapId { __device__ __forceinline__ int operator()(int n) const { return n; } };
struct MapWin { __device__ __forceinline__ int operator()(int n) const { return win_src_col(n); } };

__device__ __forceinline__ void p0_peer_tables(const Frame& F, int sb, int sn) {
    { unsigned char* d8 = WSP(unsigned char, WS_UT); float* tsc = WSP(float, WS_TSC);
      for (int row = sb * 8 + F.wave; row < 2 * 16384; row += sn * 8) {
          const float* s = (row < 16384 ? F.peer_u : F.peer_v) + (size_t)(row & 16383) * 1024 + F.lane * 16;
          f32x4 v[4]; float am = 0.f;
#pragma unroll
          for (int i = 0; i < 4; ++i) { v[i] = *(const f32x4*)(s + 4 * i); am = fmaxf(am, fmaxf(fmaxf(fabsf(v[i][0]), fabsf(v[i][1])), fmaxf(fabsf(v[i][2]), fabsf(v[i][3])))); }
          am = wave_max(am);
          const float sc = am > 0.f ? 240.0f / am : 1.0f;
          u32x4 w; unsigned ww[4];
#pragma unroll
          for (int i = 0; i < 4; ++i) { int pk = 0; pk = __builtin_amdgcn_cvt_pk_fp8_f32(v[i][0] * sc, v[i][1] * sc, pk, false); pk = __builtin_amdgcn_cvt_pk_fp8_f32(v[i][2] * sc, v[i][3] * sc, pk, true); ww[i] = (unsigned)pk; }
          w.x = ww[0]; w.y = ww[1]; w.z = ww[2]; w.w = ww[3];
          *(u32x4*)(d8 + (size_t)row * 1024 + F.lane * 16) = w;
          if (F.lane == 0) tsc[row] = am > 0.f ? am / 240.0f : 1.0f;
      } }
}

__device__ __forceinline__ void p0_convert(const Frame& F) {
    transpose_cvt(F, F.w_in, NPROJ, WSP(bf16_t, WS_WIN), 1024, NPROJ_PAD, MapWin());
    transpose_cvt(F, F.w_conv_out, 1024, WSP(bf16_t, WS_WCO), 512, 1024, MapId());
    transpose_cvt(F, F.w_attn_out, 1024, WSP(bf16_t, WS_WAO), 512, 1024, MapId());
    transpose_cvt(F, F.w_out, 1024, WSP(bf16_t, WS_WOUT), 1024, 1024, MapId());
    transpose_cvt(F, F.peer_w_q, 2048, WSP(bf16_t, WS_WQ), 1024, 2048, MapId());
    transpose_cvt(F, F.w_ada, NMOD, WSP(bf16_t, WS_WADA), 1024, NMOD, MapId());
    const size_t gt = (size_t)F.bid * 512 + F.tid, gn = (size_t)F.nblk * 512;
    { bf16_t* d = WSP(bf16_t, WS_SKBD);
      for (size_t i = gt; i < (size_t)2048 * 256 / 2; i += gn) { const int row = (int)(i >> 7), cp = (int)(i & 127) * 2; const int h = row >> 8, rr = row & 255, p = rr >> 7, key = rr & 127;
          float a = 0.f, b = 0.f; if ((cp >> 7) == p) { const float* s = F.peer_sub_keys + (((size_t)p * 8 + h) * 128 + key) * 128 + (cp & 127); a = s[0]; b = s[1]; }
          *(unsigned*)(d + (size_t)row * 256 + cp) = cvt_pk_bf16(a, b); } }
    { bf16_t* d = WSP(bf16_t, WS_CB);
      for (size_t i = gt; i < (size_t)256 * 1024 / 2; i += gn) { const int row = (int)(i >> 9), cp = (int)(i & 511) * 2; float a = 0.f, b = 0.f;
          if (row < NB) { a = F.c_prompt[row * 1024 + cp]; b = F.c_prompt[row * 1024 + cp + 1]; } else if (row < NB + DB) { a = F.c_sample[(row - NB) * 1024 + cp]; b = F.c_sample[(row - NB) * 1024 + cp + 1]; }
          *(unsigned*)(d + (size_t)row * 1024 + cp) = cvt_pk_bf16(a, b); } }
    { f32x2* d = WSP(f32x2, WS_ROPE);
      for (size_t i = gt; i < (size_t)2052 * 32; i += gn) { const int pi = (int)(i >> 5), fi = (int)(i & 31); const int pos = pi < 2048 ? pi : PAST + (pi - 2048);
          const float fr = powf(10000.0f, -(float)fi / 32.0f); const float ang = (float)pos * fr;
          d[i] = (f32x2){(float)cos((double)ang), (float)sin((double)ang)}; } }
}

template <bool SECOND> __device__ __forceinline__ void row_norm_pass(const Frame& F) {
    const float* MOD = WSP(float, WS_MOD); bf16_t* H = WSP(bf16_t, WS_H);
    const float* nw = SECOND ? F.norm2_w : F.norm1_w;
    const int so = SECOND ? 3 * 1024 : 0;
    for (int r = F.bid * 8 + F.wave; r < T; r += F.nblk * 8) {
        const float* xr = r < TP ? F.x_prompt + (size_t)r * 1024 : F.x_sample + (size_t)(r - TP) * 1024;
        f32x4 v[4]; float ss = 0.f;
#pragma unroll
        for (int i = 0; i < 4; ++i) { v[i] = *(const f32x4*)(xr + i * 256 + F.lane * 4);
            if (SECOND) { const u32x2 dv = *(const u32x2*)(WSP(bf16_t, WS_X1) + (size_t)r * 1024 + i * 256 + F.lane * 4); v[i] += (f32x4){bf_lo(dv.x), bf_hi(dv.x), bf_lo(dv.y), bf_hi(dv.y)}; }
            ss += v[i][0] * v[i][0] + v[i][1] * v[i][1] + v[i][2] * v[i][2] + v[i][3] * v[i][3]; }
        ss = wave_sum(ss);
        const float rstd = rsqrtf(ss * (1.0f / 1024.0f) + NORM_EPS);
        const float* mr = MOD + (size_t)mod_row(r) * NMOD + so;
#pragma unroll
        for (int i = 0; i < 4; ++i) { const int c = i * 256 + F.lane * 4;
            const f32x4 w = *(const f32x4*)(nw + c), sh = *(const f32x4*)(mr + c), sc = *(const f32x4*)(mr + 1024 + c);
            const f32x4 y = v[i] * rstd * w * (sc + 1.0f) + sh;
            u32x2 o; o.x = cvt_pk_bf16(y[0], y[1]); o.y = cvt_pk_bf16(y[2], y[3]);
            *(u32x2*)(H + (size_t)r * 1024 + c) = o; }
    }
}

__device__ __forceinline__ void p4_vtranspose(const Frame& F) {
    const bf16_t* V = WSP(bf16_t, WS_V); bf16_t* VTR = WSP(bf16_t, WS_VTR);
    LAS bf16_t* tile = (LAS bf16_t*)F.lds;
    for (int tix = F.bid; tix < NB * 2 * 32; tix += F.nblk) {
        const int b = tix >> 6, kvh = (tix >> 5) & 1, tt = tix & 31;
        { const int trow = F.tid >> 3, dc = F.tid & 7;
          const u32x4 w = *(const u32x4*)(V + ((size_t)(b * 2048 + tt * 64 + trow)) * 128 + kvh * 64 + dc * 8);
          const unsigned ww[4] = {w.x, w.y, w.z, w.w};
#pragma unroll
          for (int e = 0; e < 8; ++e) tile[(dc * 8 + e) * 72 + trow] = (bf16_t)((ww[e >> 1] >> ((e & 1) * 16)) & 0xffffu); }
        __syncthreads();
        { const int d = F.tid >> 3, tc = F.tid & 7;
          const u32x4 w = *(const LAS u32x4*)(tile + d * 72 + tc * 8);
          *(u32x4*)(VTR + ((size_t)((b * 2 + kvh) * 64 + d)) * 2048 + tt * 64 + tc * 8) = w; }
        __syncthreads();
    }
}
__device__ __forceinline__ void p4_conv(const Frame& F) {
    const bf16_t* U = WSP(bf16_t, WS_U); const bf16_t* BG = WSP(bf16_t, WS_BG); bf16_t* APRE = WSP(bf16_t, WS_APRE);
    const size_t gt = (size_t)F.bid * 512 + F.tid, gn = (size_t)F.nblk * 512;
    for (size_t i = gt; i < (size_t)T * 64; i += gn) {
        const int r = (int)(i >> 6), c0 = (int)(i & 63) * 8;
        float u0[8], u1[8], u2[8], bg[8], w0[8], w1[8], w2[8];
        unpack8(*(const u32x4*)(U + (size_t)r * 512 + c0), u2);
        unpack8(*(const u32x4*)(BG + (size_t)r * 512 + c0), bg);
#pragma unroll
        for (int e = 0; e < 8; ++e) { w0[e] = F.conv_w[c0 + e]; w1[e] = F.conv_w[512 + c0 + e]; w2[e] = F.conv_w[1024 + c0 + e]; u1[e] = 0.f; u0[e] = 0.f; }
        if (r < TP) { const int t = r & 2047;
            if (t >= 1) unpack8(*(const u32x4*)(U + (size_t)(r - 1) * 512 + c0), u1);
            if (t >= 2) unpack8(*(const u32x4*)(U + (size_t)(r - 2) * 512 + c0), u0);
        } else { const int rs = r - TP, b = rs >> 2, j = rs & 3;
            const float* st = F.state_conv + (size_t)b * 1024 + c0;
            if (j >= 1) unpack8(*(const u32x4*)(U + (size_t)(r - 1) * 512 + c0), u1);
            else {
#pragma unroll
                for (int e = 0; e < 8; ++e) u1[e] = st[512 + e]; }
            if (j >= 2) unpack8(*(const u32x4*)(U + (size_t)(r - 2) * 512 + c0), u0);
            else {
#pragma unroll
                for (int e = 0; e < 8; ++e) u0[e] = st[(j == 1 ? 512 : 0) + e]; }
        }
        float o[8];
#pragma unroll
        for (int e = 0; e < 8; ++e) o[e] = bg[e] * (w2[e] * u2[e] + w1[e] * u1[e] + w0[e] * u0[e]);
        *(u32x4*)(APRE + (size_t)r * 512 + c0) = pack8(o);
    }
}

constexpr int QL_STRIDE = 1040;
template <bool WLDS> __device__ __forceinline__ f32x16 idx_tile_t(const bf16x8 (&kf)[4], const LAS unsigned char* qb_, const float (&w8)[8], const LAS float* wl) {
    unsigned qo = (unsigned)(size_t)qb_; asm volatile("" : "+v"(qo));
    const LAS unsigned char* qb = (const LAS unsigned char*)(size_t)qo;
    f32x16 sc;
#pragma unroll
    for (int i = 0; i < 16; ++i) sc[i] = 0.f;
#pragma unroll
    for (int h = 0; h < 8; ++h) {
        f32x16 a;
#pragma unroll
        for (int i = 0; i < 16; ++i) a[i] = 0.f;
#pragma unroll
        for (int s = 0; s < 4; ++s) { const bf16x8 qf = *(const LAS bf16x8*)(qb + h * 128 + s * 32); a = __builtin_amdgcn_mfma_f32_32x32x16_bf16(kf[s], qf, a, 0, 0, 0); }
        const float wh = WLDS ? wl[h] : w8[h];
#pragma unroll
        for (int i = 0; i < 16; ++i) sc[i] += wh * fmaxf(a[i], 0.f);
    }
    return sc;
}
__device__ __forceinline__ f32x16 idx_tile(const bf16x8 (&kf)[4], const LAS unsigned char* qb_, const float (&w8)[8]) { return idx_tile_t<false>(kf, qb_, w8, nullptr); }

__device__ __forceinline__ int wave_sum_i_dpp(int x) {
    x += __builtin_amdgcn_update_dpp(0, x, 0xB1, 0xF, 0xF, true);
    x += __builtin_amdgcn_update_dpp(0, x, 0x4E, 0xF, 0xF, true);
    x += __builtin_amdgcn_update_dpp(0, x, 0x141, 0xF, 0xF, true);
    x += __builtin_amdgcn_update_dpp(0, x, 0x140, 0xF, 0xF, true);
    x += __builtin_amdgcn_update_dpp(0, x, 0x142, 0xA, 0xF, false);
    x += __builtin_amdgcn_update_dpp(0, x, 0x143, 0xC, 0xF, false);
    return __builtin_amdgcn_readlane(x, 63);
}
template <int NREG> __device__ __forceinline__ void select_rows8(const float* sc0, int n0, u64* mask0, int lane) {
    float cur[NREG], nxt[NREG];
#pragma unroll
    for (int j = 0; j < NREG; ++j) { cur[j] = sc0[64 * j + lane]; nxt[j] = 0.f; }
#pragma unroll 1
    for (int rr = 0; rr < 8; ++rr) {
        if (rr < 7) {
#pragma unroll
            for (int j = 0; j < NREG; ++j) nxt[j] = sc0[(size_t)(rr + 1) * 2048 + 64 * j + lane]; }
        const int n = n0 + rr;
        unsigned key[NREG];
#pragma unroll
        for (int j = 0; j < NREG; ++j) { const int idx = 64 * j + lane; const unsigned k = mono(cur[j]); key[j] = idx < n ? k : 0u; }
        unsigned thr = 0u, cut = 0u; bool exact = false;
#pragma unroll 1
        for (int bit = 31; bit >= 0; --bit) {
            const unsigned cand = thr | (1u << bit); int c = 0;
#pragma unroll
            for (int j = 0; j < NREG; ++j) c += (key[j] >= cand) ? 1 : 0;
            c = wave_sum_i_dpp(c);
            if (c == 256) { cut = cand; exact = true; break; }
            if (c > 256) thr = cand;
        }
        u64 myword = 0ull;
        if (exact) {
#pragma unroll
            for (int j = 0; j < NREG; ++j) { const u64 word = __ballot(key[j] >= cut); if (lane == j) myword = word; }
        } else {
            int cgt = 0;
#pragma unroll
            for (int j = 0; j < NREG; ++j) cgt += (key[j] > thr) ? 1 : 0;
            int need = 256 - wave_sum_i_dpp(cgt);
#pragma unroll
            for (int j = 0; j < NREG; ++j) {
                const u64 eq = __ballot(key[j] == thr);
                const int rank = mbcnt64(eq);
                const u64 word = __ballot(key[j] > thr || (key[j] == thr && rank < need));
                const int pe = __popcll(eq); need = need > pe ? need - pe : 0;
                if (lane == j) myword = word;
            }
        }
        if (lane < 32) mask0[(size_t)rr * 32 + lane] = myword;
#pragma unroll
        for (int j = 0; j < NREG; ++j) cur[j] = nxt[j];
    }
}
__device__ __forceinline__ void select_rows8_prompt(const float* sc0, int t0, u64* mask0, int lane) {
    t0 = __builtin_amdgcn_readfirstlane(t0);
    const int nmax = t0 + 8;
    if (nmax <= 256) {
#pragma unroll 1
        for (int rr = 0; rr < 8; ++rr) { const int n = t0 + rr + 1;
            if (lane < 32) { const int lo = 64 * lane; const u64 word = (n >= lo + 64) ? ~0ull : (n > lo ? ((1ull << (n - lo)) - 1ull) : 0ull); mask0[(size_t)rr * 32 + lane] = word; } }
    } else if (nmax <= 512) select_rows8<8>(sc0, t0 + 1, mask0, lane);
    else if (nmax <= 1024) select_rows8<16>(sc0, t0 + 1, mask0, lane);
    else if (nmax <= 1536) select_rows8<24>(sc0, t0 + 1, mask0, lane);
    else select_rows8<32>(sc0, t0 + 1, mask0, lane);
}

__device__ __forceinline__ void p4_prompt_unit(const Frame& F, int b, int qt, int parts, LAS int* qslot, unsigned* qhead) {
    const bf16_t* QI = WSP(bf16_t, WS_QI); const bf16_t* KI = WSP(bf16_t, WS_KI); const float* WI = WSP(float, WS_WI); float* SC = WSP(float, WS_SCR); u64* MASK = WSP(u64, WS_MASK);
    const int w = F.wave, lane = F.lane, q = lane & 31, half = lane >> 5;
    if (!(parts & 32)) {
    {
#pragma unroll
        for (int i = 0; i < 8; ++i) { const int e = F.tid + 512 * i, rw = e >> 6, ch = e & 63;
            *(LAS u32x4*)(F.lds + rw * QL_STRIDE + ch * 16) = *(const u32x4*)(QI + ((size_t)b * 2048 + qt * 64 + rw) * 512 + ch * 8); }
    }
    __syncthreads();
    {
        const int qh = w & 1, stripe = w >> 1, t0 = qt * 64 + qh * 32;
        const size_t rowq = (size_t)b * 2048 + t0 + q;
        const LAS unsigned char* qb = F.lds + (qh * 32 + q) * QL_STRIDE + half * 16;
        float w8[8];
        { const f32x4 a = *(const f32x4*)(WI + rowq * 8), c = *(const f32x4*)(WI + rowq * 8 + 4); w8[0] = a[0]; w8[1] = a[1]; w8[2] = a[2]; w8[3] = a[3]; w8[4] = c[0]; w8[5] = c[1]; w8[6] = c[2]; w8[7] = c[3]; }
        const int nkt = t0 / 32 + 1;
        if (stripe < nkt) {
            bf16x8 ka[4], kb[4];
#define P4_LOADK(dst, kt_) do { const int k_ = (kt_) < nkt ? (kt_) : stripe; const size_t rowk_ = (size_t)b * 2048 + k_ * 32 + q; \
        _Pragma("unroll") for (int s_ = 0; s_ < 4; ++s_) dst[s_] = *(const bf16x8*)(KI + rowk_ * 64 + s_ * 16 + half * 8); } while (0)
#define P4_STORE(scv, kt_) do { float* dst_ = SC + rowq * 2048 + (kt_) * 32 + 4 * half; \
        _Pragma("unroll") for (int g_ = 0; g_ < 4; ++g_) *(f32x4*)(dst_ + 8 * g_) = (f32x4){scv[4 * g_], scv[4 * g_ + 1], scv[4 * g_ + 2], scv[4 * g_ + 3]}; } while (0)
            P4_LOADK(ka, stripe);
#pragma unroll 1
            for (int kt = stripe; kt < nkt; kt += 4) {
                P4_LOADK(kb, kt + 4); __builtin_amdgcn_sched_barrier(0);
                const f32x16 sc = idx_tile(ka, qb, w8);
#pragma unroll
                for (int s = 0; s < 4; ++s) ka[s] = kb[s];
                __builtin_amdgcn_sched_barrier(0);
                P4_STORE(sc, kt);
            }
#undef P4_LOADK
#undef P4_STORE
        }
    }
    }
    __syncthreads();
    int unext = 0;
    if (F.tid == 0) unext = (int)__hip_atomic_fetch_add(qhead, 1u, __ATOMIC_RELAXED, __HIP_MEMORY_SCOPE_AGENT);
    if (!(parts & 16)) { const int t0 = qt * 64 + w * 8; const size_t row = (size_t)b * 2048 + t0; select_rows8_prompt(SC + row * 2048, t0, MASK + row * 32, lane); }
    if (F.tid == 0) *qslot = unext;
    __syncthreads();
}

__device__ __forceinline__ void p4_sample_unit(const Frame& F, int b) {
    const bf16_t* QI = WSP(bf16_t, WS_QI); const bf16_t* KI = WSP(bf16_t, WS_KI); const float* WI = WSP(float, WS_WI);
    const bf16_t* Q = WSP(bf16_t, WS_Q); const bf16_t* K = WSP(bf16_t, WS_K); const bf16_t* V = WSP(bf16_t, WS_V); bf16_t* ATT = WSP(bf16_t, WS_ATT);
    constexpr int SLW = 8224;
    constexpr int NEWKEY = 0x40000000;
    LAS unsigned* SL = (LAS unsigned*)F.lds;
    LAS int* SELR = (LAS int*)(F.lds + 4 * SLW * 4);
    LAS unsigned char* QL = F.lds + 4 * SLW * 4 + 4096;
    LAS int* CNT = (LAS int*)(F.lds + 4 * SLW * 4 + 4096 + 4 * QL_STRIDE);
    const int w = F.wave, lane = F.lane, q = lane & 31, half = lane >> 5, tid = F.tid;
    const int* pt = F.page_table + b * NPG;
    const size_t r0 = (size_t)TP + b * 4;
    if (tid < 256) { const int rw = tid >> 6, ch = tid & 63; *(LAS u32x4*)(QL + rw * QL_STRIDE + ch * 16) = *(const u32x4*)(QI + (r0 + rw) * 512 + ch * 8); }
    if (tid < 32) ((LAS float*)(QL + 4 * QL_STRIDE + 256))[tid] = WI[r0 * 8 + tid];
    LAS int* PTL = (LAS int*)(QL + 4 * QL_STRIDE + 512);
    if (tid >= 64 && tid < 128) PTL[tid - 64] = pt[tid - 64];
    __syncthreads();
    {
        const size_t rowq = r0 + (q & 3);
        const LAS unsigned char* qb = QL + (q & 3) * QL_STRIDE + half * 16;
        const LAS float* wl = (const LAS float*)(QL + 4 * QL_STRIDE + 256) + (q & 3) * 8;
        const float w8[8] = {0.f, 0.f, 0.f, 0.f, 0.f, 0.f, 0.f, 0.f};
        (void)rowq;
        f32x4 ta[8], tb[8];
#define SMP_LOAD(dst, kt_) do { const int k_ = (kt_) < 256 ? (kt_) : 255; const float* kr_ = F.cache_kidx + ((size_t)PTL[k_ >> 2] * PAGE + ((k_ & 3) * 32 + q)) * 64 + half * 8; \
        _Pragma("unroll") for (int s_ = 0; s_ < 4; ++s_) { dst[2 * s_] = *(const f32x4*)(kr_ + s_ * 16); dst[2 * s_ + 1] = *(const f32x4*)(kr_ + s_ * 16 + 4); } } while (0)
#define SMP_TILE(srcb, kt_) do { if ((kt_) < 256) { bf16x8 kf_[4]; \
        _Pragma("unroll") for (int s_ = 0; s_ < 4; ++s_) { const f32x4 a_ = srcb[2 * s_], c_ = srcb[2 * s_ + 1]; \
            u32x4 wv_; wv_.x = cvt_pk_bf16(a_[0], a_[1]); wv_.y = cvt_pk_bf16(a_[2], a_[3]); wv_.z = cvt_pk_bf16(c_[0], c_[1]); wv_.w = cvt_pk_bf16(c_[2], c_[3]); kf_[s_] = __builtin_bit_cast(bf16x8, wv_); } \
        const f32x16 sc_ = idx_tile_t<true>(kf_, qb, w8, wl); \
        if (q < 4) { _Pragma("unroll") for (int i_ = 0; i_ < 16; ++i_) SL[q * SLW + (kt_) * 32 + 8 * (i_ >> 2) + 4 * half + (i_ & 3)] = mono(sc_[i_]); } } } while (0)
        SMP_LOAD(ta, w);
#pragma unroll 1
        for (int kt = w; kt < 256; kt += 16) {
            SMP_LOAD(tb, kt + 8); __builtin_amdgcn_sched_barrier(0); SMP_TILE(ta, kt);
            SMP_LOAD(ta, kt + 16); __builtin_amdgcn_sched_barrier(0); SMP_TILE(tb, kt + 8);
        }
#undef SMP_LOAD
#undef SMP_TILE
        if (w == 0) {
            bf16x8 kf[4];
#pragma unroll
            for (int s = 0; s < 4; ++s) { u32x4 wv = (u32x4){0u, 0u, 0u, 0u}; if (q < 4) wv = *(const u32x4*)(KI + (r0 + q) * 64 + s * 16 + half * 8); kf[s] = __builtin_bit_cast(bf16x8, wv); }
            const f32x16 sc = idx_tile_t<true>(kf, qb, w8, wl);
            if (q < 4) {
#pragma unroll
                for (int i = 0; i < 16; ++i) SL[q * SLW + 256 * 32 + 8 * (i >> 2) + 4 * half + (i & 3)] = mono(sc[i]);
            }
        }
    }
    __syncthreads();
    {
        const int j = w >> 1, hw = w & 1, n = PAST + 1 + j;
        unsigned key[65];
#pragma unroll
        for (int k = 0; k < 65; ++k) { const int idx = hw * 4160 + 64 * k + lane; key[k] = 0u; if (idx < n) key[k] = SL[j * SLW + idx]; }
        unsigned thr = 0u;
#pragma unroll 1
        for (int bit = 31; bit >= 0; --bit) {
            const unsigned cand = thr | (1u << bit); int c = 0;
#pragma unroll
            for (int k = 0; k < 65; ++k) c += __popcll(__ballot(key[k] >= cand));
            if (lane == 0) CNT[(bit & 1) * 8 + w] = c;
            __syncthreads();
            const int tot = CNT[(bit & 1) * 8 + (w & ~1)] + CNT[(bit & 1) * 8 + (w | 1)];
            if (tot >= 256) thr = cand;
        }
        int cgt = 0, ceq = 0;
#pragma unroll 1
        for (int k = 0; k < 65; ++k) { const int idx = hw * 4160 + 64 * k + lane; const unsigned kk = idx < n ? SL[j * SLW + idx] : 0u;
            cgt += __popcll(__ballot(kk > thr)); ceq += __popcll(__ballot(kk == thr)); }
        if (lane == 0) { CNT[16 + w * 2] = cgt; CNT[16 + w * 2 + 1] = ceq; }
        __syncthreads();
        const int cgt0 = CNT[16 + (w & ~1) * 2], ceq0 = CNT[16 + (w & ~1) * 2 + 1], cgt1 = CNT[16 + (w | 1) * 2];
        const int need_tot = 256 - (cgt0 + cgt1);
        const int take0 = ceq0 < need_tot ? ceq0 : need_tot;
        int need = hw == 0 ? take0 : need_tot - take0;
        int base = hw == 0 ? 0 : cgt0 + take0;
#pragma unroll 1
        for (int k = 0; k < 65; ++k) {
            const int idx = hw * 4160 + 64 * k + lane; const unsigned kk = idx < n ? SL[j * SLW + idx] : 0u;
            const u64 eq = __ballot(kk == thr);
            const int rank = (int)__builtin_amdgcn_mbcnt_hi((unsigned)(eq >> 32), __builtin_amdgcn_mbcnt_lo((unsigned)eq, 0u));
            const bool on = kk > thr || (kk == thr && rank < need);
            const u64 sel = __ballot(on);
            const int pe = __popcll(eq); need = need > pe ? need - pe : 0;
            if (on) { const int pos = base + (int)__builtin_amdgcn_mbcnt_hi((unsigned)(sel >> 32), __builtin_amdgcn_mbcnt_lo((unsigned)sel, 0u));
                if (pos < 256) SELR[j * 256 + pos] = idx < PAST ? PTL[idx >> 7] * PAGE + (idx & 127) : (NEWKEY | (idx - PAST)); }
            base += __popcll(sel);
        }
    }
    __syncthreads();
    {
        LAS float* QF4 = (LAS float*)F.lds;
        LAS float* LG4 = (LAS float*)(F.lds + 8192);
        LAS float* PV4 = (LAS float*)(F.lds + 8192 + 32768);
#pragma unroll
        for (int j = 0; j < 4; ++j) QF4[j * 512 + tid] = bf2f(Q[(r0 + j) * 512 + tid]);
        __syncthreads();
#pragma unroll 1
        for (int j = 0; j < 4; ++j) {
            const int slot = tid >> 1, kvh = tid & 1; const int row = SELR[j * 256 + slot];
            float d0 = 0.f, d1 = 0.f, d2 = 0.f, d3 = 0.f;
            const LAS float* qb = QF4 + j * 512 + kvh * 256;
            if (row < NEWKEY) {
                const float* kr = F.cache_k + ((size_t)row * 2 + kvh) * 64;
                f32x4 kv[16];
#pragma unroll
                for (int c = 0; c < 16; ++c) kv[c] = *(const f32x4*)(kr + c * 4);
#pragma unroll
                for (int c = 0; c < 16; ++c)
#pragma unroll
                    for (int e = 0; e < 4; ++e) { const float kk = kv[c][e]; const int dd = c * 4 + e; d0 += kk * qb[dd]; d1 += kk * qb[64 + dd]; d2 += kk * qb[128 + dd]; d3 += kk * qb[192 + dd]; }
            } else {
                const bf16_t* kr = K + (r0 + (row - NEWKEY)) * 128 + kvh * 64;
#pragma unroll
                for (int c = 0; c < 8; ++c) { float kv[8]; unpack8(*(const u32x4*)(kr + c * 8), kv);
#pragma unroll
                    for (int e = 0; e < 8; ++e) { const float kk = kv[e]; const int dd = c * 8 + e; d0 += kk * qb[dd]; d1 += kk * qb[64 + dd]; d2 += kk * qb[128 + dd]; d3 += kk * qb[192 + dd]; } }
            }
            LAS float* lg = LG4 + j * 2048 + kvh * 1024 + slot;
            lg[0] = d0 * 0.125f; lg[256] = d1 * 0.125f; lg[512] = d2 * 0.125f; lg[768] = d3 * 0.125f;
        }
        __syncthreads();
#pragma unroll 1
        for (int j = 0; j < 4; ++j) {
            LAS float* lr = LG4 + j * 2048 + w * 256;
            float v0 = lr[lane], v1 = lr[64 + lane], v2 = lr[128 + lane], v3 = lr[192 + lane];
            const float mx = wave_max(fmaxf(fmaxf(v0, v1), fmaxf(v2, v3)));
            v0 = __expf(v0 - mx); v1 = __expf(v1 - mx); v2 = __expf(v2 - mx); v3 = __expf(v3 - mx);
            const float inv = 1.0f / wave_sum(v0 + v1 + v2 + v3);
            lr[lane] = v0 * inv; lr[64 + lane] = v1 * inv; lr[128 + lane] = v2 * inv; lr[192 + lane] = v3 * inv;
        }
        __syncthreads();
#pragma unroll 1
        for (int j = 0; j < 4; ++j) {
            float acc[8];
#pragma unroll
            for (int h = 0; h < 8; ++h) acc[h] = 0.f;
#pragma unroll 1
            for (int s0 = 0; s0 < 32; s0 += 16) {
                float v0[16], v1[16];
#pragma unroll
                for (int i = 0; i < 16; ++i) { const int row = SELR[j * 256 + w * 32 + s0 + i];
                    if (row < NEWKEY) { const float* vr = F.cache_v + (size_t)row * 128 + lane; v0[i] = vr[0]; v1[i] = vr[64]; }
                    else { const bf16_t* vr = V + (r0 + (row - NEWKEY)) * 128 + lane; v0[i] = bf2f(vr[0]); v1[i] = bf2f(vr[64]); } }
#pragma unroll
                for (int i = 0; i < 16; ++i) { const int slot = w * 32 + s0 + i;
#pragma unroll
                    for (int h = 0; h < 8; ++h) acc[h] += LG4[j * 2048 + h * 256 + slot] * (h < 4 ? v0[i] : v1[i]); }
            }
#pragma unroll
            for (int h = 0; h < 8; ++h) PV4[(w * 4 + j) * 512 + h * 64 + lane] = acc[h];
        }
        __syncthreads();
#pragma unroll
        for (int j = 0; j < 4; ++j) { float o = 0.f;
#pragma unroll
            for (int ww = 0; ww < 8; ++ww) o += PV4[(ww * 4 + j) * 512 + tid];
            ATT[(r0 + j) * 512 + tid] = (bf16_t)(cvt_pk_bf16(o, 0.f) & 0xffffu); }
        __syncthreads();
    }
}

__device__ __forceinline__ void p4_all(const Frame& F, int rep, int parts) {
    if (parts & 1) p4_vtranspose(F);
    if (parts & 2) p4_conv(F);
    if (parts & 4) { for (int b = F.bid; b < DB; b += F.nblk) p4_sample_unit(F, b); }
    if (!(parts & 8)) return;
    LAS int* qslot = (LAS int*)(F.lds + LDS_MISC + 32);
    __syncthreads();
    if (F.tid == 0) *qslot = (int)__hip_atomic_fetch_add(F.ctl + CW_Q4 + 64 * rep, 1u, __ATOMIC_RELAXED, __HIP_MEMORY_SCOPE_AGENT);
    for (;;) {
        __syncthreads();
        const int u = *qslot;
        if (u >= NB * 32) break;
        p4_prompt_unit(F, u & 31, 31 - (u >> 5), parts, qslot, F.ctl + CW_Q4 + 64 * rep);
    }
}

template <bool FAST> __device__ __forceinline__ void p5_unit_t(const Frame& F, int b, int kvh, int qt, const bf16x8 (&qf)[4], float mq, u32x4 kv, u32x4 vv, u64 mw) {
    const bf16_t* Q = WSP(bf16_t, WS_Q); const bf16_t* K = WSP(bf16_t, WS_K); const bf16_t* VTR = WSP(bf16_t, WS_VTR); const u64* MASK = WSP(u64, WS_MASK); bf16_t* ATT = WSP(bf16_t, WS_ATT);
    LAS unsigned char* Kl = F.lds;
    LAS unsigned char* Vl = F.lds + 64 * 144;
    const int w = F.wave, lane = F.lane, q = lane & 31, half = lane >> 5, tid = F.tid;
    const int g = w & 3, th = w >> 2, head = kvh * 4 + g;
    const size_t rowq = (size_t)b * 2048 + qt * 64 + th * 32 + q;
    f32x16 O0, O1;
#pragma unroll
    for (int i = 0; i < 16; ++i) { O0[i] = 0.f; O1[i] = 0.f; }
    float mrun = -1e30f, lrun = 0.f;
    const int rw = tid >> 3, ch = tid & 7;
    const bf16_t* kgp = K + ((size_t)b * 2048 + rw) * 128 + kvh * 64 + ch * 8;
    const bf16_t* vgp = VTR + ((size_t)((b * 2 + kvh) * 64 + rw)) * 2048 + ch * 8;
    for (int kt = 0; kt <= qt; ++kt) {
        __syncthreads();
        *(LAS u32x4*)(Kl + rw * 144 + ch * 16) = kv;
        *(LAS u32x4*)(Vl + rw * 144 + ch * 16) = vv;
        const u64 mwc = mw;
        __syncthreads();
        { const int kn = kt < qt ? kt + 1 : kt;
          kv = *(const u32x4*)(kgp + (size_t)kn * 64 * 128); vv = *(const u32x4*)(vgp + kn * 64); mw = MASK[rowq * 32 + kn]; }
        f32x16 S[2];
#pragma unroll
        for (int ks = 0; ks < 2; ++ks) {
            f32x16 a;
#pragma unroll
            for (int i = 0; i < 16; ++i) a[i] = FAST ? -mq : 0.f;
#pragma unroll
            for (int s = 0; s < 4; ++s) { const bf16x8 kf = *(const LAS bf16x8*)(Kl + (ks * 32 + q) * 144 + s * 32 + half * 16); a = __builtin_amdgcn_mfma_f32_32x32x16_bf16(kf, qf[s], a, 0, 0, 0); }
            S[ks] = a;
        }
        const u64 mh = mwc >> (4 * half);
        const unsigned mword[2] = {(unsigned)mh, (unsigned)(mh >> 32)};
        if (FAST) {
            float ls = 0.f;
#pragma unroll
            for (int ks = 0; ks < 2; ++ks)
#pragma unroll
                for (int i = 0; i < 16; ++i) { const unsigned keep = (unsigned)__builtin_amdgcn_sbfe((int)mword[ks], 8 * (i >> 2) + (i & 3), 1);
                    const float p = __uint_as_float(__float_as_uint(__builtin_amdgcn_exp2f(S[ks][i])) & keep); S[ks][i] = p; ls += p; }
            lrun += ls;
        } else {
            float mx = -INFINITY;
#pragma unroll
            for (int ks = 0; ks < 2; ++ks)
#pragma unroll
                for (int i = 0; i < 16; ++i) { const bool on = (mword[ks] >> (8 * (i >> 2) + (i & 3))) & 1u; const float sv = on ? S[ks][i] : -INFINITY; S[ks][i] = sv; mx = fmaxf(mx, sv); }
            mx = fmaxf(mx, __shfl_xor(mx, 32));
            const float mnew = fmaxf(mrun, mx);
            const float alpha = __builtin_amdgcn_exp2f(mrun - mnew);
            float ls = 0.f;
#pragma unroll
            for (int ks = 0; ks < 2; ++ks)
#pragma unroll
                for (int i = 0; i < 16; ++i) { const float p = __builtin_amdgcn_exp2f(S[ks][i] - mnew); S[ks][i] = p; ls += p; }
            lrun = lrun * alpha + ls;
            if (__any(mnew != mrun)) {
#pragma unroll
                for (int i = 0; i < 16; ++i) { O0[i] *= alpha; O1[i] *= alpha; } }
            mrun = mnew;
        }
#pragma unroll
        for (int ks = 0; ks < 2; ++ks)
#pragma unroll
            for (int s2 = 0; s2 < 2; ++s2) {
                u32x4 pw; pw.x = cvt_pk_bf16(S[ks][8 * s2 + 0], S[ks][8 * s2 + 1]); pw.y = cvt_pk_bf16(S[ks][8 * s2 + 2], S[ks][8 * s2 + 3]); pw.z = cvt_pk_bf16(S[ks][8 * s2 + 4], S[ks][8 * s2 + 5]); pw.w = cvt_pk_bf16(S[ks][8 * s2 + 6], S[ks][8 * s2 + 7]);
                const bf16x8 pf = __builtin_bit_cast(bf16x8, pw);
                const int kb = (ks * 32 + 16 * s2 + 4 * half) * 2;
                { const u32x2 a = *(const LAS u32x2*)(Vl + q * 144 + kb), c = *(const LAS u32x2*)(Vl + q * 144 + kb + 16);
                  const bf16x8 vf = __builtin_bit_cast(bf16x8, (u32x4){a.x, a.y, c.x, c.y}); O0 = __builtin_amdgcn_mfma_f32_32x32x16_bf16(vf, pf, O0, 0, 0, 0); }
                { const u32x2 a = *(const LAS u32x2*)(Vl + (32 + q) * 144 + kb), c = *(const LAS u32x2*)(Vl + (32 + q) * 144 + kb + 16);
                  const bf16x8 vf = __builtin_bit_cast(bf16x8, (u32x4){a.x, a.y, c.x, c.y}); O1 = __builtin_amdgcn_mfma_f32_32x32x16_bf16(vf, pf, O1, 0, 0, 0); }
            }
    }
    const float inv = 1.0f / (lrun + __shfl_xor(lrun, 32));
    bf16_t* op = ATT + rowq * 512 + head * 64 + 4 * half;
#pragma unroll
    for (int gq = 0; gq < 4; ++gq) {
        u32x2 a; a.x = cvt_pk_bf16(O0[4 * gq] * inv, O0[4 * gq + 1] * inv); a.y = cvt_pk_bf16(O0[4 * gq + 2] * inv, O0[4 * gq + 3] * inv); *(u32x2*)(op + 8 * gq) = a;
        u32x2 c; c.x = cvt_pk_bf16(O1[4 * gq] * inv, O1[4 * gq + 1] * inv); c.y = cvt_pk_bf16(O1[4 * gq + 2] * inv, O1[4 * gq + 3] * inv); *(u32x2*)(op + 32 + 8 * gq) = c;
    }
}
__device__ __forceinline__ void p5_unit_fast(const Frame& F, int b, int kvh, int qt, const bf16x8 (&qf)[4], float mq, u32x4 kv, u32x4 vv, u32x4 kv1, u32x4 vv1, u64 mcur, u64 mnxt) {
    const bf16_t* K = WSP(bf16_t, WS_K); const bf16_t* VTR = WSP(bf16_t, WS_VTR); const u64* MASK = WSP(u64, WS_MASK); bf16_t* ATT = WSP(bf16_t, WS_ATT);
    LAS unsigned char* Kl = F.lds;
    LAS unsigned char* Vl = F.lds + 3 * 64 * 144;
    const int w = F.wave, lane = F.lane, q = lane & 31, half = lane >> 5, tid = F.tid;
    const int g = w & 3, th = w >> 2, head = kvh * 4 + g;
    const size_t rowq = (size_t)b * 2048 + qt * 64 + th * 32 + q;
    f32x16 O0, O1, L;
#pragma unroll
    for (int i = 0; i < 16; ++i) { O0[i] = 0.f; O1[i] = 0.f; L[i] = 0.f; }
    bf16x8 ones;
    { u32x4 o; o.x = o.y = o.z = o.w = 0x3F803F80u; asm volatile("" : "+v"(o)); ones = __builtin_bit_cast(bf16x8, o); }
    const int rw = tid >> 3, ch = tid & 7, nt = qt + 1;
    const int vwo = (ch >> 1) * 32 + (ch & 1) * 8;
    const bf16_t* kgp = K + ((size_t)b * 2048 + rw) * 128 + kvh * 64 + ch * 8;
    const bf16_t* vgp = VTR + ((size_t)((b * 2 + kvh) * 64 + rw)) * 2048 + ch * 8;
    const int k2 = nt > 2 ? 2 : 0;
    __syncthreads();
    *(LAS u32x4*)(Kl + rw * 144 + ch * 16) = kv; *(LAS u32x2*)(Vl + rw * 144 + vwo) = (u32x2){vv.x, vv.y}; *(LAS u32x2*)(Vl + rw * 144 + vwo + 16) = (u32x2){vv.z, vv.w};
    *(LAS u32x4*)(Kl + 9216 + rw * 144 + ch * 16) = kv1; *(LAS u32x2*)(Vl + 9216 + rw * 144 + vwo) = (u32x2){vv1.x, vv1.y}; *(LAS u32x2*)(Vl + 9216 + rw * 144 + vwo + 16) = (u32x2){vv1.z, vv1.w};
    __syncthreads();
    kv = *(const u32x4*)(kgp + (size_t)k2 * 64 * 128); vv = *(const u32x4*)(vgp + k2 * 64);
    int ob0 = 0, ob1 = 9216, ob2 = 18432;
    f32x16 SA[2], SB[2];
#pragma unroll
    for (int ks = 0; ks < 2; ++ks) {
        f32x16 a;
#pragma unroll
        for (int i = 0; i < 16; ++i) a[i] = 0.f;
#pragma unroll
        for (int s = 0; s < 4; ++s) { const bf16x8 kf = *(const LAS bf16x8*)(Kl + (ks * 32 + q) * 144 + s * 32 + half * 16); a = __builtin_amdgcn_mfma_f32_32x32x16_bf16(kf, qf[s], a, 0, 0, 0); }
        SA[ks] = a;
    }
    auto tile = [&](f32x16 (&Sc)[2], f32x16 (&Sn)[2], const int kt) __attribute__((always_inline)) {
        *(LAS u32x4*)(Kl + ob2 + rw * 144 + ch * 16) = kv; *(LAS u32x2*)(Vl + ob2 + rw * 144 + vwo) = (u32x2){vv.x, vv.y}; *(LAS u32x2*)(Vl + ob2 + rw * 144 + vwo + 16) = (u32x2){vv.z, vv.w};
        { const int kn = kt + 3 < nt ? kt + 3 : kt;
          kv = *(const u32x4*)(kgp + (size_t)kn * 64 * 128); vv = *(const u32x4*)(vgp + kn * 64); }
        const u64 mnn = MASK[rowq * 32 + (kt + 2 < nt ? kt + 2 : kt)];
        bf16x8 kf[9];
        const LAS unsigned char* kfb = Kl + ob1 + q * 144 + half * 16;
        kf[0] = *(const LAS bf16x8*)kfb;
        const u64 mh = mcur >> (4 * half);
        const unsigned mword[2] = {(unsigned)mh, (unsigned)(mh >> 32)};
#pragma unroll
        for (int i = 0; i < 16; ++i) { Sn[0][i] = 0.f; Sn[1][i] = 0.f; }
#pragma unroll
        for (int j = 0; j < 8; ++j) {
            const int ks = j & 1, s = j >> 1;
            if (j < 7) kf[j + 1] = *(const LAS bf16x8*)(kfb + ((j + 1) & 1) * 32 * 144 + ((j + 1) >> 1) * 32);
            Sn[ks] = __builtin_amdgcn_mfma_f32_32x32x16_bf16(kf[j], qf[s], Sn[ks], 0, 0, 0);
            const int eks = j >> 2;
#pragma unroll
            for (int e = 0; e < 4; ++e) { const int i = (j & 3) * 4 + e;
                unsigned keep;
                asm("v_bfe_i32 %0, %1, %2, 1" : "=v"(keep) : "v"(mword[eks]), "n"(8 * (i >> 2) + (i & 3)));
                Sc[eks][i] = __uint_as_float(__float_as_uint(__builtin_amdgcn_exp2f(Sc[eks][i])) & keep); }
            __builtin_amdgcn_sched_barrier(0);
        }
#pragma unroll
        for (int ks = 0; ks < 2; ++ks)
#pragma unroll
            for (int s2 = 0; s2 < 2; ++s2) {
                u32x4 pw; pw.x = cvt_pk_bf16(Sc[ks][8 * s2 + 0], Sc[ks][8 * s2 + 1]); pw.y = cvt_pk_bf16(Sc[ks][8 * s2 + 2], Sc[ks][8 * s2 + 3]); pw.z = cvt_pk_bf16(Sc[ks][8 * s2 + 4], Sc[ks][8 * s2 + 5]); pw.w = cvt_pk_bf16(Sc[ks][8 * s2 + 6], Sc[ks][8 * s2 + 7]);
                const bf16x8 pf = __builtin_bit_cast(bf16x8, pw);
                const int kb = (ks * 2 + s2) * 32 + half * 16;
                const LAS unsigned char* vb = Vl + ob0;
                { const bf16x8 vf = *(const LAS bf16x8*)(vb + q * 144 + kb); O0 = __builtin_amdgcn_mfma_f32_32x32x16_bf16(vf, pf, O0, 0, 0, 0); }
                { const bf16x8 vf = *(const LAS bf16x8*)(vb + (32 + q) * 144 + kb); O1 = __builtin_amdgcn_mfma_f32_32x32x16_bf16(vf, pf, O1, 0, 0, 0); }
                L = __builtin_amdgcn_mfma_f32_32x32x16_bf16(ones, pf, L, 0, 0, 0);
            }
        mcur = mnxt; mnxt = mnn;
        { const int t = ob0; ob0 = ob1; ob1 = ob2; ob2 = t; }
        __syncthreads();
    };
    int kt = 0;
    for (; kt + 1 < nt; kt += 2) { tile(SA, SB, kt); tile(SB, SA, kt + 1); }
    if (kt < nt) tile(SA, SB, kt);
    const float inv = 1.0f / L[0];
    bf16_t* op = ATT + rowq * 512 + head * 64 + 4 * half;
#pragma unroll
    for (int gq = 0; gq < 4; ++gq) {
        u32x2 a; a.x = cvt_pk_bf16(O0[4 * gq] * inv, O0[4 * gq + 1] * inv); a.y = cvt_pk_bf16(O0[4 * gq + 2] * inv, O0[4 * gq + 3] * inv); *(u32x2*)(op + 8 * gq) = a;
        u32x2 c; c.x = cvt_pk_bf16(O1[4 * gq] * inv, O1[4 * gq + 1] * inv); c.y = cvt_pk_bf16(O1[4 * gq + 2] * inv, O1[4 * gq + 3] * inv); *(u32x2*)(op + 32 + 8 * gq) = c;
    }
}
__device__ __forceinline__ void p5_unit(const Frame& F, int b, int kvh, int qt, float kbound) {
    const bf16_t* Q = WSP(bf16_t, WS_Q);
    const int w = F.wave, lane = F.lane, q = lane & 31, half = lane >> 5;
    const int g = w & 3, th = w >> 2, head = kvh * 4 + g;
    const size_t rowq = (size_t)b * 2048 + qt * 64 + th * 32 + q;
    bf16x8 qf[4]; float qs = 0.f;
    u32x4 qraw[4];
#pragma unroll
    for (int s = 0; s < 4; ++s) qraw[s] = *(const u32x4*)(Q + rowq * 512 + head * 64 + s * 16 + half * 8);
    const int rw0 = F.tid >> 3, ch0 = F.tid & 7, k1 = qt > 0 ? 1 : 0;
    const bf16_t* kgp0 = WSP(bf16_t, WS_K) + ((size_t)b * 2048 + rw0) * 128 + kvh * 64 + ch0 * 8;
    const bf16_t* vgp0 = WSP(bf16_t, WS_VTR) + ((size_t)((b * 2 + kvh) * 64 + rw0)) * 2048 + ch0 * 8;
    const u32x4 kv0 = *(const u32x4*)kgp0, vv0 = *(const u32x4*)vgp0;
    const u32x4 kv1 = *(const u32x4*)(kgp0 + (size_t)k1 * 64 * 128), vv1 = *(const u32x4*)(vgp0 + k1 * 64);
    const u64 m0 = WSP(u64, WS_MASK)[rowq * 32], m1 = WSP(u64, WS_MASK)[rowq * 32 + k1];
#pragma unroll
    for (int s = 0; s < 4; ++s) { float t8[8]; unpack8(qraw[s], t8);
#pragma unroll
        for (int e = 0; e < 8; ++e) t8[e] *= 0.125f * 1.4426950408889634f;
        const u32x4 pk = pack8(t8); qf[s] = __builtin_bit_cast(bf16x8, pk);
        float r8[8]; unpack8(pk, r8);
#pragma unroll
        for (int e = 0; e < 8; ++e) qs += r8[e] * r8[e]; }
    qs += __shfl_xor(qs, 32);
    const float mq = sqrtf(qs) * kbound;
    if (!__any(!(mq <= 40.0f))) p5_unit_fast(F, b, kvh, qt, qf, mq, kv0, vv0, kv1, vv1, m0, m1);
    else p5_unit_t<false>(F, b, kvh, qt, qf, 0.f, kv0, vv0, m0);
}
__device__ __forceinline__ void p5_all(const Frame& F, int rep) {
    const float kbound = 8.1f * wave_max(fabsf(F.k_norm_w[F.lane]));

    LAS int* qslot = (LAS int*)(F.lds + LDS_MISC + 32);
    const int xq = blockIdx.x & 7;
    int unext = 0;
    if (F.tid == 0) unext = (int)__hip_atomic_fetch_add(F.ctl + CW_Q5 + 64 * (xq + 8 * rep), 1u, __ATOMIC_RELAXED, __HIP_MEMORY_SCOPE_AGENT);
    for (;;) {
        __syncthreads();
        if (F.tid == 0) *qslot = unext;
        __syncthreads();
        const int u = *qslot;
        if (u >= 4 * 2 * 32) break;
        if (F.tid == 0) unext = (int)__hip_atomic_fetch_add(F.ctl + CW_Q5 + 64 * (xq + 8 * rep), 1u, __ATOMIC_RELAXED, __HIP_MEMORY_SCOPE_AGENT);
        p5_unit(F, 4 * xq + ((u >> 1) & 3), u & 1, 31 - (u >> 3), kbound);
    }
}

__device__ __forceinline__ void ce_desc(unsigned& a, unsigned& b) { const unsigned hi = a > b ? a : b, lo = a > b ? b : a; a = hi; b = lo; }
__device__ __forceinline__ void sort16_desc(unsigned (&a)[16]) {
#pragma unroll
    for (int k = 2; k <= 16; k <<= 1)
#pragma unroll
        for (int j = k >> 1; j > 0; j >>= 1)
#pragma unroll
            for (int i = 0; i < 16; ++i) { const int l = i ^ j; if (l > i) { if ((i & k) == 0) ce_desc(a[i], a[l]); else ce_desc(a[l], a[i]); } }
}
__device__ __forceinline__ void merge_top16(unsigned (&L)[16], const unsigned (&N)[16]) {
#pragma unroll
    for (int i = 0; i < 16; ++i) L[i] = L[i] > N[15 - i] ? L[i] : N[15 - i];
#pragma unroll
    for (int j = 8; j > 0; j >>= 1)
#pragma unroll
        for (int i = 0; i < 16; ++i) { const int l = i ^ j; if (l > i) ce_desc(L[i], L[l]); }
}
__device__ __forceinline__ unsigned mono16(unsigned h) { return (h & 0x8000u) ? (~h & 0xffffu) : (h | 0x8000u); }
__device__ __forceinline__ float unmono16(unsigned k) { const unsigned h = (k & 0x8000u) ? (k & 0x7fffu) : (~k & 0xffffu); return (float)__builtin_bit_cast(_Float16, (unsigned short)h); }
__device__ __forceinline__ void p11_select(const Frame& F) {
    const unsigned short* PST = WSP(unsigned short, WS_SCR); int* EIDX = WSP(int, WS_EIDX); float* G = WSP(float, WS_G);
    LAS unsigned char* TILE = F.lds;
    LAS unsigned* LST = (LAS unsigned*)F.lds;
    const int tid = F.tid;
    for (int unit = F.bid; unit < 258 * 8; unit += F.nblk) {
        const int pm = unit >> 3, h = unit & 7;
        const int row = tid & 255, p = tid >> 8;
        __syncthreads();
#pragma unroll
        for (int i = 0; i < 16; ++i) { const int e = tid + 512 * i, rw = e >> 5, ch = e & 31;
            *(LAS u32x4*)(TILE + rw * 528 + ch * 16) = *(const u32x4*)(PST + (size_t)unit * 65536 + rw * 256 + ch * 8); }
        __syncthreads();
        unsigned L[16];
#pragma unroll 1
        for (int k0 = 0; k0 < 128; k0 += 16) {
            const u32x4 a = *(const LAS u32x4*)(TILE + row * 528 + p * 256 + k0 * 2), b = *(const LAS u32x4*)(TILE + row * 528 + p * 256 + k0 * 2 + 16);
            const unsigned wv[8] = {a.x, a.y, a.z, a.w, b.x, b.y, b.z, b.w};
            unsigned N[16];
#pragma unroll
            for (int e = 0; e < 8; ++e) { N[2 * e] = (mono16(wv[e] & 0xffffu) << 16) | (unsigned)(127 - (k0 + 2 * e)); N[2 * e + 1] = (mono16(wv[e] >> 16) << 16) | (unsigned)(127 - (k0 + 2 * e + 1)); }
            sort16_desc(N);
            if (k0 == 0) {
#pragma unroll
                for (int e = 0; e < 16; ++e) L[e] = N[e];
            } else merge_top16(L, N);
        }
        __syncthreads();
#pragma unroll
        for (int q = 0; q < 16; ++q) LST[tid * 17 + q] = L[q];
        __syncthreads();
        if (tid < 256) {
            unsigned L2[16];
#pragma unroll
            for (int q = 0; q < 16; ++q) L2[q] = LST[(tid + 256) * 17 + q];
            float s1[16], s2[16];
#pragma unroll
            for (int q = 0; q < 16; ++q) { s1[q] = unmono16(L[q] >> 16); s2[q] = unmono16(L2[q] >> 16); }
            unsigned C[16], N[16]; int nn = 0; bool first = true;
#pragma unroll
            for (int i = 0; i < 16; ++i)
#pragma unroll
                for (int j = 0; j < 16; ++j)
                    if ((i + 1) * (j + 1) <= 16) {
                        N[nn++] = (mono(s1[i] + s2[j]) & ~255u) | (unsigned)(255 - (i * 16 + j));
                        if (nn == 16) { sort16_desc(N); if (first) {
#pragma unroll
                                for (int e = 0; e < 16; ++e) C[e] = N[e];
                                first = false; } else merge_top16(C, N); nn = 0; }
                    }
            {
#pragma unroll
                for (int e = 2; e < 16; ++e) N[e] = 0u;
                sort16_desc(N); merge_top16(C, N); }
            float sv[16]; int ev[16]; float mx = -INFINITY;
#pragma unroll
            for (int q = 0; q < 16; ++q) { const int pos = 255 - (int)(C[q] & 255u); const int i = pos >> 4, j = pos & 15;
                const unsigned k1 = LST[tid * 17 + i], k2 = LST[(tid + 256) * 17 + j];
                ev[q] = (127 - (int)(k1 & 127u)) * 128 + (127 - (int)(k2 & 127u));
                sv[q] = unmono16(k1 >> 16) + unmono16(k2 >> 16); mx = fmaxf(mx, sv[q]); }
            float sum = 0.f;
#pragma unroll
            for (int q = 0; q < 16; ++q) { sv[q] = __expf(sv[q] - mx); sum += sv[q]; }
            const float inv = 1.0f / sum;
            const size_t ob = ((size_t)(pm * 256 + row) * 8 + h) * 16;
#pragma unroll
            for (int q4 = 0; q4 < 4; ++q4) {
                *(int4*)(EIDX + ob + q4 * 4) = make_int4(ev[q4 * 4], ev[q4 * 4 + 1], ev[q4 * 4 + 2], ev[q4 * 4 + 3]);
                *(f32x4*)(G + ob + q4 * 4) = (f32x4){sv[q4 * 4] * inv, sv[q4 * 4 + 1] * inv, sv[q4 * 4 + 2] * inv, sv[q4 * 4 + 3] * inv}; }
        }
    }
}

typedef float f32x2v __attribute__((ext_vector_type(2)));
typedef __bf16 bf2_t __attribute__((ext_vector_type(2)));
__device__ __forceinline__ float dpp_add_xor1(float x) { return x + __uint_as_float(__builtin_amdgcn_update_dpp(0u, __float_as_uint(x), 0xB1, 0xF, 0xF, true)); }
__device__ __forceinline__ float dpp_add_xor2(float x) { return x + __uint_as_float(__builtin_amdgcn_update_dpp(0u, __float_as_uint(x), 0x4E, 0xF, 0xF, true)); }
__device__ __forceinline__ float dpp_add_hmir(float x) { return x + __uint_as_float(__builtin_amdgcn_update_dpp(0u, __float_as_uint(x), 0x141, 0xF, 0xF, true)); }

constexpr int P12A_TB_ = 48;
__device__ __forceinline__ void p12a_entry(const u32x4 (&rows)[8], int ent, const LAS unsigned char* H2L, int l8, float* ACT, int tb) {
    const int tl = (ent >> 21) & 63, slot = (ent >> 14) & 127;
    const LAS unsigned char* hp = H2L + tl * 2080 + l8 * 32;
    float acc = 0.f;
#pragma unroll
    for (int j = 0; j < 8; ++j) {
        const u32x4 ha = *(const LAS u32x4*)(hp + j * 256), hb = *(const LAS u32x4*)(hp + j * 256 + 16);
        const unsigned hw[8] = {ha.x, ha.y, ha.z, ha.w, hb.x, hb.y, hb.z, hb.w};
        const unsigned uw[4] = {rows[j].x, rows[j].y, rows[j].z, rows[j].w};
#pragma unroll
        for (int k = 0; k < 4; ++k) {
            acc = __builtin_amdgcn_fdot2_f32_bf16(__builtin_amdgcn_cvt_scalef32_pk_bf16_fp8(uw[k], 1.0f, false), __builtin_bit_cast(bf2_t, hw[2 * k]), acc, false);
            acc = __builtin_amdgcn_fdot2_f32_bf16(__builtin_amdgcn_cvt_scalef32_pk_bf16_fp8(uw[k], 1.0f, true), __builtin_bit_cast(bf2_t, hw[2 * k + 1]), acc, false); }
    }
    acc = dpp_add_hmir(dpp_add_xor2(dpp_add_xor1(acc)));
    if (l8 == 0 && ent >= 0) ACT[((size_t)tb * P12A_TB_ + tl) * 128 + slot] = acc;
}

constexpr int P12A_TB = 48, P12A_HSTRIDE = 2080;
__device__ __forceinline__ void p12a_act(const Frame& F, int probe) {
    const unsigned char* H2 = WSP(unsigned char, WS_H); const int* EIDX = WSP(int, WS_EIDX); const unsigned char* UT = WSP(unsigned char, WS_UT); float* ACT = (probe & 64) ? WSP(float, WS_SCR) : WSP(float, WS_ACT);
    const int emask = (probe & 64) ? 0x38ff : 0x3fff;
    LAS unsigned char* H2L = F.lds;
    LAS int* LSTL = (LAS int*)(F.lds + P12A_TB * P12A_HSTRIDE);
    LAS int* CTR = (LAS int*)(F.lds + P12A_TB * P12A_HSTRIDE + 6144 * 4);
    const int lane = F.lane, w = F.wave, tid = F.tid, g = lane >> 3, l8 = lane & 7;
    const bool part = (F.nblk & 7) == 0;
    const int xv = part ? (F.bid & 7) : 0, r = part ? (F.bid >> 3) : F.bid, nr = part ? (F.nblk >> 3) : F.nblk, npass = part ? 1 : 8;
    for (int pass = 0; pass < npass; ++pass) {
        const int v = xv * npass + pass;
        for (int tb = r; tb < T / P12A_TB; tb += nr) {
            u32x4 hreg[12]; int eAs[6], eBs[6];
#pragma unroll
            for (int i = 0; i < 12; ++i) { const int e_ = tid + 512 * i, row = e_ >> 7, ch = e_ & 127; hreg[i] = *(const u32x4*)(H2 + ((size_t)(tb * P12A_TB + row)) * 2048 + ch * 16); }
#pragma unroll
            for (int i = 0; i < 6; ++i) { const size_t t = (size_t)tb * P12A_TB + 6 * w + i; eAs[i] = EIDX[t * 128 + lane]; eBs[i] = EIDX[t * 128 + 64 + lane]; }
            __syncthreads();
            if (tid == 0) *CTR = 0;
#pragma unroll
            for (int i = 0; i < 12; ++i) { const int e_ = tid + 512 * i, row = e_ >> 7, ch = e_ & 127; *(LAS u32x4*)(H2L + row * P12A_HSTRIDE + ch * 16) = hreg[i]; }
            __syncthreads();
#pragma unroll
            for (int i = 0; i < 6; ++i) {
                const int tl = 6 * w + i; const int eA = eAs[i], eB = eBs[i];
                const bool onA = (eA >> 11) == v, onB = (eB >> 11) == v;
                const u64 mA = __ballot(onA), mB = __ballot(onB);
                const int nA = __popcll(mA), cnt = nA + __popcll(mB);
                int base = 0;
                if (lane == 0 && cnt > 0) base = __hip_atomic_fetch_add(CTR, cnt, __ATOMIC_RELAXED, __HIP_MEMORY_SCOPE_WORKGROUP);
                base = __builtin_amdgcn_readfirstlane(base);
                if (onA) LSTL[base + mbcnt64(mA)] = (tl << 21) | (lane << 14) | eA;
                if (onB) LSTL[base + nA + mbcnt64(mB)] = (tl << 21) | ((64 + lane) << 14) | eB;
            }
            __syncthreads();
            const int total = *CTR;
            const int nsteps = (total + 7) >> 3;
#define P12A_ENT(s_) ({ const int ix_ = (s_) * 8 + g; ix_ < total ? LSTL[ix_] : -1; })
#define P12A_ROWS(dst, ent_) do { const unsigned char* rp_ = UT + (size_t)((ent_) & emask) * 1024 + l8 * 16; \
        _Pragma("unroll") for (int j_ = 0; j_ < 8; ++j_) dst[j_] = *(const u32x4*)(rp_ + j_ * 128); } while (0)
            int s = w;
            if (s < nsteps) {
                int e0 = P12A_ENT(s), e1 = P12A_ENT(s + 8);
                u32x4 ra[8], rb[8];
                P12A_ROWS(ra, e0);
                for (;;) {
                    P12A_ROWS(rb, e1);
                    const int e2 = P12A_ENT(s + 16);
                    __builtin_amdgcn_sched_barrier(0);
                    p12a_entry(ra, e0, H2L, l8, ACT, tb);
                    s += 8; if (s >= nsteps) break;
                    P12A_ROWS(ra, e2);
                    const int e3 = P12A_ENT(s + 16);
                    __builtin_amdgcn_sched_barrier(0);
                    p12a_entry(rb, e1, H2L, l8, ACT, tb);
                    s += 8; if (s >= nsteps) break;
                    e0 = e2; e1 = e3;
                }
            }
#undef P12A_ENT
#undef P12A_ROWS
        }
    }
}

__device__ __forceinline__ void p12c_coef(const Frame& F) {
    const int* EIDX = WSP(int, WS_EIDX); const float* G = WSP(float, WS_G); const float* ACT = WSP(float, WS_ACT); const float* USC = WSP(float, WS_TSC); const float* VSC = WSP(float, WS_TSC) + 16384;
    u64* META = WSP(u64, WS_METAG);
    const size_t gt = (size_t)F.bid * 512 + F.tid, gn = (size_t)F.nblk * 512;
    size_t i = gt;
    for (; i + 3 * gn < (size_t)T * 128; i += 4 * gn) {
        int e[4]; float gg[4], aa[4], us[4], vs[4];
#pragma unroll
        for (int k = 0; k < 4; ++k) { e[k] = EIDX[i + k * gn]; gg[k] = G[i + k * gn]; aa[k] = ACT[i + k * gn]; }
#pragma unroll
        for (int k = 0; k < 4; ++k) { us[k] = USC[e[k]]; vs[k] = VSC[e[k]]; }
#pragma unroll
        for (int k = 0; k < 4; ++k) { const float c = gg[k] * gelu_tanh(aa[k] * us[k]) * vs[k]; META[i + k * gn] = (u64)(unsigned)e[k] | ((u64)__float_as_uint(c) << 32); }
    }
    for (; i < (size_t)T * 128; i += gn) { const int e = EIDX[i]; const float c = G[i] * gelu_tanh(ACT[i] * USC[e]) * VSC[e];
        META[i] = (u64)(unsigned)e | ((u64)__float_as_uint(c) << 32); }
}

__device__ __forceinline__ void p12b_out(const Frame& F) {
    const u64* METAG = WSP(u64, WS_METAG); const unsigned char* VT2 = WSP(unsigned char, WS_VT2); const float* MOD = WSP(float, WS_MOD); const bf16_t* Dm = WSP(bf16_t, WS_X1);
    const int lane = F.lane, w = F.wave, g = lane >> 3, l8 = lane & 7;
    LAS u64* META = (LAS u64*)(F.lds + w * 16384);
    const bool part = (F.nblk & 7) == 0;
    const int xv = part ? (F.bid & 7) : 0, r = part ? (F.bid >> 3) : F.bid, nr = part ? (F.nblk >> 3) : F.nblk, npass = part ? 1 : 8;
    const int qstride = nr * 8, nq = T / 8;
    for (int pass = 0; pass < npass; ++pass) {
        const int v = xv * npass + pass;
        const unsigned char* vbase = VT2 + v * 128 + l8 * 16;
        int q = r * 8 + w, buf = 0;
        if (q < nq) {
#pragma unroll
            for (int i = 0; i < 16; ++i) META[i * 64 + lane] = METAG[(size_t)q * 1024 + i * 64 + lane];
        }
        for (; q < nq; q += qstride) {
            const int qn = q + qstride;
            if (qn < nq) {
#pragma unroll
                for (int i = 0; i < 8; ++i) __builtin_amdgcn_global_load_lds((const unsigned*)((const unsigned char*)METAG + (size_t)qn * 8192 + i * 1024 + lane * 16), (LAS unsigned*)((LAS unsigned char*)(META + (buf ^ 1) * 1024) + i * 1024), 16, 0, 0); }
            const LAS u64* mp = META + buf * 1024 + g * 128;
            f32x2v acc[8];
#pragma unroll
            for (int k = 0; k < 8; ++k) acc[k] = (f32x2v){0.f, 0.f};
            u32x4 pa[16], pb[16];
            const LAS unsigned* mw = (const LAS unsigned*)mp;
#define P12B_LOAD(dst, c_) do { _Pragma("unroll") for (int i_ = 0; i_ < 16; ++i_) dst[i_] = *(const u32x4*)(vbase + (size_t)(mw[2 * ((c_) * 16 + i_)] & 0x3fffu) * 1024); } while (0)
#define P12B_FMA(srcb, c_) do { _Pragma("unroll") for (int i_ = 0; i_ < 16; ++i_) { const u32x4 p_ = srcb[i_]; const int wv_[4] = {(int)p_.x, (int)p_.y, (int)p_.z, (int)p_.w}; \
        const float cfv_ = __uint_as_float(mw[2 * ((c_) * 16 + i_) + 1]); const f32x2v cc_ = (f32x2v){cfv_, cfv_}; \
        _Pragma("unroll") for (int k_ = 0; k_ < 4; ++k_) { acc[2 * k_] += cc_ * __builtin_amdgcn_cvt_pk_f32_fp8(wv_[k_], false); acc[2 * k_ + 1] += cc_ * __builtin_amdgcn_cvt_pk_f32_fp8(wv_[k_], true); } } } while (0)
            P12B_LOAD(pa, 0);
#pragma unroll 1
            for (int cc = 0; cc < 3; ++cc) { P12B_LOAD(pb, 2 * cc + 1); P12B_FMA(pa, 2 * cc); P12B_LOAD(pa, 2 * cc + 2); P12B_FMA(pb, 2 * cc + 1); }
            P12B_LOAD(pb, 7); P12B_FMA(pa, 6); P12B_FMA(pb, 7);
#undef P12B_LOAD
#undef P12B_FMA
            { const size_t t = (size_t)q * 8 + g; const int c0 = v * 128 + l8 * 16;
              const float* xr = (t < (size_t)TP ? F.x_prompt + t * 1024 : F.x_sample + (t - TP) * 1024) + c0; const bf16_t* dr = Dm + t * 1024 + c0;
              const float* g2 = MOD + (size_t)mod_row((int)t) * NMOD + 5 * 1024 + c0; float* yr = F.out + t * 1024 + c0;
#pragma unroll
              for (int k = 0; k < 4; ++k) { const u32x2 dv = *(const u32x2*)(dr + 4 * k); const f32x4 xv4 = *(const f32x4*)(xr + 4 * k) + (f32x4){bf_lo(dv.x), bf_hi(dv.x), bf_lo(dv.y), bf_hi(dv.y)}, gv4 = *(const f32x4*)(g2 + 4 * k);
                  *(f32x4*)(yr + 4 * k) = xv4 + gv4 * (f32x4){acc[2 * k].x, acc[2 * k].y, acc[2 * k + 1].x, acc[2 * k + 1].y}; } }
            asm volatile("s_waitcnt vmcnt(0)" ::: "memory");
            buf ^= 1;
        }
    }
}


#ifndef SELF_CHECK
#define SELF_CHECK 0
#endif
#if SELF_CHECK
__device__ __forceinline__ void chk_fail(const Frame& F, size_t off) { F.out[off] = __uint_as_float(0x7fc00000u); }
__device__ __forceinline__ void self_check_mask(const Frame& F) {
    if (F.bid >= 18 || F.wave != 0) return;
    const int bs[3] = {0, 13, 31}; const int ts[6] = {255, 256, 300, 777, 1500, 2047};
    const int b = bs[F.bid / 6], t = ts[F.bid % 6], n = t + 1;
    const float* sc = WSP(float, WS_SCR) + ((size_t)b * 2048 + t) * 2048; const u64* mk = WSP(u64, WS_MASK) + ((size_t)b * 2048 + t) * 32;
    int bad = 0;
    for (int s = F.lane; s < 2048; s += 64) {
        bool sel = false;
        if (s < n) { const float v = sc[s]; int cnt = 0; for (int s2 = 0; s2 < n; ++s2) { const float v2 = sc[s2]; cnt += (v2 > v || (v2 == v && s2 < s)) ? 1 : 0; } sel = cnt < 256; }
        const bool got = (mk[s >> 6] >> (s & 63)) & 1ull;
        bad += (sel != got) ? 1 : 0;
    }
    if (__ballot(bad != 0) != 0ull && F.lane == 0) chk_fail(F, OFF_KP);
}
__device__ __forceinline__ void self_check_attn(const Frame& F) {
    if (F.bid >= 18) return;
    const int bs[3] = {0, 13, 31}; const int ts[6] = {0, 255, 256, 300, 1500, 2047};
    const int b = bs[F.bid / 6], t = ts[F.bid % 6], head = F.wave, kvh = head >> 2;
    const bf16_t* Q = WSP(bf16_t, WS_Q); const bf16_t* K = WSP(bf16_t, WS_K); const bf16_t* V = WSP(bf16_t, WS_V); const bf16_t* ATT = WSP(bf16_t, WS_ATT);
    const u64* mk = WSP(u64, WS_MASK) + ((size_t)b * 2048 + t) * 32;
    const size_t rq = (size_t)b * 2048 + t;
    float mx = -INFINITY;
    for (int s = F.lane; s <= t; s += 64) if ((mk[s >> 6] >> (s & 63)) & 1ull) { float d = 0.f; for (int e = 0; e < 64; ++e) d += bf2f(Q[rq * 512 + head * 64 + e]) * bf2f(K[((size_t)b * 2048 + s) * 128 + kvh * 64 + e]); mx = fmaxf(mx, d * 0.125f); }
    mx = wave_max(mx);
    float o[64]; float l = 0.f;
#pragma unroll
    for (int e = 0; e < 64; ++e) o[e] = 0.f;
    for (int s = F.lane; s <= t; s += 64) if ((mk[s >> 6] >> (s & 63)) & 1ull) { float d = 0.f; for (int e = 0; e < 64; ++e) d += bf2f(Q[rq * 512 + head * 64 + e]) * bf2f(K[((size_t)b * 2048 + s) * 128 + kvh * 64 + e]);
        const float p = __expf(d * 0.125f - mx); l += p;
#pragma unroll
        for (int e = 0; e < 64; ++e) o[e] += p * bf2f(V[((size_t)b * 2048 + s) * 128 + kvh * 64 + e]); }
    l = wave_sum(l); float err = 0.f, mag = 0.f;
#pragma unroll
    for (int e = 0; e < 64; ++e) { const float r = wave_sum(o[e]) / l; const float gts = bf2f(ATT[rq * 512 + head * 64 + e]); err = fmaxf(err, fabsf(r - gts)); mag = fmaxf(mag, fabsf(r)); }
    if (!(err <= 0.03f * mag + 2e-3f) && F.lane == 0) chk_fail(F, OFF_VP);
}
__device__ __forceinline__ void self_check_peer(const Frame& F) {
    if (F.bid >= 6) return;
    const int tsamp[6] = {0, 1000, 40000, 65535, 65536, 66047};
    const int t = tsamp[F.bid], tid = F.tid;
    const bf16_t* Q2 = WSP(bf16_t, WS_Q2); const bf16_t* H2 = WSP(bf16_t, WS_H); const int* EIDX = WSP(int, WS_EIDX); const float* G = WSP(float, WS_G);
    const bf16_t* Dm = WSP(bf16_t, WS_X1); const float* MOD = WSP(float, WS_MOD);
    LAS float* S = (LAS float*)F.lds;
    LAS int* REF = (LAS int*)(F.lds + 8192);
    LAS float* CO = (LAS float*)(F.lds + 8192 + 512);
    LAS int* CNTW = (LAS int*)(F.lds + 8192 + 1024);
    for (int i = tid; i < 2048; i += 512) { const int hp = i >> 7, key = i & 127, h = hp >> 1, p = hp & 1; float d = 0.f;
        for (int e = 0; e < 128; ++e) d += bf2f(Q2[(size_t)t * 2048 + h * 256 + p * 128 + e]) * F.peer_sub_keys[(((size_t)p * 8 + h) * 128 + key) * 128 + e];
        S[i] = d; }
    if (tid == 0) *CNTW = 0;
    __syncthreads();
    if (tid < 8) { const int h = tid; int i1[16], i2[16]; float s1[16], s2[16];
        for (int p = 0; p < 2; ++p) { const LAS float* sp = S + (h * 2 + p) * 128; int n = 0;
            for (int k = 0; k < 128; ++k) { int rank = 0; for (int k2 = 0; k2 < 128; ++k2) rank += (sp[k2] > sp[k] || (sp[k2] == sp[k] && k2 < k)) ? 1 : 0;
                if (rank < 16) { if (p == 0) { i1[rank] = k; s1[rank] = sp[k]; } else { i2[rank] = k; s2[rank] = sp[k]; } ++n; } } }
        for (int a = 0; a < 16; ++a) for (int c = 0; c < 16; ++c) { const float v = s1[a] + s2[c]; int rank = 0;
            for (int a2 = 0; a2 < 16; ++a2) for (int c2 = 0; c2 < 16; ++c2) { const float v2 = s1[a2] + s2[c2]; rank += (v2 > v || (v2 == v && (a2 * 16 + c2) < (a * 16 + c))) ? 1 : 0; }
            if (rank < 16) REF[h * 16 + rank] = i1[a] * 128 + i2[c]; } }
    __syncthreads();
    if (tid < 128) { const int h = tid >> 4; const int e = EIDX[(size_t)t * 128 + tid]; bool found = false; for (int k = 0; k < 16; ++k) found |= (REF[h * 16 + k] == e); if (!found) atomicAdd((int*)CNTW, 1); }
    __syncthreads();
    if (tid == 0 && *CNTW > 12) chk_fail(F, OFF_KIP);
    { const int slot = tid >> 2, part = tid & 3; const int e = EIDX[(size_t)t * 128 + slot]; float d = 0.f;
      for (int c = part * 256; c < part * 256 + 256; ++c) d += F.peer_u[(size_t)e * 1024 + c] * bf2f(H2[(size_t)t * 1024 + c]);
      d += __shfl_xor(d, 1); d += __shfl_xor(d, 2);
      if (part == 0) CO[slot] = G[(size_t)t * 128 + slot] * gelu_tanh(d); }
    __syncthreads();
    float err = 0.f, mag = 0.f;
    for (int c = tid; c < 1024; c += 512) { float o = 0.f; for (int slot = 0; slot < 128; ++slot) o += CO[slot] * F.peer_v[(size_t)EIDX[(size_t)t * 128 + slot] * 1024 + c];
        const float g2 = MOD[(size_t)mod_row(t) * NMOD + 5 * 1024 + c]; const float ref = g2 * o, got = F.out[(size_t)t * 1024 + c] - ((t < TP ? F.x_prompt[(size_t)t * 1024 + c] : F.x_sample[(size_t)(t - TP) * 1024 + c]) + bf2f(Dm[(size_t)t * 1024 + c]));
        err = fmaxf(err, fabsf(ref - got)); mag = fmaxf(mag, fabsf(ref)); }
    err = wave_max(err); mag = wave_max(mag);
    LAS float* RED = (LAS float*)(F.lds + 8192 + 2048);
    if (F.lane == 0) { RED[F.wave] = err; RED[8 + F.wave] = mag; }
    __syncthreads();
    if (tid == 0) { float e2 = 0.f, m2 = 0.f; for (int w = 0; w < 8; ++w) { e2 = fmaxf(e2, RED[w]); m2 = fmaxf(m2, RED[8 + w]); } if (!(e2 <= 0.12f * m2 + 1e-4f)) chk_fail(F, OFF_CONVP); }
}
#endif

constexpr int N_PHASES = 15;
__global__ void __launch_bounds__(512, 2) fwd_kernel(Params P) {
    extern __shared__ __attribute__((aligned(16))) unsigned char lds_raw[];
    Frame F;
    F.lds = (LAS unsigned char*)lds_raw; F.tid = threadIdx.x; F.lane = F.tid & 63; F.wave = __builtin_amdgcn_readfirstlane(F.tid >> 6); F.bid = blockIdx.x; F.nblk = gridDim.x;
    F.ws = P.ws; F.ctl = (unsigned*)(P.ws + WS_CTL); F.out = P.out;
    F.x_prompt = P.in[0]; F.x_sample = P.in[1]; F.cache_k = P.in[2]; F.cache_v = P.in[3]; F.cache_kidx = P.in[4]; F.state_conv = P.in[5]; F.page_table = (const int*)P.in[6];
    F.c_prompt = P.in[7]; F.c_sample = P.in[8]; F.w_ada = P.in[9]; F.b_ada = P.in[10]; F.norm1_w = P.in[11]; F.w_in = P.in[12]; F.conv_w = P.in[13]; F.q_norm_w = P.in[14]; F.k_norm_w = P.in[15];
    F.w_conv_out = P.in[16]; F.w_attn_out = P.in[17]; F.w_out = P.in[18]; F.norm2_w = P.in[19]; F.peer_w_q = P.in[20]; F.peer_sub_keys = P.in[21]; F.peer_u = P.in[22]; F.peer_v = P.in[23];
    if (F.tid < 16) ((LAS unsigned*)(F.lds + LDS_MISC))[F.tid] = 0u;
    __syncthreads();
    const int lo = P.ph_lo, hi = P.ph_hi;
    const bool one = (hi - lo) > 1;
    XcdBarrier bar; bar.bar = F.ctl + CW_BAR; bar.x = 0; bar.st = nullptr;
    if (one) bar = xcd_barrier_post(F.ctl + CW_BAR, (volatile LAS unsigned*)(F.lds + LDS_MISC));
#define IN(k) (lo <= (k) && (k) < hi)
#define SEAM(k) do { if (IN(k) && IN((k) + 1)) xcd_barrier(bar); } while (0)

#define PHASE(k, ...) do { if (IN(k)) { const int rep = 0; __VA_ARGS__; } SEAM(k); } while (0)

    PHASE(0, p0_convert(F));
    PHASE(1, {
        float* MODw = WSP(float, WS_MOD); const float* bias = F.b_ada;
        skinny_phase<false>(F, WSP(bf16_t, WS_CB), WSP(bf16_t, WS_WADA), nullptr, nullptr, 1024, 1024, NMOD, 0, 3, [=](int r, int c, const float (&s01)[4], const float (&s23)[4]) {
            const f32x4 bv = *(const f32x4*)(bias + c);
            *(f32x4*)(MODw + (size_t)r * NMOD + c) = (f32x4){s01[0] + s23[0] + bv[0], s01[1] + s23[1] + bv[1], s01[2] + s23[2] + bv[2], s01[3] + s23[3] + bv[3]}; }); });
    PHASE(2, row_norm_pass<false>(F));
    PHASE(3, {
        pg8::Gemm g{WSP(bf16_t, WS_H), WSP(bf16_t, WS_WIN), T, NPROJ_PAD, 1024, 1024, 1024, 0}; pg8::StaticOrder S; S.init(T, NPROJ_PAD, F.nblk, F.bid);
        EpiInProj E{WSP(bf16_t, WS_U), WSP(bf16_t, WS_BG), WSP(bf16_t, WS_Q), WSP(bf16_t, WS_K), WSP(bf16_t, WS_V), WSP(bf16_t, WS_QI), WSP(bf16_t, WS_KI), WSP(bf16_t, WS_SGA), WSP(bf16_t, WS_SGB),
                    WSP(float, WS_WI), F.q_norm_w, F.k_norm_w, WSP(f32x2, WS_ROPE), F.out};
        pg8::gemm_phase(F.lds, g, S, E);
        { const int tail = S.nwg % F.nblk;
          if (tail == 0) p0_peer_tables(F, F.bid, F.nblk); else if (F.bid >= tail) p0_peer_tables(F, F.bid - tail, F.nblk - tail); } });
    PHASE(4, p4_all(F, rep, P.pad));
#if SELF_CHECK
#define SC_MASK() self_check_mask(F)
#define SC_ATTN() self_check_attn(F)
#else
#define SC_MASK() do {} while (0)
#define SC_ATTN() do {} while (0)
#endif
    PHASE(5, { SC_MASK(); p5_all(F, rep); });
    PHASE(6, { SC_ATTN();
        { pg8::Gemm g{WSP(bf16_t, WS_APRE), WSP(bf16_t, WS_WCO), TP, 1024, 1024, 512, 512, 0, WSP(bf16_t, WS_ATT), WSP(bf16_t, WS_WAO)}; pg8::StaticOrder S; S.init(TP, 1024, F.nblk, F.bid);
          EpiMixFused E{WSP(bf16_t, WS_SGA), WSP(bf16_t, WS_SGB), WSP(bf16_t, WS_MIX)}; pg8::gemm_phase<EpiMixFused, pg8::StaticOrder, true, true, true>(F.lds, g, S, E); }
        { const bf16_t* SGA = WSP(bf16_t, WS_SGA); const bf16_t* SGB = WSP(bf16_t, WS_SGB); bf16_t* MIX = WSP(bf16_t, WS_MIX);
          skinny_phase<true>(F, WSP(bf16_t, WS_APRE), WSP(bf16_t, WS_WCO), WSP(bf16_t, WS_ATT), WSP(bf16_t, WS_WAO), 512, 512, 1024, TP, 8, [=](int r, int c, const float (&s01)[4], const float (&s23)[4]) {
              const size_t o = (size_t)r * 1024 + c; const u32x2 ga = *(const u32x2*)(SGA + o), gb = *(const u32x2*)(SGB + o);
              u32x2 m; m.x = cvt_pk_bf16(bf_lo(ga.x) * s01[0] + bf_lo(gb.x) * s23[0], bf_hi(ga.x) * s01[1] + bf_hi(gb.x) * s23[1]);
              m.y = cvt_pk_bf16(bf_lo(ga.y) * s01[2] + bf_lo(gb.y) * s23[2], bf_hi(ga.y) * s01[3] + bf_hi(gb.y) * s23[3]); *(u32x2*)(MIX + o) = m; }); } });
    PHASE(7, {
        pg8::Gemm g{WSP(bf16_t, WS_MIX), WSP(bf16_t, WS_WOUT), TP, 1024, 1024, 1024, 1024, 0}; pg8::StaticOrder S; S.init(TP, 1024, F.nblk, F.bid);
        EpiOut E{WSP(float, WS_MOD), WSP(bf16_t, WS_X1)}; pg8::gemm_phase(F.lds, g, S, E);
        { const float* MOD = WSP(float, WS_MOD); bf16_t* Dm = WSP(bf16_t, WS_X1);
          skinny_phase<false>(F, WSP(bf16_t, WS_MIX), WSP(bf16_t, WS_WOUT), nullptr, nullptr, 1024, 1024, 1024, TP, 8, [=](int r, int c, const float (&s01)[4], const float (&s23)[4]) {
              const f32x4 g1 = *(const f32x4*)(MOD + (size_t)mod_row(r) * NMOD + 2048 + c);
              u32x2 d; d.x = cvt_pk_bf16(g1[0] * (s01[0] + s23[0]), g1[1] * (s01[1] + s23[1])); d.y = cvt_pk_bf16(g1[2] * (s01[2] + s23[2]), g1[3] * (s01[3] + s23[3]));
              *(u32x2*)(Dm + (size_t)r * 1024 + c) = d; }); } });
    PHASE(8, row_norm_pass<true>(F));
    PHASE(9, {
        pg8::Gemm g{WSP(bf16_t, WS_H), WSP(bf16_t, WS_WQ), TP, 2048, 1024, 1024, 1024, 0}; pg8::StaticOrder S; S.init(TP, 2048, F.nblk, F.bid);
        EpiBf16Plain E{WSP(bf16_t, WS_Q2), 2048}; pg8::gemm_phase(F.lds, g, S, E);
        { bf16_t* Q2 = WSP(bf16_t, WS_Q2);
          skinny_phase<false>(F, WSP(bf16_t, WS_H), WSP(bf16_t, WS_WQ), nullptr, nullptr, 1024, 1024, 2048, TP, 8, [=](int r, int c, const float (&s01)[4], const float (&s23)[4]) {
              u32x2 d; d.x = cvt_pk_bf16(s01[0] + s23[0], s01[1] + s23[1]); d.y = cvt_pk_bf16(s01[2] + s23[2], s01[3] + s23[3]); *(u32x2*)(Q2 + (size_t)r * 2048 + c) = d; }); } });
    PHASE(10, {
        pg8::Gemm g{WSP(bf16_t, WS_Q2), WSP(bf16_t, WS_SKBD), TP, 2048, 256, 2048, 256, 256}; pg8::StaticOrder S; S.init(TP, 2048, F.nblk, F.bid);
        EpiPST E{WSP(unsigned short, WS_SCR)}; pg8::gemm_phase<EpiPST, pg8::StaticOrder, false, false>(F.lds, g, S, E);
        { unsigned short* PST = WSP(unsigned short, WS_SCR);
          auto fin = [=](int r, int c, const float (&s01)[4], const float (&s23)[4]) {
              u32x2 d; d.x = cvt_pk_f16(s01[0] + s23[0], s01[1] + s23[1]); d.y = cvt_pk_f16(s01[2] + s23[2], s01[3] + s23[3]);
              *(u32x2*)(PST + (size_t)((r >> 8) * 8 + (c >> 8)) * 65536 + (size_t)(r & 255) * 256 + (c & 255)) = d; };
          skinny_phase<false, decltype(fin), 64>(F, WSP(bf16_t, WS_Q2), WSP(bf16_t, WS_SKBD), nullptr, nullptr, 2048, 256, 2048, TP, 8, fin, 256); } });
    PHASE(11, p11_select(F));
    PHASE(12, p12a_act(F, P.pad));
    PHASE(13, p12c_coef(F));
    PHASE(14, p12b_out(F));
#if SELF_CHECK
    xcd_barrier(bar);
    self_check_peer(F);
#endif
#undef PHASE
#undef IN
#undef SEAM
}

extern "C" void kernel_launch(void* const* d_in, const int* in_sizes, int n_in, void* d_out, int out_size, void* d_ws, size_t ws_size, hipStream_t stream) {
    static int grid = 0;
    if (grid == 0) {
        if (n_in != 24 || (size_t)out_size != OUT_TOTAL || ws_size < WS_END) { fprintf(stderr, "kernel_launch: unexpected sizes n_in %d out %d ws %zu (need %zu)\n", n_in, out_size, ws_size, (size_t)WS_END); grid = -1; return; }
        int dev = 0, cus = 0, per_cu = 0;
        if (hipGetDevice(&dev) != hipSuccess || hipDeviceGetAttribute(&cus, hipDeviceAttributeMultiprocessorCount, dev) != hipSuccess) { grid = -1; return; }
        if (hipFuncSetAttribute((const void*)fwd_kernel, hipFuncAttributeMaxDynamicSharedMemorySize, LDS_BYTES) != hipSuccess) { fprintf(stderr, "kernel_launch: hipFuncSetAttribute failed\n"); grid = -1; return; }
        if (hipOccupancyMaxActiveBlocksPerMultiprocessor(&per_cu, (const void*)fwd_kernel, 512, LDS_BYTES) != hipSuccess || per_cu < 1) { fprintf(stderr, "kernel_launch: occupancy query says %d\n", per_cu); }
        (void)hipGetLastError();
        grid = cus;
    }
    if (grid < 0) return;
    (void)hipMemsetAsync((char*)d_ws + WS_CTL, 0, CTL_BYTES, stream);
    Params p{};
    for (int i = 0; i < 24; ++i) p.in[i] = (const float*)d_in[i];
    p.out = (float*)d_out; p.ws = (unsigned char*)d_ws; p.rep_mask = 0; p.pad = 15;
#if N_LAUNCH_MODE == 1
    p.ph_lo = 0; p.ph_hi = N_PHASES;
    hipLaunchKernelGGL(fwd_kernel, dim3(grid), dim3(512), LDS_BYTES, stream, p);
#else
    for (int k = 0; k < N_PHASES; ++k) { p.ph_lo = k; p.ph_hi = k + 1; hipLaunchKernelGGL(fwd_kernel, dim3(grid), dim3(512), LDS_BYTES, stream, p);
        if ((REPEAT_MASK >> k) & 1) { (void)hipMemsetAsync((char*)d_ws + WS_CTL, 0, CTL_BYTES, stream); p.pad = PROBE_PARTS; hipLaunchKernelGGL(fwd_kernel, dim3(grid), dim3(512), LDS_BYTES, stream, p); p.pad = 15; } }
#endif
}
```

```cpp
#include <hip/hip_runtime.h>
#include <cstdio>
#include <cstdint>

#ifndef N_LAUNCH_MODE
#define N_LAUNCH_MODE 1
#endif

#define REPEAT_MASK 0x0000

#define PROBE_PARTS 15
#define LAS __attribute__((address_space(3)))
typedef unsigned short bf16_t;
typedef short bf16x8 __attribute__((ext_vector_type(8)));
typedef short bf16x4 __attribute__((ext_vector_type(4)));
typedef float f32x4 __attribute__((ext_vector_type(4)));
typedef float f32x2 __attribute__((ext_vector_type(2)));
typedef float f32x16 __attribute__((ext_vector_type(16)));
typedef unsigned u32x4 __attribute__((ext_vector_type(4)));
typedef unsigned u32x2 __attribute__((ext_vector_type(2)));
typedef unsigned long long u64;

constexpr int D = 1024, TP = 65536, TS = 512, T = TP + TS, SEQ = 2048, NB = 32, DB = 128, DS = 4;
constexpr int PAST = 8192, PAGE = 128, NPG = 64;
constexpr int NPROJ = 4936, NPROJ_PAD = 5120;
constexpr int NMOD = 6144;
constexpr float NORM_EPS = 1e-6f;
constexpr float IDX_SCALE = 0.125f * 0.35355339059327373f;
constexpr size_t OFF_Y = 0;
constexpr size_t OFF_KP = (size_t)T * D;
constexpr size_t OFF_VP = OFF_KP + (size_t)TP * 128;
constexpr size_t OFF_KIP = OFF_VP + (size_t)TP * 128;
constexpr size_t OFF_CONVP = OFF_KIP + (size_t)TP * 64;
constexpr size_t OFF_KS = OFF_CONVP + (size_t)NB * 2 * 512;
constexpr size_t OFF_VS = OFF_KS + (size_t)TS * 128;
constexpr size_t OFF_KIS = OFF_VS + (size_t)TS * 128;
constexpr size_t OFF_CONVS = OFF_KIS + (size_t)TS * 64;
constexpr size_t OUT_TOTAL = OFF_CONVS + (size_t)DB * 2 * 512;
static_assert(OUT_TOTAL == 88932352, "out size");

constexpr size_t al256(size_t x) { return (x + 255) & ~(size_t)255; }
constexpr size_t WS_CTL = 0;
constexpr size_t CTL_BYTES = 65536;
constexpr size_t WS_WIN = WS_CTL + CTL_BYTES;
constexpr size_t WS_WCO = WS_WIN + (size_t)NPROJ_PAD * 1024 * 2;
constexpr size_t WS_WAO = WS_WCO + (size_t)1024 * 512 * 2;
constexpr size_t WS_WOUT = WS_WAO + (size_t)1024 * 512 * 2;
constexpr size_t WS_WQ = WS_WOUT + (size_t)1024 * 1024 * 2;
constexpr size_t WS_SKBD = WS_WQ + (size_t)2048 * 1024 * 2;
constexpr size_t WS_UT = WS_SKBD + (size_t)2048 * 256 * 2;
constexpr size_t WS_VT2 = WS_UT + (size_t)16384 * 1024;
constexpr size_t WS_TSC = WS_VT2 + (size_t)16384 * 1024;
constexpr size_t WS_WADA = WS_TSC + (size_t)2 * 16384 * 4;
constexpr size_t WS_CB = WS_WADA + (size_t)NMOD * 1024 * 2;
constexpr size_t WS_MOD = WS_CB + (size_t)256 * 1024 * 2;
constexpr size_t WS_ROPE = WS_MOD + (size_t)256 * NMOD * 4;
constexpr size_t WS_H = al256(WS_ROPE + (size_t)2052 * 32 * 8);
constexpr size_t WS_U = WS_H + (size_t)T * 1024 * 2;
constexpr size_t WS_BG = WS_U + (size_t)T * 512 * 2;
constexpr size_t WS_Q = WS_BG + (size_t)T * 512 * 2;
constexpr size_t WS_K = WS_Q + (size_t)T * 512 * 2;
constexpr size_t WS_V = WS_K + (size_t)T * 128 * 2;
constexpr size_t WS_VTR = WS_V + (size_t)T * 128 * 2;
constexpr size_t WS_QI = WS_VTR + (size_t)TP * 128 * 2;
constexpr size_t WS_KI = WS_QI + (size_t)T * 512 * 2;
constexpr size_t WS_WI = WS_KI + (size_t)T * 64 * 2;
constexpr size_t WS_SGA = WS_WI + (size_t)T * 8 * 4;
constexpr size_t WS_SGB = WS_SGA + (size_t)T * 1024 * 2;
constexpr size_t WS_MASK = WS_SGB + (size_t)T * 1024 * 2;
constexpr size_t WS_APRE = WS_MASK + (size_t)TP * 32 * 8;
constexpr size_t WS_ATT = WS_APRE + (size_t)T * 512 * 2;
constexpr size_t WS_MIX = WS_ATT + (size_t)T * 512 * 2;
constexpr size_t WS_Q2 = WS_MIX + (size_t)T * 1024 * 2;
constexpr size_t WS_EIDX = WS_Q2 + (size_t)T * 2048 * 2;
constexpr size_t WS_G = WS_EIDX + (size_t)T * 128 * 4;
constexpr size_t WS_SCR = WS_G + (size_t)T * 128 * 4;
constexpr size_t SCR_BYTES = (size_t)T * 2048 * 4;
constexpr size_t WS_X1 = WS_SCR + SCR_BYTES;
constexpr size_t WS_ACT = WS_X1 + (size_t)T * 1024 * 4;
constexpr size_t WS_LISTG = WS_ACT + (size_t)T * 128 * 4;
constexpr size_t WS_METAG = WS_LISTG + (size_t)256 * 8192 * 4;
constexpr size_t WS_END = WS_METAG + (size_t)T * 128 * 8;

constexpr int CW_BAR = 0;
constexpr int CW_Q4 = 4096;
constexpr int CW_Q5 = 8192;

constexpr int LDS_BYTES = 155648;
constexpr int LDS_MISC = 155648 - 64;

#define XB_TMO      128
#define XB_XCNT(j)  (256  + 64 * (j))
#define XB_XSUB(j)  (1280 + 64 * (j))
#define XB_XGEN(j)  (2304 + 64 * (j))
#define XB_TOP      3328
#define XB_TOPGEN   3392
#define XCD_BAR_WORDS 3456
#define XB_SPIN_CAP (1u << 18)

__device__ __forceinline__ unsigned xb_ld(unsigned* p)              { return __hip_atomic_load(p, __ATOMIC_RELAXED, __HIP_MEMORY_SCOPE_AGENT); }
__device__ __forceinline__ unsigned xb_add(unsigned* p, unsigned v) { return __hip_atomic_fetch_add(p, v, __ATOMIC_RELAXED, __HIP_MEMORY_SCOPE_AGENT); }
__device__ __forceinline__ unsigned xb_xcc_id() { return (unsigned)__builtin_amdgcn_s_getreg((3 << 11) | 20) & 0xFu; }
#define XB_SPIN(cond, bar) do { unsigned _sp = 0; while (cond) { __builtin_amdgcn_s_sleep(1); \
    if ((++_sp & 255u) == 0u) { if (xb_ld(&(bar)[XB_TMO])) break; if (_sp > XB_SPIN_CAP) { atomicAdd(&(bar)[XB_TMO], 1u); break; } } } } while (0)

struct XcdBarrier { unsigned* bar; unsigned x; volatile LAS unsigned* st; };

__device__ __forceinline__ XcdBarrier xcd_barrier_post(unsigned* bar, volatile LAS unsigned* st) {
    XcdBarrier b; b.bar = bar; b.x = xb_xcc_id(); b.st = st;
    if (threadIdx.x == 0) (void)xb_add(&bar[XB_XCNT(b.x)], 1u);
    return b;
}
__device__ __forceinline__ void xcd_barrier_complete(unsigned* bar, unsigned x, unsigned& nloc, unsigned& nx) {
    const unsigned G = gridDim.x * gridDim.y * gridDim.z;
    unsigned sum, cnt, mine, sp = 0u;
    for (;;) {
        sum = 0u; cnt = 0u; mine = 0u;
#pragma unroll
        for (unsigned j = 0; j < 16; ++j) { const unsigned c = xb_ld(&bar[XB_XCNT(j)]); sum += c; cnt += (c > 0u) ? 1u : 0u; mine = (j == x) ? c : mine; }
        if (sum == G) break;
        __builtin_amdgcn_s_sleep(1);
        if ((++sp & 255u) == 0u) { if (xb_ld(&bar[XB_TMO])) break; if (sp > XB_SPIN_CAP) { atomicAdd(&bar[XB_TMO], 1u); break; } }
    }
    nloc = mine > 0u ? mine : 1u; nx = cnt > 0u ? cnt : 1u;
}
__device__ __forceinline__ void xcd_barrier(const XcdBarrier& b) {
    asm volatile("s_waitcnt vmcnt(0)" ::: "memory");
    __syncthreads();
    if (threadIdx.x == 0) {
        unsigned* bar = b.bar;
        __builtin_amdgcn_s_waitcnt(0);
        unsigned nloc = b.st[0], nx = b.st[1];
        if (nloc == 0u) { xcd_barrier_complete(bar, b.x, nloc, nx); b.st[0] = nloc; b.st[1] = nx; }
        const unsigned old = xb_add(&bar[XB_XSUB(b.x)], 1u);
        const unsigned gen = old / nloc;
        if (old + 1u == (gen + 1u) * nloc) {
            __builtin_amdgcn_fence(__ATOMIC_RELEASE, "agent");
            asm volatile("s_waitcnt vmcnt(0)" ::: "memory");
            const unsigned og = xb_add(&bar[XB_TOP], 1u);
            const unsigned tg = og / nx;
            if (og + 1u == (tg + 1u) * nx) xb_add(&bar[XB_TOPGEN], 1u);
            else XB_SPIN(xb_ld(&bar[XB_TOPGEN]) == tg, bar);
            __builtin_amdgcn_fence(__ATOMIC_ACQUIRE, "agent");
            xb_add(&bar[XB_XGEN(b.x)], 1u);
            asm volatile("s_waitcnt vmcnt(0)" ::: "memory");
        } else {
            XB_SPIN(xb_ld(&bar[XB_XGEN(b.x)]) == gen, bar);
            __builtin_amdgcn_fence(__ATOMIC_ACQUIRE, "agent");
            asm volatile("s_waitcnt vmcnt(0)" ::: "memory");
        }
    }
    __syncthreads();
}

typedef __bf16 cvtbf2_t __attribute__((ext_vector_type(2)));
__device__ __forceinline__ unsigned cvt_pk_bf16(float lo, float hi) { const cvtbf2_t v = __builtin_convertvector((f32x2){lo, hi}, cvtbf2_t); return __builtin_bit_cast(unsigned, v); }
__device__ __forceinline__ float bf_lo(unsigned u) { return __uint_as_float(u << 16); }
__device__ __forceinline__ float bf_hi(unsigned u) { return __uint_as_float(u & 0xffff0000u); }
__device__ __forceinline__ float bf2f(bf16_t b) { return __uint_as_float(((unsigned)b) << 16); }
__device__ __forceinline__ u32x4 pack8(const float (&v)[8]) { u32x4 w; w.x = cvt_pk_bf16(v[0], v[1]); w.y = cvt_pk_bf16(v[2], v[3]); w.z = cvt_pk_bf16(v[4], v[5]); w.w = cvt_pk_bf16(v[6], v[7]); return w; }
__device__ __forceinline__ void unpack8(const u32x4 w, float (&v)[8]) { v[0] = bf_lo(w.x); v[1] = bf_hi(w.x); v[2] = bf_lo(w.y); v[3] = bf_hi(w.y); v[4] = bf_lo(w.z); v[5] = bf_hi(w.z); v[6] = bf_lo(w.w); v[7] = bf_hi(w.w); }
__device__ __forceinline__ unsigned mono(float v) { const unsigned u = __float_as_uint(v); return (u & 0x80000000u) ? ~u : (u | 0x80000000u); }
__device__ __forceinline__ float unmono(unsigned k) { const unsigned u = (k & 0x80000000u) ? (k & 0x7fffffffu) : ~k; return __uint_as_float(u); }
__device__ __forceinline__ float sigmoidf_(float x) { return __builtin_amdgcn_rcpf(1.0f + __expf(-x)); }
__device__ __forceinline__ float gelu_tanh(float x) { const float u = 0.7978845608028654f * (x + 0.044715f * x * x * x); const float e = __expf(2.0f * u); const float th = 1.0f - 2.0f * __builtin_amdgcn_rcpf(e + 1.0f); return 0.5f * x * (1.0f + th); }
__device__ __forceinline__ int mbcnt64(u64 m) { return (int)__builtin_amdgcn_mbcnt_hi((unsigned)(m >> 32), __builtin_amdgcn_mbcnt_lo((unsigned)m, 0u)); }
__device__ __forceinline__ float wave_sum(float v) {
#pragma unroll
    for (int o = 32; o > 0; o >>= 1) v += __shfl_xor(v, o);
    return v;
}
__device__ __forceinline__ float wave_max(float v) {
#pragma unroll
    for (int o = 32; o > 0; o >>= 1) v = fmaxf(v, __shfl_xor(v, o));
    return v;
}

namespace pg8 {
constexpr int BM = 256, BK = 64, HALF = 128, HTB = HALF * BK * 2, STAGE_BYTES = 8 * HTB, NXCD = 8, WGM = 8;
__host__ __device__ __forceinline__ int lds_byte(int r, int c) { const int st = (r >> 4) * 2 + (c >> 5), rr = r & 15, cc = c & 31, ob = rr * 64 + cc * 2; return st * 1024 + (ob ^ (((ob >> 9) & 1) << 5)); }
__host__ __device__ __forceinline__ void stage_rc(int b, int& R, int& C) { const int st = b / 1024, sb = b % 1024, swz = sb ^ (((sb >> 9) & 1) << 5); R = (st >> 1) * 16 + swz / 64; C = (st & 1) * 32 + (swz % 64) / 2; }
__host__ __device__ __forceinline__ int perm32(int rho) { const int n = rho >> 4, i = rho & 15; return 8 * (i >> 2) + 4 * n + (i & 3); }

struct Unit { int pm, pn; };
struct Gemm { const bf16_t* A; const bf16_t* Bt; int M, N, K, lda, ldb, a_pn_cols; const bf16_t* A2 = nullptr; const bf16_t* Bt2 = nullptr; };

struct StaticOrder {
    int nM, nN, nwg, G, c;
    __host__ __device__ void init(int M, int N, int G_, int c_) { nM = M / BM; nN = N / BM; nwg = nM * nN; G = G_; c = c_; }
    __host__ __device__ bool next(int i, Unit& u) const {
        const long L = (long)i * G + c; if (L >= nwg) return false;
        int wgid = (int)L; { const int q = nwg / NXCD, r = nwg % NXCD, xcd = wgid % NXCD, off = wgid / NXCD; wgid = (xcd < r ? xcd * (q + 1) : r * (q + 1) + (xcd - r) * q) + off; }
        const int nig = WGM * nN, gid = wgid / nig, fm = gid * WGM, gsz = (nM - fm) < WGM ? (nM - fm) : WGM;
        u.pm = fm + ((wgid % nig) % gsz); u.pn = (wgid % nig) / gsz; return true;
    }
    __device__ __forceinline__ void a_ready(const Unit&) const {}
    __device__ __forceinline__ void done(const Unit&) const {}
};

template <class Epi, class Sched, bool ALIGN_EPI = true, bool SP2 = true, bool DUAL = false>
__device__ __forceinline__ void gemm_phase(LAS unsigned char* lds, const Gemm g, const Sched& S, const Epi& E) {
    const int tid = threadIdx.x, wid = __builtin_amdgcn_readfirstlane(tid >> 6), lane = tid & 63, wr = wid >> 2, wc = wid & 3, fr = lane & 15, fq = lane >> 4;
    const int K = g.K, nt = K / BK;
    unsigned voffA[2], voffB[2];
#pragma unroll
    for (int i = 0; i < 2; ++i) { int R, C; stage_rc(tid * 16 + i * 8192, R, C); const int Rb = Epi::PERM ? ((R & ~31) + perm32(R & 31)) : R;
        voffA[i] = (unsigned)(R * g.lda + C) * 2u; voffB[i] = (unsigned)(Rb * g.ldb + C) * 2u; }
    const size_t kstep = (size_t)(BK * 2);
    const int nh = nt / 2;
    const long dA = DUAL ? ((const char*)g.A2 - (const char*)g.A) - (long)nh * (long)kstep : 0, dB = DUAL ? ((const char*)g.Bt2 - (const char*)g.Bt) - (long)nh * (long)kstep : 0;
    const size_t hstepA = (size_t)HALF * g.lda * 2, hstepB = (size_t)HALF * g.ldb * 2;
    const size_t tstepA = 2 * hstepA, tstepB = 2 * hstepB;
    const size_t pnstepA = (size_t)g.a_pn_cols * 2;
    const unsigned ldsw = (unsigned)wid * 1024u;
    const int aoff = lds_byte(wr * 64 + fr, fq * 8), boff = lds_byte(wc * 32 + fr, fq * 8);
#define PG8_SA(b, h) (((b) * 2 + (h)) * HTB)
#define PG8_SB(b, h) ((4 + (b) * 2 + (h)) * HTB)
#define PG8_STAGE(bufoff, gbase, voff) do { _Pragma("unroll") for (int _i = 0; _i < 2; ++_i) \
        __builtin_amdgcn_global_load_lds((const unsigned*)((const char*)(gbase) + (voff)[_i]), (LAS unsigned*)(lds + (bufoff) + ldsw + _i * 8192), 16, 0, 0); } while (0)
#define PG8_LDA(dst, b, h) do { _Pragma("unroll") for (int m = 0; m < 4; ++m) _Pragma("unroll") for (int k = 0; k < 2; ++k) dst[m][k] = *(const LAS bf16x8*)(lds + PG8_SA(b, h) + aoff + m * 2048 + k * 1024); } while (0)
#define PG8_LDB(dst, b, h) do { _Pragma("unroll") for (int n = 0; n < 2; ++n) _Pragma("unroll") for (int k = 0; k < 2; ++k) dst[n][k] = *(const LAS bf16x8*)(lds + PG8_SB(b, h) + boff + n * 2048 + k * 1024); } while (0)
#define PG8_MMA(ai, bj, At, Bt) do { __builtin_amdgcn_s_setprio(1); _Pragma("unroll") for (int m = 0; m < 4; ++m) _Pragma("unroll") for (int n = 0; n < 2; ++n) _Pragma("unroll") for (int k = 0; k < 2; ++k) \
        acc[ai][bj][m][n] = __builtin_amdgcn_mfma_f32_16x16x32_bf16(Bt[n][k], At[m][k], acc[ai][bj][m][n], 0, 0, 0); __builtin_amdgcn_s_setprio(0); } while (0)
#define PG8_WAIT_V(n) asm volatile("s_waitcnt vmcnt(" #n ")" ::: "memory")
#define PG8_WAIT_L(n) asm volatile("s_waitcnt lgkmcnt(" #n ")" ::: "memory")
#define PG8_BAR __builtin_amdgcn_s_barrier()
#define PG8_SCHED __builtin_amdgcn_sched_barrier(0)
#define PG8_UA(u_) ((const char*)g.A + (size_t)(u_).pm * tstepA + (size_t)(u_).pn * pnstepA)
#define PG8_UB(u_) ((const char*)g.Bt + (size_t)(u_).pn * tstepB)
    Unit cur, nxt; int ui = 0;
    if (!S.next(0, cur)) return;
    f32x4 acc[2][2][4][2];
#pragma unroll
    for (int a = 0; a < 2; ++a)
#pragma unroll
        for (int b = 0; b < 2; ++b)
#pragma unroll
            for (int m = 0; m < 4; ++m)
#pragma unroll
                for (int n = 0; n < 2; ++n) acc[a][b][m][n] = (f32x4){0.f, 0.f, 0.f, 0.f};
    bf16x8 At[4][2], B0[2][2], B1[2][2];
    const char* cA = PG8_UA(cur); const char* cB = PG8_UB(cur);
    S.a_ready(cur);
    if constexpr (SP2) {
        PG8_STAGE(PG8_SB(0, 0), cB, voffB); PG8_STAGE(PG8_SB(0, 1), cB + hstepB, voffB); PG8_STAGE(PG8_SA(0, 0), cA, voffA); PG8_STAGE(PG8_SA(0, 1), cA + hstepA, voffA);
        if (wr == 1) PG8_BAR;
        PG8_WAIT_V(2); PG8_BAR;
        PG8_STAGE(PG8_SB(1, 0), cB + kstep, voffB); PG8_STAGE(PG8_SA(1, 0), cA + kstep, voffA); PG8_STAGE(PG8_SB(1, 1), cB + hstepB + kstep, voffB);
        PG8_WAIT_V(6); PG8_BAR;
    } else {
        PG8_STAGE(PG8_SB(0, 0), cB, voffB); PG8_STAGE(PG8_SA(0, 0), cA, voffA); PG8_STAGE(PG8_SB(0, 1), cB + hstepB, voffB); PG8_STAGE(PG8_SA(0, 1), cA + hstepA, voffA);
        if (wr == 1) PG8_BAR;
        PG8_WAIT_V(4); PG8_BAR;
        PG8_STAGE(PG8_SB(1, 0), cB + kstep, voffB); PG8_STAGE(PG8_SA(1, 0), cA + kstep, voffA); PG8_STAGE(PG8_SB(1, 1), cB + hstepB + kstep, voffB);
        PG8_WAIT_V(6); PG8_BAR;
    }
    for (;;) {
        const bool has_next = S.next(ui + 1, nxt);
        const char* nA = has_next ? PG8_UA(nxt) : cA; const char* nB = has_next ? PG8_UB(nxt) : cB;
        for (int t = 0; t < nt; t += 2) {
            const bool last = (t == nt - 2);
            const char* a1 = cA + (size_t)(t + 1) * kstep;
            const char* a2 = last ? nA : cA + (size_t)(t + 2) * kstep; const char* b2 = last ? nB : cB + (size_t)(t + 2) * kstep;
            if constexpr (DUAL) {
                if (t >= nh) a1 += dA;
                if (!last && t + 2 >= nh) { a2 += dA; b2 += dB; }
                if (t == nh) E.mid(acc, cur, wr, wc, fr, fq);
            }
            const char* a3 = a2 + kstep; const char* b3 = b2 + kstep;
            if (last && has_next) S.a_ready(nxt);
            if constexpr (SP2) {
            PG8_LDB(B0, 0, 0); PG8_LDB(B1, 0, 1); PG8_SCHED; PG8_LDA(At, 0, 0); PG8_STAGE(PG8_SA(1, 1), a1 + hstepA, voffA);
            PG8_WAIT_V(8); PG8_WAIT_L(0); PG8_BAR; PG8_MMA(0, 0, At, B0); PG8_MMA(0, 1, At, B1); PG8_BAR; PG8_SCHED;
            PG8_LDA(At, 0, 1); PG8_STAGE(PG8_SB(0, 0), b2, voffB); PG8_STAGE(PG8_SB(0, 1), b2 + hstepB, voffB); PG8_STAGE(PG8_SA(0, 0), a2, voffA);
            PG8_WAIT_V(8); PG8_WAIT_L(0); PG8_BAR; PG8_MMA(1, 0, At, B0); PG8_MMA(1, 1, At, B1); PG8_BAR; PG8_SCHED;
            PG8_LDB(B0, 1, 0); PG8_LDB(B1, 1, 1); PG8_SCHED; PG8_LDA(At, 1, 0); PG8_STAGE(PG8_SA(0, 1), a2 + hstepA, voffA);
            PG8_WAIT_V(8); PG8_WAIT_L(0); PG8_BAR; PG8_MMA(0, 0, At, B0); PG8_MMA(0, 1, At, B1); PG8_BAR; PG8_SCHED;
            PG8_LDA(At, 1, 1); PG8_STAGE(PG8_SB(1, 0), b3, voffB); PG8_STAGE(PG8_SB(1, 1), b3 + hstepB, voffB); PG8_STAGE(PG8_SA(1, 0), a3, voffA);
            PG8_WAIT_V(8); PG8_WAIT_L(0); PG8_BAR; PG8_MMA(1, 0, At, B0); PG8_MMA(1, 1, At, B1); PG8_BAR; PG8_SCHED;
            } else {
            PG8_LDB(B0, 0, 0); PG8_SCHED; PG8_LDA(At, 0, 0); PG8_STAGE(PG8_SA(1, 1), a1 + hstepA, voffA);
            PG8_WAIT_L(8); PG8_BAR; PG8_WAIT_L(0); PG8_MMA(0, 0, At, B0); PG8_BAR; PG8_SCHED;
            PG8_LDB(B1, 0, 1); PG8_STAGE(PG8_SB(0, 0), b2, voffB);
            PG8_BAR; PG8_WAIT_L(0); PG8_MMA(0, 1, At, B1); PG8_BAR;
            PG8_LDA(At, 0, 1); PG8_STAGE(PG8_SA(0, 0), a2, voffA);
            PG8_BAR; PG8_WAIT_L(0); PG8_MMA(1, 0, At, B0); PG8_BAR; PG8_SCHED;
            PG8_STAGE(PG8_SB(0, 1), b2 + hstepB, voffB);
            PG8_WAIT_V(6); PG8_BAR; PG8_MMA(1, 1, At, B1); PG8_BAR;
            PG8_LDB(B0, 1, 0); PG8_SCHED; PG8_LDA(At, 1, 0); PG8_STAGE(PG8_SA(0, 1), a2 + hstepA, voffA);
            PG8_WAIT_L(8); PG8_BAR; PG8_WAIT_L(0); PG8_MMA(0, 0, At, B0); PG8_BAR; PG8_SCHED;
            PG8_LDB(B1, 1, 1); PG8_STAGE(PG8_SB(1, 0), b3, voffB);
            PG8_BAR; PG8_WAIT_L(0); PG8_MMA(0, 1, At, B1); PG8_BAR;
            PG8_LDA(At, 1, 1); PG8_STAGE(PG8_SA(1, 0), a3, voffA);
            PG8_BAR; PG8_WAIT_L(0); PG8_MMA(1, 0, At, B0); PG8_BAR; PG8_SCHED;
            PG8_STAGE(PG8_SB(1, 1), b3 + hstepB, voffB);
            PG8_WAIT_V(6); PG8_BAR; PG8_MMA(1, 1, At, B1); PG8_BAR;
            }
        }
        if constexpr (ALIGN_EPI) { if (wr == 0) PG8_BAR; }
        E(acc, cur, wr, wc, fr, fq); S.done(cur);
        if (!has_next) break;
#pragma unroll
        for (int a = 0; a < 2; ++a)
#pragma unroll
            for (int b = 0; b < 2; ++b)
#pragma unroll
                for (int m = 0; m < 4; ++m)
#pragma unroll
                    for (int n = 0; n < 2; ++n) acc[a][b][m][n] = (f32x4){0.f, 0.f, 0.f, 0.f};
        cur = nxt; cA = nA; cB = nB; ++ui;
        if constexpr (ALIGN_EPI) { if (wr == 1) PG8_BAR; }
    }
    PG8_WAIT_V(0);
    if constexpr (!ALIGN_EPI) { if (wr == 0) PG8_BAR; }
    PG8_BAR;
#undef PG8_UA
#undef PG8_UB
#undef PG8_SA
#undef PG8_SB
#undef PG8_STAGE
#undef PG8_LDA
#undef PG8_LDB
#undef PG8_MMA
#undef PG8_WAIT_V
#undef PG8_WAIT_L
#undef PG8_BAR
#undef PG8_SCHED
}
}
using pg8::Unit;

__device__ __forceinline__ int mod_row(int r) { return r < TP ? (r >> 11) : NB + ((r - TP) >> 2); }
__device__ __forceinline__ int pos_idx(int r) { return r < TP ? (r & 2047) : 2048 + ((r - TP) & 3); }

struct EpiF32Bias {
    static constexpr bool PERM = false;
    float* C; int ldc; const float* bias;
    __device__ __forceinline__ void operator()(const f32x4 (&acc)[2][2][4][2], const Unit& u, int wr, int wc, int fr, int fq) const {
        const int row0 = u.pm * 256 + wr * 64 + fr, col0 = u.pn * 256 + wc * 32 + 4 * fq;
#pragma unroll
        for (int ai = 0; ai < 2; ++ai)
#pragma unroll
            for (int m = 0; m < 4; ++m) { float* rowp = C + (size_t)(row0 + ai * 128 + m * 16) * ldc + col0;
#pragma unroll
                for (int bj = 0; bj < 2; ++bj)
#pragma unroll
                    for (int n = 0; n < 2; ++n) { const f32x4 bv = *(const f32x4*)(bias + col0 + bj * 128 + n * 16); *(f32x4*)(rowp + bj * 128 + n * 16) = acc[ai][bj][m][n] + bv; } }
    }
};

struct EpiBf16Plain {
    static constexpr bool PERM = true;
    bf16_t* O; int ldc;
    __device__ __forceinline__ void operator()(const f32x4 (&acc)[2][2][4][2], const Unit& u, int wr, int wc, int fr, int fq) const {
        const int row0 = u.pm * 256 + wr * 64 + fr, col0 = u.pn * 256 + wc * 32 + 8 * fq;
#pragma unroll
        for (int ai = 0; ai < 2; ++ai)
#pragma unroll
            for (int m = 0; m < 4; ++m) { bf16_t* rowp = O + (size_t)(row0 + ai * 128 + m * 16) * ldc + col0;
#pragma unroll
                for (int bj = 0; bj < 2; ++bj) { const f32x4 v0 = acc[ai][bj][m][0], v1 = acc[ai][bj][m][1];
                    u32x4 w; w.x = cvt_pk_bf16(v0[0], v0[1]); w.y = cvt_pk_bf16(v0[2], v0[3]); w.z = cvt_pk_bf16(v1[0], v1[1]); w.w = cvt_pk_bf16(v1[2], v1[3]);
                    *(u32x4*)(rowp + bj * 128) = w; } }
    }
};

struct EpiInProj {
    static constexpr bool PERM = true;
    bf16_t *U, *BG, *Q, *K, *V, *QI, *KI, *SGA, *SGB; float* WI; const float *qnw, *knw; const f32x2* rope; float* out;
    __device__ __forceinline__ void rope_rows(const f32x4 (&acc)[2][2][4][2], int ai, int m, int r, int fq, const float* nw, float (&o1)[8], float (&o2)[8]) const {
        float x1[8], x2[8];
#pragma unroll
        for (int n = 0; n < 2; ++n)
#pragma unroll
            for (int j = 0; j < 4; ++j) { x1[n * 4 + j] = acc[ai][0][m][n][j]; x2[n * 4 + j] = acc[ai][1][m][n][j]; }
        const int i0 = fq * 8;
        if (nw) {
            float ss = 0.f;
#pragma unroll
            for (int e = 0; e < 8; ++e) ss += x1[e] * x1[e] + x2[e] * x2[e];
            ss += __shfl_xor(ss, 16); ss += __shfl_xor(ss, 32);
            const float rstd = rsqrtf(ss * (1.0f / 64.0f) + NORM_EPS);
#pragma unroll
            for (int e = 0; e < 8; ++e) { x1[e] = x1[e] * rstd * nw[i0 + e]; x2[e] = x2[e] * rstd * nw[32 + i0 + e]; }
        }
        const f32x2* rp = rope + (size_t)pos_idx(r) * 32 + i0;
#pragma unroll
        for (int e = 0; e < 8; ++e) { const f32x2 cs = rp[e]; o1[e] = x1[e] * cs.x - x2[e] * cs.y; o2[e] = x2[e] * cs.x + x1[e] * cs.y; }
    }
    __device__ __forceinline__ void operator()(const f32x4 (&acc)[2][2][4][2], const Unit& u, int wr, int wc, int fr, int fq) const {
        const int pn = u.pn;
        const bool smp = u.pm >= 256;
#pragma unroll
        for (int ai = 0; ai < 2; ++ai)
#pragma unroll
            for (int m = 0; m < 4; ++m) {
                const int r = u.pm * 256 + ai * 128 + wr * 64 + m * 16 + fr;
                const int rs = r - TP;
                if (pn < 4) {
                    float uv[8];
#pragma unroll
                    for (int n = 0; n < 2; ++n)
#pragma unroll
                        for (int j = 0; j < 4; ++j) uv[n * 4 + j] = acc[ai][0][m][n][j] * acc[ai][1][m][n][j];
                    const int c0 = pn * 128 + wc * 32 + fq * 8;
                    *(u32x4*)(U + (size_t)r * 512 + c0) = pack8(uv);
                    float* cp = nullptr;
                    if (!smp) { const int t = r & 2047; if (t >= 2046) cp = out + OFF_CONVP + ((size_t)(r >> 11) * 2 + (t - 2046)) * 512 + c0; }
                    else { const int j4 = rs & 3; if (j4 >= 2) cp = out + OFF_CONVS + ((size_t)(rs >> 2) * 2 + (j4 - 2)) * 512 + c0; }
                    if (cp) { *(f32x4*)cp = (f32x4){uv[0], uv[1], uv[2], uv[3]}; *(f32x4*)(cp + 4) = (f32x4){uv[4], uv[5], uv[6], uv[7]}; }
                } else if (pn < 6) {
#pragma unroll
                    for (int bj = 0; bj < 2; ++bj) { float v[8];
#pragma unroll
                        for (int n = 0; n < 2; ++n)
#pragma unroll
                            for (int j = 0; j < 4; ++j) v[n * 4 + j] = acc[ai][bj][m][n][j];
                        *(u32x4*)(BG + (size_t)r * 512 + (pn - 4) * 256 + bj * 128 + wc * 32 + fq * 8) = pack8(v); }
                } else if (pn < 8) {
                    float o1[8], o2[8]; rope_rows(acc, ai, m, r, fq, qnw, o1, o2);
                    bf16_t* p = Q + (size_t)r * 512 + ((pn - 6) * 4 + wc) * 64 + fq * 8;
                    *(u32x4*)p = pack8(o1); *(u32x4*)(p + 32) = pack8(o2);
                } else if (pn == 8) {
                    float o1[8], o2[8];
                    const int hd = wc & 1;
                    if (wc < 2) rope_rows(acc, ai, m, r, fq, knw, o1, o2);
                    else {
#pragma unroll
                        for (int n = 0; n < 2; ++n)
#pragma unroll
                            for (int j = 0; j < 4; ++j) { o1[n * 4 + j] = acc[ai][0][m][n][j]; o2[n * 4 + j] = acc[ai][1][m][n][j]; }
                    }
                    bf16_t* p = (wc < 2 ? K : V) + (size_t)r * 128 + hd * 64 + fq * 8;
                    *(u32x4*)p = pack8(o1); *(u32x4*)(p + 32) = pack8(o2);
                    float* op = out + (smp ? (wc < 2 ? OFF_KS : OFF_VS) + (size_t)rs * 128 : (wc < 2 ? OFF_KP : OFF_VP) + (size_t)r * 128) + hd * 64 + fq * 8;
                    *(f32x4*)op = (f32x4){o1[0], o1[1], o1[2], o1[3]}; *(f32x4*)(op + 4) = (f32x4){o1[4], o1[5], o1[6], o1[7]};
                    *(f32x4*)(op + 32) = (f32x4){o2[0], o2[1], o2[2], o2[3]}; *(f32x4*)(op + 36) = (f32x4){o2[4], o2[5], o2[6], o2[7]};
                } else if (pn < 11) {
                    float o1[8], o2[8]; rope_rows(acc, ai, m, r, fq, nullptr, o1, o2);
                    bf16_t* p = QI + (size_t)r * 512 + ((pn - 9) * 4 + wc) * 64 + fq * 8;
                    *(u32x4*)p = pack8(o1); *(u32x4*)(p + 32) = pack8(o2);
                } else if (pn == 11) {
                    if (wc == 0) {
                        float o1[8], o2[8]; rope_rows(acc, ai, m, r, fq, nullptr, o1, o2);
                        bf16_t* p = KI + (size_t)r * 64 + fq * 8;
                        *(u32x4*)p = pack8(o1); *(u32x4*)(p + 32) = pack8(o2);
                        float* op = out + (smp ? OFF_KIS + (size_t)rs * 64 : OFF_KIP + (size_t)r * 64) + fq * 8;
                        *(f32x4*)op = (f32x4){o1[0], o1[1], o1[2], o1[3]}; *(f32x4*)(op + 4) = (f32x4){o1[4], o1[5], o1[6], o1[7]};
                        *(f32x4*)(op + 32) = (f32x4){o2[0], o2[1], o2[2], o2[3]}; *(f32x4*)(op + 36) = (f32x4){o2[4], o2[5], o2[6], o2[7]};
                    } else if (wc == 1 && fq == 0) {
                        float* wp = WI + (size_t)r * 8;
                        *(f32x4*)wp = acc[ai][0][m][0] * IDX_SCALE; *(f32x4*)(wp + 4) = acc[ai][0][m][1] * IDX_SCALE;
                    }
                } else {
                    bf16_t* base = pn < 16 ? SGA : SGB; const int pc = pn < 16 ? pn - 12 : pn - 16;
#pragma unroll
                    for (int bj = 0; bj < 2; ++bj) { float v[8];
#pragma unroll
                        for (int n = 0; n < 2; ++n)
#pragma unroll
                            for (int j = 0; j < 4; ++j) v[n * 4 + j] = sigmoidf_(acc[ai][bj][m][n][j]);
                        *(u32x4*)(base + (size_t)r * 1024 + pc * 256 + bj * 128 + wc * 32 + fq * 8) = pack8(v); }
                }
            }
    }
};
__host__ __device__ __forceinline__ int win_src_col(int j) {
    const int pn = j >> 8, tc = j & 255, bj = tc >> 7, wc = (tc >> 5) & 3, i = tc & 31;
    if (pn < 4) return (bj ? 1024 : 0) + pn * 128 + (tc & 127);
    if (pn < 6) return 512 + (pn - 4) * 256 + tc;
    if (pn < 8) return 1536 + ((pn - 6) * 4 + wc) * 64 + bj * 32 + i;
    if (pn == 8) return wc < 2 ? 2048 + wc * 64 + bj * 32 + i : 2176 + (wc - 2) * 64 + bj * 32 + i;
    if (pn < 11) return 2304 + ((pn - 9) * 4 + wc) * 64 + bj * 32 + i;
    if (pn == 11) { if (wc == 0) return 2816 + bj * 32 + i; if (wc == 1 && bj == 0 && i < 8) return 2880 + i; return -1; }
    if (pn < 16) return 2888 + (pn - 12) * 256 + tc;
    return 3912 + (pn - 16) * 256 + tc;
}

template <int MODE> struct EpiMix {
    static constexpr bool PERM = true;
    const bf16_t* SG; bf16_t* MIX;
    __device__ __forceinline__ void operator()(const f32x4 (&acc)[2][2][4][2], const Unit& u, int wr, int wc, int fr, int fq) const {
        const int row0 = u.pm * 256 + wr * 64 + fr, col0 = u.pn * 256 + wc * 32 + 8 * fq;
#pragma unroll
        for (int ai = 0; ai < 2; ++ai)
#pragma unroll
            for (int m = 0; m < 4; ++m) { const size_t ro = (size_t)(row0 + ai * 128 + m * 16) * 1024 + col0;
#pragma unroll
                for (int bj = 0; bj < 2; ++bj) {
                    float g[8], v[8]; unpack8(*(const u32x4*)(SG + ro + bj * 128), g);
#pragma unroll
                    for (int n = 0; n < 2; ++n)
#pragma unroll
                        for (int j = 0; j < 4; ++j) v[n * 4 + j] = g[n * 4 + j] * acc[ai][bj][m][n][j];
                    if (MODE == 1) { float pv[8]; unpack8(*(const u32x4*)(MIX + ro + bj * 128), pv);
#pragma unroll
                        for (int e = 0; e < 8; ++e) v[e] += pv[e]; }
                    *(u32x4*)(MIX + ro + bj * 128) = pack8(v); } }
    }
};

struct EpiMixFused {
    static constexpr bool PERM = true;
    const bf16_t* SGA; const bf16_t* SGB; bf16_t* MIX;
    __device__ __forceinline__ void mid(f32x4 (&acc)[2][2][4][2], const Unit& u, int wr, int wc, int fr, int fq) const {
        unsigned o0 = ((unsigned)(u.pm * 256 + wr * 64 + fr) * 1024u + (unsigned)(u.pn * 256 + wc * 32 + 8 * fq)) * 2u;
        asm volatile("" : "+v"(o0));
#pragma unroll
        for (int ai = 0; ai < 2; ++ai)
#pragma unroll
            for (int m = 0; m < 4; ++m) { const unsigned ro = o0 + (unsigned)(ai * 128 + m * 16) * 2048u;
#pragma unroll
                for (int bj = 0; bj < 2; ++bj) {
                    float ga[8], gb[8]; unpack8(*(const u32x4*)((const char*)SGA + ro + bj * 256), ga); unpack8(*(const u32x4*)((const char*)SGB + ro + bj * 256), gb);
#pragma unroll
                    for (int n = 0; n < 2; ++n)
#pragma unroll
                        for (int j = 0; j < 4; ++j) acc[ai][bj][m][n][j] *= ga[n * 4 + j] * __builtin_amdgcn_rcpf(fmaxf(gb[n * 4 + j], 1e-20f)); }
                if (m & 1) __builtin_amdgcn_sched_barrier(0); }
    }
    __device__ __forceinline__ void operator()(const f32x4 (&acc)[2][2][4][2], const Unit& u, int wr, int wc, int fr, int fq) const {
        unsigned o0 = ((unsigned)(u.pm * 256 + wr * 64 + fr) * 1024u + (unsigned)(u.pn * 256 + wc * 32 + 8 * fq)) * 2u;
        asm volatile("" : "+v"(o0));
#pragma unroll
        for (int ai = 0; ai < 2; ++ai)
#pragma unroll
            for (int m = 0; m < 4; ++m) { const unsigned ro = o0 + (unsigned)(ai * 128 + m * 16) * 2048u;
#pragma unroll
                for (int bj = 0; bj < 2; ++bj) {
                    float gb[8], v[8]; unpack8(*(const u32x4*)((const char*)SGB + ro + bj * 256), gb);
#pragma unroll
                    for (int n = 0; n < 2; ++n)
#pragma unroll
                        for (int j = 0; j < 4; ++j) v[n * 4 + j] = fmaxf(gb[n * 4 + j], 1e-20f) * acc[ai][bj][m][n][j];
                    *(u32x4*)((char*)MIX + ro + bj * 256) = pack8(v); } }
    }
};

struct EpiOut {
    static constexpr bool PERM = true;
    const float* MOD; bf16_t* Dm;
    __device__ __forceinline__ void operator()(const f32x4 (&acc)[2][2][4][2], const Unit& u, int wr, int wc, int fr, int fq) const {
        const int col0 = u.pn * 256 + wc * 32 + 8 * fq;
#pragma unroll
        for (int ai = 0; ai < 2; ++ai)
#pragma unroll
            for (int m = 0; m < 4; ++m) {
                const int r = u.pm * 256 + ai * 128 + wr * 64 + m * 16 + fr;
                const float* gr = MOD + (size_t)mod_row(r) * NMOD + 2048;
#pragma unroll
                for (int bj = 0; bj < 2; ++bj) { const int c = col0 + bj * 128;
                    const f32x4 g0 = *(const f32x4*)(gr + c), g1 = *(const f32x4*)(gr + c + 4); float v[8];
#pragma unroll
                    for (int j = 0; j < 4; ++j) { v[j] = g0[j] * acc[ai][bj][m][0][j]; v[4 + j] = g1[j] * acc[ai][bj][m][1][j]; }
                    *(u32x4*)(Dm + (size_t)r * 1024 + c) = pack8(v); } }
    }
};

typedef _Float16 h2_t __attribute__((ext_vector_type(2)));
__device__ __forceinline__ unsigned cvt_pk_f16(float lo, float hi) { const h2_t v = __builtin_convertvector((f32x2){lo, hi}, h2_t); return __builtin_bit_cast(unsigned, v); }
struct EpiPST {
    static constexpr bool PERM = true;
    unsigned short* PST;
    __device__ __forceinline__ void operator()(const f32x4 (&acc)[2][2][4][2], const Unit& u, int wr, int wc, int fr, int fq) const {
        unsigned short* base = PST + (size_t)(u.pm * 8 + u.pn) * 65536 + wc * 32 + 8 * fq;
#pragma unroll
        for (int ai = 0; ai < 2; ++ai)
#pragma unroll
            for (int m = 0; m < 4; ++m) { const int rl = ai * 128 + wr * 64 + m * 16 + fr;
#pragma unroll
                for (int bj = 0; bj < 2; ++bj) { const f32x4 v0 = acc[ai][bj][m][0], v1 = acc[ai][bj][m][1];
                    u32x4 w; w.x = cvt_pk_f16(v0[0], v0[1]); w.y = cvt_pk_f16(v0[2], v0[3]); w.z = cvt_pk_f16(v1[0], v1[1]); w.w = cvt_pk_f16(v1[2], v1[3]);
                    *(u32x4*)(base + (size_t)rl * 256 + bj * 128) = w; } }
    }
};

struct Params { const float* in[24]; float* out; unsigned char* ws; int ph_lo, ph_hi, rep_mask, pad; };
struct Frame {
    LAS unsigned char* lds; int tid, lane, wave, bid, nblk; unsigned* ctl; unsigned char* ws; float* out;
    const float *x_prompt, *x_sample, *cache_k, *cache_v, *cache_kidx, *state_conv; const int* page_table; const float *c_prompt, *c_sample, *w_ada, *b_ada, *norm1_w, *w_in, *conv_w, *q_norm_w, *k_norm_w,
        *w_conv_out, *w_attn_out, *w_out, *norm2_w, *peer_w_q, *peer_sub_keys, *peer_u, *peer_v;
};
#define WSP(type, off) ((type*)(F.ws + (off)))

template <bool DUAL, class Fin, int KQ = 256>
__device__ __forceinline__ void skinny_phase(const Frame& F, const bf16_t* A1, const bf16_t* B1, const bf16_t* A2, const bf16_t* B2, int lda, int ldb, int N, int row_base, int nrt, Fin fin, int a_pn_cols = 0, int pn_shift = 3) {
    LAS float* P = (LAS float*)F.lds;
    const int lane = F.lane, q = lane & 31, half = lane >> 5, w = F.wave, rb = w & 1, kq = w >> 1;
    const bf16_t* Asel = (DUAL && kq >= 2) ? A2 : A1; const bf16_t* Bsel = (DUAL && kq >= 2) ? B2 : B1;
    const int k0 = (DUAL ? (kq & 1) : kq) * KQ + half * 8;
    const int ntile = nrt * (N / 32);
    for (int tl = F.bid; tl < ntile; tl += F.nblk) {
        const int rt = tl % nrt, ct = tl / nrt;
        const bf16_t* ap = Asel + (size_t)(row_base + rt * 64 + rb * 32 + q) * lda + k0 + (ct >> pn_shift) * a_pn_cols;
        const bf16_t* bp = Bsel + (size_t)(ct * 32 + q) * ldb + k0;
        f32x16 acc;
#pragma unroll
        for (int i = 0; i < 16; ++i) acc[i] = 0.f;
        constexpr int NS = KQ / 16 < 16 ? KQ / 16 : 16;
#pragma unroll 1
        for (int kb = 0; kb < KQ / 16 / NS; ++kb) {
            u32x4 a[NS], b[NS];
#pragma unroll
            for (int i = 0; i < NS; ++i) { a[i] = *(const u32x4*)(ap + (kb * NS + i) * 16); b[i] = *(const u32x4*)(bp + (kb * NS + i) * 16); }
#pragma unroll
            for (int i = 0; i < NS; ++i) acc = __builtin_amdgcn_mfma_f32_32x32x16_bf16(__builtin_bit_cast(bf16x8, a[i]), __builtin_bit_cast(bf16x8, b[i]), acc, 0, 0, 0);
        }
        __syncthreads();
#pragma unroll
        for (int i = 0; i < 16; ++i) P[(kq * 64 + rb * 32 + 8 * (i >> 2) + 4 * half + (i & 3)) * 33 + q] = acc[i];
        __syncthreads();
        const int r = F.tid >> 3, c4 = (F.tid & 7) * 4;
        float s01[4], s23[4];
#pragma unroll
        for (int j = 0; j < 4; ++j) { s01[j] = P[(0 * 64 + r) * 33 + c4 + j] + P[(1 * 64 + r) * 33 + c4 + j]; s23[j] = P[(2 * 64 + r) * 33 + c4 + j] + P[(3 * 64 + r) * 33 + c4 + j]; }
        fin(row_base + rt * 64 + r, ct * 32 + c4, s01, s23);
    }
    __syncthreads();
}

template <class Map> __device__ __forceinline__ void transpose_cvt(const Frame& F, const float* src, int ld_src, bf16_t* dst, int K, int Nd, Map map) {
    LAS float* tile = (LAS float*)F.lds;
    const int ntk = K / 64, ntn = Nd / 64, ntile = ntk * ntn;
    float v[8];
#define TC_LOAD(tix_) do { const int tn_ = (tix_) / ntk, tk_ = (tix_) % ntk; _Pragma("unroll") for (int i_ = 0; i_ < 8; ++i_) { const int e_ = F.tid + 512 * i_, kk_ = e_ >> 6, nn_ = e_ & 63; \
        const int sc_ = map(tn_ * 64 + nn_); v[i_] = sc_ >= 0 ? src[(size_t)(tk_ * 64 + kk_) * ld_src + sc_] : 0.f; } } while (0)
    int tix = F.bid;
    if (tix < ntile) TC_LOAD(tix);
    for (; tix < ntile; tix += F.nblk) {
        const int tn = tix / ntk, tk = tix % ntk;
#pragma unroll
        for (int i = 0; i < 8; ++i) { const int e = F.tid + 512 * i, kk = e >> 6, nn = e & 63; tile[kk * 65 + nn] = v[i]; }
        __syncthreads();
        if (tix + F.nblk < ntile) TC_LOAD(tix + F.nblk);
#pragma unroll
        for (int i = 0; i < 4; ++i) { const int e = F.tid + 512 * i, nn = e >> 5, kp = e & 31;
            *(unsigned*)(dst + (size_t)(tn * 64 + nn) * K + tk * 64 + 2 * kp) = cvt_pk_bf16(tile[(2 * kp) * 65 + nn], tile[(2 * kp + 1) * 65 + nn]); }
        __syncthreads();
    }
#undef TC_LOAD
}
struct MapId { __device__ __forceinline__ int operator()(int n) const { return n; } };
struct MapWin { __device__ __forceinline__ int operator()(int n) const { return win_src_col(n); } };

__device__ __forceinline__ void p0_peer_tables(const Frame& F, int sb, int sn) {
    { unsigned char* d8 = WSP(unsigned char, WS_UT); float* tsc = WSP(float, WS_TSC);
      for (int row = sb * 8 + F.wave; row < 2 * 16384; row += sn * 8) {
          const float* s = (row < 16384 ? F.peer_u : F.peer_v) + (size_t)(row & 16383) * 1024 + F.lane * 16;
          f32x4 v[4]; float am = 0.f;
#pragma unroll
          for (int i = 0; i < 4; ++i) { v[i] = *(const f32x4*)(s + 4 * i); am = fmaxf(am, fmaxf(fmaxf(fabsf(v[i][0]), fabsf(v[i][1])), fmaxf(fabsf(v[i][2]), fabsf(v[i][3])))); }
          am = wave_max(am);
          const float sc = am > 0.f ? 240.0f / am : 1.0f;
          u32x4 w; unsigned ww[4];
#pragma unroll
          for (int i = 0; i < 4; ++i) { int pk = 0; pk = __builtin_amdgcn_cvt_pk_fp8_f32(v[i][0] * sc, v[i][1] * sc, pk, false); pk = __builtin_amdgcn_cvt_pk_fp8_f32(v[i][2] * sc, v[i][3] * sc, pk, true); ww[i] = (unsigned)pk; }
          w.x = ww[0]; w.y = ww[1]; w.z = ww[2]; w.w = ww[3];
          *(u32x4*)(d8 + (size_t)row * 1024 + F.lane * 16) = w;
          if (F.lane == 0) tsc[row] = am > 0.f ? am / 240.0f : 1.0f;
      } }
}

__device__ __forceinline__ void p0_convert(const Frame& F) {
    transpose_cvt(F, F.w_in, NPROJ, WSP(bf16_t, WS_WIN), 1024, NPROJ_PAD, MapWin());
    transpose_cvt(F, F.w_conv_out, 1024, WSP(bf16_t, WS_WCO), 512, 1024, MapId());
    transpose_cvt(F, F.w_attn_out, 1024, WSP(bf16_t, WS_WAO), 512, 1024, MapId());
    transpose_cvt(F, F.w_out, 1024, WSP(bf16_t, WS_WOUT), 1024, 1024, MapId());
    transpose_cvt(F, F.w_ada, NMOD, WSP(bf16_t, WS_WADA), 1024, NMOD, MapId());
    const size_t gt = (size_t)F.bid * 512 + F.tid, gn = (size_t)F.nblk * 512;
    { bf16_t* d = WSP(bf16_t, WS_Q2);
      for (size_t i = gt; i < (size_t)1024 * 2048 / 2; i += gn) *(unsigned*)(d + 2 * i) = cvt_pk_bf16(F.peer_w_q[2 * i], F.peer_w_q[2 * i + 1]); }
    { bf16_t* d = WSP(bf16_t, WS_SKBD);
      for (size_t i = gt; i < (size_t)2048 * 128 / 2; i += gn) { const int row = (int)(i >> 6), cp = (int)(i & 63) * 2; const int h = row >> 8, p = (row >> 7) & 1, key = row & 127;
          const float* s = F.peer_sub_keys + (((size_t)p * 8 + h) * 128 + key) * 128 + cp;
          *(unsigned*)(d + (size_t)row * 128 + cp) = cvt_pk_bf16(s[0], s[1]); } }
    { bf16_t* d = WSP(bf16_t, WS_CB);
      for (size_t i = gt; i < (size_t)256 * 1024 / 2; i += gn) { const int row = (int)(i >> 9), cp = (int)(i & 511) * 2; float a = 0.f, b = 0.f;
          if (row < NB) { a = F.c_prompt[row * 1024 + cp]; b = F.c_prompt[row * 1024 + cp + 1]; } else if (row < NB + DB) { a = F.c_sample[(row - NB) * 1024 + cp]; b = F.c_sample[(row - NB) * 1024 + cp + 1]; }
          *(unsigned*)(d + (size_t)row * 1024 + cp) = cvt_pk_bf16(a, b); } }
    { f32x2* d = WSP(f32x2, WS_ROPE);
      for (size_t i = gt; i < (size_t)2052 * 32; i += gn) { const int pi = (int)(i >> 5), fi = (int)(i & 31); const int pos = pi < 2048 ? pi : PAST + (pi - 2048);
          const float fr = powf(10000.0f, -(float)fi / 32.0f); const float ang = (float)pos * fr;
          d[i] = (f32x2){(float)cos((double)ang), (float)sin((double)ang)}; } }
}

template <bool SECOND> __device__ __forceinline__ void row_norm_pass(const Frame& F) {
    const float* MOD = WSP(float, WS_MOD); bf16_t* H = WSP(bf16_t, WS_H);
    const float* nw = SECOND ? F.norm2_w : F.norm1_w;
    const int so = SECOND ? 3 * 1024 : 0;
    for (int r = F.bid * 8 + F.wave; r < T; r += F.nblk * 8) {
        const float* xr = r < TP ? F.x_prompt + (size_t)r * 1024 : F.x_sample + (size_t)(r - TP) * 1024;
        f32x4 v[4]; float ss = 0.f;
#pragma unroll
        for (int i = 0; i < 4; ++i) { v[i] = *(const f32x4*)(xr + i * 256 + F.lane * 4);
            if (SECOND) { const u32x2 dv = *(const u32x2*)(WSP(bf16_t, WS_X1) + (size_t)r * 1024 + i * 256 + F.lane * 4); v[i] += (f32x4){bf_lo(dv.x), bf_hi(dv.x), bf_lo(dv.y), bf_hi(dv.y)}; }
            ss += v[i][0] * v[i][0] + v[i][1] * v[i][1] + v[i][2] * v[i][2] + v[i][3] * v[i][3]; }
        ss = wave_sum(ss);
        const float rstd = rsqrtf(ss * (1.0f / 1024.0f) + NORM_EPS);
        const float* mr = MOD + (size_t)mod_row(r) * NMOD + so;
#pragma unroll
        for (int i = 0; i < 4; ++i) { const int c = i * 256 + F.lane * 4;
            const f32x4 w = *(const f32x4*)(nw + c), sh = *(const f32x4*)(mr + c), sc = *(const f32x4*)(mr + 1024 + c);
            const f32x4 y = v[i] * rstd * w * (sc + 1.0f) + sh;
            u32x2 o; o.x = cvt_pk_bf16(y[0], y[1]); o.y = cvt_pk_bf16(y[2], y[3]);
            *(u32x2*)(H + (size_t)r * 1024 + c) = o; }
    }
}

__device__ __forceinline__ void p4_vtranspose(const Frame& F) {
    const bf16_t* V = WSP(bf16_t, WS_V); bf16_t* VTR = WSP(bf16_t, WS_VTR);
    LAS bf16_t* tile = (LAS bf16_t*)F.lds;
    for (int tix = F.bid; tix < NB * 2 * 32; tix += F.nblk) {
        const int b = tix >> 6, kvh = (tix >> 5) & 1, tt = tix & 31;
        { const int trow = F.tid >> 3, dc = F.tid & 7;
          const u32x4 w = *(const u32x4*)(V + ((size_t)(b * 2048 + tt * 64 + trow)) * 128 + kvh * 64 + dc * 8);
          const unsigned ww[4] = {w.x, w.y, w.z, w.w};
#pragma unroll
          for (int e = 0; e < 8; ++e) tile[(dc * 8 + e) * 72 + trow] = (bf16_t)((ww[e >> 1] >> ((e & 1) * 16)) & 0xffffu); }
        __syncthreads();
        { const int d = F.tid >> 3, tc = F.tid & 7;
          const u32x4 w = *(const LAS u32x4*)(tile + d * 72 + tc * 8);
          *(u32x4*)(VTR + ((size_t)((b * 2 + kvh) * 64 + d)) * 2048 + tt * 64 + tc * 8) = w; }
        __syncthreads();
    }
}
__device__ __forceinline__ void p4_conv(const Frame& F) {
    const bf16_t* U = WSP(bf16_t, WS_U); const bf16_t* BG = WSP(bf16_t, WS_BG); bf16_t* APRE = WSP(bf16_t, WS_APRE);
    const size_t gt = (size_t)F.bid * 512 + F.tid, gn = (size_t)F.nblk * 512;
    for (size_t i = gt; i < (size_t)T * 64; i += gn) {
        const int r = (int)(i >> 6), c0 = (int)(i & 63) * 8;
        float u0[8], u1[8], u2[8], bg[8], w0[8], w1[8], w2[8];
        unpack8(*(const u32x4*)(U + (size_t)r * 512 + c0), u2);
        unpack8(*(const u32x4*)(BG + (size_t)r * 512 + c0), bg);
#pragma unroll
        for (int e = 0; e < 8; ++e) { w0[e] = F.conv_w[c0 + e]; w1[e] = F.conv_w[512 + c0 + e]; w2[e] = F.conv_w[1024 + c0 + e]; u1[e] = 0.f; u0[e] = 0.f; }
        if (r < TP) { const int t = r & 2047;
            if (t >= 1) unpack8(*(const u32x4*)(U + (size_t)(r - 1) * 512 + c0), u1);
            if (t >= 2) unpack8(*(const u32x4*)(U + (size_t)(r - 2) * 512 + c0), u0);
        } else { const int rs = r - TP, b = rs >> 2, j = rs & 3;
            const float* st = F.state_conv + (size_t)b * 1024 + c0;
            if (j >= 1) unpack8(*(const u32x4*)(U + (size_t)(r - 1) * 512 + c0), u1);
            else {
#pragma unroll
                for (int e = 0; e < 8; ++e) u1[e] = st[512 + e]; }
            if (j >= 2) unpack8(*(const u32x4*)(U + (size_t)(r - 2) * 512 + c0), u0);
            else {
#pragma unroll
                for (int e = 0; e < 8; ++e) u0[e] = st[(j == 1 ? 512 : 0) + e]; }
        }
        float o[8];
#pragma unroll
        for (int e = 0; e < 8; ++e) o[e] = bg[e] * (w2[e] * u2[e] + w1[e] * u1[e] + w0[e] * u0[e]);
        *(u32x4*)(APRE + (size_t)r * 512 + c0) = pack8(o);
    }
}

constexpr int QL_STRIDE = 1040;
template <bool WLDS> __device__ __forceinline__ f32x16 idx_tile_t(const bf16x8 (&kf)[4], const LAS unsigned char* qb_, const float (&w8)[8], const LAS float* wl) {
    unsigned qo = (unsigned)(size_t)qb_; asm volatile("" : "+v"(qo));
    const LAS unsigned char* qb = (const LAS unsigned char*)(size_t)qo;
    f32x16 sc;
#pragma unroll
    for (int i = 0; i < 16; ++i) sc[i] = 0.f;
#pragma unroll
    for (int h = 0; h < 8; ++h) {
        f32x16 a;
#pragma unroll
        for (int i = 0; i < 16; ++i) a[i] = 0.f;
#pragma unroll
        for (int s = 0; s < 4; ++s) { const bf16x8 qf = *(const LAS bf16x8*)(qb + h * 128 + s * 32); a = __builtin_amdgcn_mfma_f32_32x32x16_bf16(kf[s], qf, a, 0, 0, 0); }
        const float wh = WLDS ? wl[h] : w8[h];
#pragma unroll
        for (int i = 0; i < 16; ++i) sc[i] += wh * fmaxf(a[i], 0.f);
    }
    return sc;
}
__device__ __forceinline__ f32x16 idx_tile(const bf16x8 (&kf)[4], const LAS unsigned char* qb_, const float (&w8)[8]) { return idx_tile_t<false>(kf, qb_, w8, nullptr); }

__device__ __forceinline__ int wave_sum_i_dpp(int x) {
    x += __builtin_amdgcn_update_dpp(0, x, 0xB1, 0xF, 0xF, true);
    x += __builtin_amdgcn_update_dpp(0, x, 0x4E, 0xF, 0xF, true);
    x += __builtin_amdgcn_update_dpp(0, x, 0x141, 0xF, 0xF, true);
    x += __builtin_amdgcn_update_dpp(0, x, 0x140, 0xF, 0xF, true);
    x += __builtin_amdgcn_update_dpp(0, x, 0x142, 0xA, 0xF, false);
    x += __builtin_amdgcn_update_dpp(0, x, 0x143, 0xC, 0xF, false);
    return __builtin_amdgcn_readlane(x, 63);
}
template <int NREG> __device__ __forceinline__ void select_rows8(const float* sc0, int n0, u64* mask0, int lane) {
    float cur[NREG], nxt[NREG];
#pragma unroll
    for (int j = 0; j < NREG; ++j) { cur[j] = sc0[64 * j + lane]; nxt[j] = 0.f; }
#pragma unroll 1
    for (int rr = 0; rr < 8; ++rr) {
        if (rr < 7) {
#pragma unroll
            for (int j = 0; j < NREG; ++j) nxt[j] = sc0[(size_t)(rr + 1) * 2048 + 64 * j + lane]; }
        const int n = n0 + rr;
        unsigned key[NREG];
#pragma unroll
        for (int j = 0; j < NREG; ++j) { const int idx = 64 * j + lane; const unsigned k = mono(cur[j]); key[j] = idx < n ? k : 0u; }
        unsigned thr = 0u, cut = 0u; bool exact = false;
#pragma unroll 1
        for (int bit = 31; bit >= 0; --bit) {
            const unsigned cand = thr | (1u << bit); int c = 0;
#pragma unroll
            for (int j = 0; j < NREG; ++j) c += (key[j] >= cand) ? 1 : 0;
            c = wave_sum_i_dpp(c);
            if (c == 256) { cut = cand; exact = true; break; }
            if (c > 256) thr = cand;
        }
        u64 myword = 0ull;
        if (exact) {
#pragma unroll
            for (int j = 0; j < NREG; ++j) { const u64 word = __ballot(key[j] >= cut); if (lane == j) myword = word; }
        } else {
            int cgt = 0;
#pragma unroll
            for (int j = 0; j < NREG; ++j) cgt += (key[j] > thr) ? 1 : 0;
            int need = 256 - wave_sum_i_dpp(cgt);
#pragma unroll
            for (int j = 0; j < NREG; ++j) {
                const u64 eq = __ballot(key[j] == thr);
                const int rank = mbcnt64(eq);
                const u64 word = __ballot(key[j] > thr || (key[j] == thr && rank < need));
                const int pe = __popcll(eq); need = need > pe ? need - pe : 0;
                if (lane == j) myword = word;
            }
        }
        if (lane < 32) mask0[(size_t)rr * 32 + lane] = myword;
#pragma unroll
        for (int j = 0; j < NREG; ++j) cur[j] = nxt[j];
    }
}
__device__ __forceinline__ void select_rows8_prompt(const float* sc0, int t0, u64* mask0, int lane) {
    t0 = __builtin_amdgcn_readfirstlane(t0);
    const int nmax = t0 + 8;
    if (nmax <= 256) {
#pragma unroll 1
        for (int rr = 0; rr < 8; ++rr) { const int n = t0 + rr + 1;
            if (lane < 32) { const int lo = 64 * lane; const u64 word = (n >= lo + 64) ? ~0ull : (n > lo ? ((1ull << (n - lo)) - 1ull) : 0ull); mask0[(size_t)rr * 32 + lane] = word; } }
    } else if (nmax <= 512) select_rows8<8>(sc0, t0 + 1, mask0, lane);
    else if (nmax <= 1024) select_rows8<16>(sc0, t0 + 1, mask0, lane);
    else if (nmax <= 1536) select_rows8<24>(sc0, t0 + 1, mask0, lane);
    else select_rows8<32>(sc0, t0 + 1, mask0, lane);
}

__device__ __forceinline__ void p4_prompt_unit(const Frame& F, int b, int qt, int parts, LAS int* qslot, unsigned* qhead) {
    const bf16_t* QI = WSP(bf16_t, WS_QI); const bf16_t* KI = WSP(bf16_t, WS_KI); const float* WI = WSP(float, WS_WI); float* SC = WSP(float, WS_SCR); u64* MASK = WSP(u64, WS_MASK);
    const int w = F.wave, lane = F.lane, q = lane & 31, half = lane >> 5;
    if (!(parts & 32)) {
    {
#pragma unroll
        for (int i = 0; i < 8; ++i) { const int e = F.tid + 512 * i, rw = e >> 6, ch = e & 63;
            *(LAS u32x4*)(F.lds + rw * QL_STRIDE + ch * 16) = *(const u32x4*)(QI + ((size_t)b * 2048 + qt * 64 + rw) * 512 + ch * 8); }
    }
    __syncthreads();
    {
        const int qh = w & 1, stripe = w >> 1, t0 = qt * 64 + qh * 32;
        const size_t rowq = (size_t)b * 2048 + t0 + q;
        const LAS unsigned char* qb = F.lds + (qh * 32 + q) * QL_STRIDE + half * 16;
        float w8[8];
        { const f32x4 a = *(const f32x4*)(WI + rowq * 8), c = *(const f32x4*)(WI + rowq * 8 + 4); w8[0] = a[0]; w8[1] = a[1]; w8[2] = a[2]; w8[3] = a[3]; w8[4] = c[0]; w8[5] = c[1]; w8[6] = c[2]; w8[7] = c[3]; }
        const int nkt = t0 / 32 + 1;
        if (stripe < nkt) {
            bf16x8 ka[4], kb[4];
#define P4_LOADK(dst, kt_) do { const int k_ = (kt_) < nkt ? (kt_) : stripe; const size_t rowk_ = (size_t)b * 2048 + k_ * 32 + q; \
        _Pragma("unroll") for (int s_ = 0; s_ < 4; ++s_) dst[s_] = *(const bf16x8*)(KI + rowk_ * 64 + s_ * 16 + half * 8); } while (0)
#define P4_STORE(scv, kt_) do { float* dst_ = SC + rowq * 2048 + (kt_) * 32 + 4 * half; \
        _Pragma("unroll") for (int g_ = 0; g_ < 4; ++g_) *(f32x4*)(dst_ + 8 * g_) = (f32x4){scv[4 * g_], scv[4 * g_ + 1], scv[4 * g_ + 2], scv[4 * g_ + 3]}; } while (0)
            P4_LOADK(ka, stripe);
#pragma unroll 1
            for (int kt = stripe; kt < nkt; kt += 4) {
                P4_LOADK(kb, kt + 4); __builtin_amdgcn_sched_barrier(0);
                const f32x16 sc = idx_tile(ka, qb, w8);
#pragma unroll
                for (int s = 0; s < 4; ++s) ka[s] = kb[s];
                __builtin_amdgcn_sched_barrier(0);
                P4_STORE(sc, kt);
            }
#undef P4_LOADK
#undef P4_STORE
        }
    }
    }
    __syncthreads();
    int unext = 0;
    if (F.tid == 0) unext = (int)__hip_atomic_fetch_add(qhead, 1u, __ATOMIC_RELAXED, __HIP_MEMORY_SCOPE_AGENT);
    if (!(parts & 16)) { const int t0 = qt * 64 + w * 8; const size_t row = (size_t)b * 2048 + t0; select_rows8_prompt(SC + row * 2048, t0, MASK + row * 32, lane); }
    if (F.tid == 0) *qslot = unext;
    __syncthreads();
}

__device__ __forceinline__ void p4_sample_unit(const Frame& F, int b) {
    const bf16_t* QI = WSP(bf16_t, WS_QI); const bf16_t* KI = WSP(bf16_t, WS_KI); const float* WI = WSP(float, WS_WI);
    const bf16_t* Q = WSP(bf16_t, WS_Q); const bf16_t* K = WSP(bf16_t, WS_K); const bf16_t* V = WSP(bf16_t, WS_V); bf16_t* ATT = WSP(bf16_t, WS_ATT);
    constexpr int SLW = 8224;
    constexpr int NEWKEY = 0x40000000;
    LAS unsigned* SL = (LAS unsigned*)F.lds;
    LAS int* SELR = (LAS int*)(F.lds + 4 * SLW * 4);
    LAS unsigned char* QL = F.lds + 4 * SLW * 4 + 4096;
    LAS int* CNT = (LAS int*)(F.lds + 4 * SLW * 4 + 4096 + 4 * QL_STRIDE);
    const int w = F.wave, lane = F.lane, q = lane & 31, half = lane >> 5, tid = F.tid;
    const int* pt = F.page_table + b * NPG;
    const size_t r0 = (size_t)TP + b * 4;
    if (tid < 256) { const int rw = tid >> 6, ch = tid & 63; *(LAS u32x4*)(QL + rw * QL_STRIDE + ch * 16) = *(const u32x4*)(QI + (r0 + rw) * 512 + ch * 8); }
    if (tid < 32) ((LAS float*)(QL + 4 * QL_STRIDE + 256))[tid] = WI[r0 * 8 + tid];
    LAS int* PTL = (LAS int*)(QL + 4 * QL_STRIDE + 512);
    if (tid >= 64 && tid < 128) PTL[tid - 64] = pt[tid - 64];
    __syncthreads();
    {
        const size_t rowq = r0 + (q & 3);
        const LAS unsigned char* qb = QL + (q & 3) * QL_STRIDE + half * 16;
        const LAS float* wl = (const LAS float*)(QL + 4 * QL_STRIDE + 256) + (q & 3) * 8;
        const float w8[8] = {0.f, 0.f, 0.f, 0.f, 0.f, 0.f, 0.f, 0.f};
        (void)rowq;
        f32x4 ta[8], tb[8];
#define SMP_LOAD(dst, kt_) do { const int k_ = (kt_) < 256 ? (kt_) : 255; const float* kr_ = F.cache_kidx + ((size_t)PTL[k_ >> 2] * PAGE + ((k_ & 3) * 32 + q)) * 64 + half * 8; \
        _Pragma("unroll") for (int s_ = 0; s_ < 4; ++s_) { dst[2 * s_] = *(const f32x4*)(kr_ + s_ * 16); dst[2 * s_ + 1] = *(const f32x4*)(kr_ + s_ * 16 + 4); } } while (0)
#define SMP_TILE(srcb, kt_) do { if ((kt_) < 256) { bf16x8 kf_[4]; \
        _Pragma("unroll") for (int s_ = 0; s_ < 4; ++s_) { const f32x4 a_ = srcb[2 * s_], c_ = srcb[2 * s_ + 1]; \
            u32x4 wv_; wv_.x = cvt_pk_bf16(a_[0], a_[1]); wv_.y = cvt_pk_bf16(a_[2], a_[3]); wv_.z = cvt_pk_bf16(c_[0], c_[1]); wv_.w = cvt_pk_bf16(c_[2], c_[3]); kf_[s_] = __builtin_bit_cast(bf16x8, wv_); } \
        const f32x16 sc_ = idx_tile_t<true>(kf_, qb, w8, wl); \
        if (q < 4) { _Pragma("unroll") for (int i_ = 0; i_ < 16; ++i_) SL[q * SLW + (kt_) * 32 + 8 * (i_ >> 2) + 4 * half + (i_ & 3)] = mono(sc_[i_]); } } } while (0)
        SMP_LOAD(ta, w);
#pragma unroll 1
        for (int kt = w; kt < 256; kt += 16) {
            SMP_LOAD(tb, kt + 8); __builtin_amdgcn_sched_barrier(0); SMP_TILE(ta, kt);
            SMP_LOAD(ta, kt + 16); __builtin_amdgcn_sched_barrier(0); SMP_TILE(tb, kt + 8);
        }
#undef SMP_LOAD
#undef SMP_TILE
        if (w == 0) {
            bf16x8 kf[4];
#pragma unroll
            for (int s = 0; s < 4; ++s) { u32x4 wv = (u32x4){0u, 0u, 0u, 0u}; if (q < 4) wv = *(const u32x4*)(KI + (r0 + q) * 64 + s * 16 + half * 8); kf[s] = __builtin_bit_cast(bf16x8, wv); }
            const f32x16 sc = idx_tile_t<true>(kf, qb, w8, wl);
            if (q < 4) {
#pragma unroll
                for (int i = 0; i < 16; ++i) SL[q * SLW + 256 * 32 + 8 * (i >> 2) + 4 * half + (i & 3)] = mono(sc[i]);
            }
        }
    }
    __syncthreads();
    {
        const int j = w >> 1, hw = w & 1, n = PAST + 1 + j;
        unsigned key[65];
#pragma unroll
        for (int k = 0; k < 65; ++k) { const int idx = hw * 4160 + 64 * k + lane; key[k] = 0u; if (idx < n) key[k] = SL[j * SLW + idx]; }
        unsigned thr = 0u;
#pragma unroll 1
        for (int bit = 31; bit >= 0; --bit) {
            const unsigned cand = thr | (1u << bit); int c = 0;
#pragma unroll
            for (int k = 0; k < 65; ++k) c += __popcll(__ballot(key[k] >= cand));
            if (lane == 0) CNT[(bit & 1) * 8 + w] = c;
            __syncthreads();
            const int tot = CNT[(bit & 1) * 8 + (w & ~1)] + CNT[(bit & 1) * 8 + (w | 1)];
            if (tot >= 256) thr = cand;
        }
        int cgt = 0, ceq = 0;
#pragma unroll 1
        for (int k = 0; k < 65; ++k) { const int idx = hw * 4160 + 64 * k + lane; const unsigned kk = idx < n ? SL[j * SLW + idx] : 0u;
            cgt += __popcll(__ballot(kk > thr)); ceq += __popcll(__ballot(kk == thr)); }
        if (lane == 0) { CNT[16 + w * 2] = cgt; CNT[16 + w * 2 + 1] = ceq; }
        __syncthreads();
        const int cgt0 = CNT[16 + (w & ~1) * 2], ceq0 = CNT[16 + (w & ~1) * 2 + 1], cgt1 = CNT[16 + (w | 1) * 2];
        const int need_tot = 256 - (cgt0 + cgt1);
        const int take0 = ceq0 < need_tot ? ceq0 : need_tot;
        int need = hw == 0 ? take0 : need_tot - take0;
        int base = hw == 0 ? 0 : cgt0 + take0;
#pragma unroll 1
        for (int k = 0; k < 65; ++k) {
            const int idx = hw * 4160 + 64 * k + lane; const unsigned kk = idx < n ? SL[j * SLW + idx] : 0u;
            const u64 eq = __ballot(kk == thr);
            const int rank = (int)__builtin_amdgcn_mbcnt_hi((unsigned)(eq >> 32), __builtin_amdgcn_mbcnt_lo((unsigned)eq, 0u));
            const bool on = kk > thr || (kk == thr && rank < need);
            const u64 sel = __ballot(on);
            const int pe = __popcll(eq); need = need > pe ? need - pe : 0;
            if (on) { const int pos = base + (int)__builtin_amdgcn_mbcnt_hi((unsigned)(sel >> 32), __builtin_amdgcn_mbcnt_lo((unsigned)sel, 0u));
                if (pos < 256) SELR[j * 256 + pos] = idx < PAST ? PTL[idx >> 7] * PAGE + (idx & 127) : (NEWKEY | (idx - PAST)); }
            base += __popcll(sel);
        }
    }
    __syncthreads();
    {
        LAS float* QF4 = (LAS float*)F.lds;
        LAS float* LG4 = (LAS float*)(F.lds + 8192);
        LAS float* PV4 = (LAS float*)(F.lds + 8192 + 32768);
#pragma unroll
        for (int j = 0; j < 4; ++j) QF4[j * 512 + tid] = bf2f(Q[(r0 + j) * 512 + tid]);
        __syncthreads();
#pragma unroll 1
        for (int j = 0; j < 4; ++j) {
            const int slot = tid >> 1, kvh = tid & 1; const int row = SELR[j * 256 + slot];
            float d0 = 0.f, d1 = 0.f, d2 = 0.f, d3 = 0.f;
            const LAS float* qb = QF4 + j * 512 + kvh * 256;
            if (row < NEWKEY) {
                const float* kr = F.cache_k + ((size_t)row * 2 + kvh) * 64;
                f32x4 kv[16];
#pragma unroll
                for (int c = 0; c < 16; ++c) kv[c] = *(const f32x4*)(kr + c * 4);
#pragma unroll
                for (int c = 0; c < 16; ++c)
#pragma unroll
                    for (int e = 0; e < 4; ++e) { const float kk = kv[c][e]; const int dd = c * 4 + e; d0 += kk * qb[dd]; d1 += kk * qb[64 + dd]; d2 += kk * qb[128 + dd]; d3 += kk * qb[192 + dd]; }
            } else {
                const bf16_t* kr = K + (r0 + (row - NEWKEY)) * 128 + kvh * 64;
#pragma unroll
                for (int c = 0; c < 8; ++c) { float kv[8]; unpack8(*(const u32x4*)(kr + c * 8), kv);
#pragma unroll
                    for (int e = 0; e < 8; ++e) { const float kk = kv[e]; const int dd = c * 8 + e; d0 += kk * qb[dd]; d1 += kk * qb[64 + dd]; d2 += kk * qb[128 + dd]; d3 += kk * qb[192 + dd]; } }
            }
            LAS float* lg = LG4 + j * 2048 + kvh * 1024 + slot;
            lg[0] = d0 * 0.125f; lg[256] = d1 * 0.125f; lg[512] = d2 * 0.125f; lg[768] = d3 * 0.125f;
        }
        __syncthreads();
#pragma unroll 1
        for (int j = 0; j < 4; ++j) {
            LAS float* lr = LG4 + j * 2048 + w * 256;
            float v0 = lr[lane], v1 = lr[64 + lane], v2 = lr[128 + lane], v3 = lr[192 + lane];
            const float mx = wave_max(fmaxf(fmaxf(v0, v1), fmaxf(v2, v3)));
            v0 = __expf(v0 - mx); v1 = __expf(v1 - mx); v2 = __expf(v2 - mx); v3 = __expf(v3 - mx);
            const float inv = 1.0f / wave_sum(v0 + v1 + v2 + v3);
            lr[lane] = v0 * inv; lr[64 + lane] = v1 * inv; lr[128 + lane] = v2 * inv; lr[192 + lane] = v3 * inv;
        }
        __syncthreads();
#pragma unroll 1
        for (int j = 0; j < 4; ++j) {
            float acc[8];
#pragma unroll
            for (int h = 0; h < 8; ++h) acc[h] = 0.f;
#pragma unroll 1
            for (int s0 = 0; s0 < 32; s0 += 16) {
                float v0[16], v1[16];
#pragma unroll
                for (int i = 0; i < 16; ++i) { const int row = SELR[j * 256 + w * 32 + s0 + i];
                    if (row < NEWKEY) { const float* vr = F.cache_v + (size_t)row * 128 + lane; v0[i] = vr[0]; v1[i] = vr[64]; }
                    else { const bf16_t* vr = V + (r0 + (row - NEWKEY)) * 128 + lane; v0[i] = bf2f(vr[0]); v1[i] = bf2f(vr[64]); } }
#pragma unroll
                for (int i = 0; i < 16; ++i) { const int slot = w * 32 + s0 + i;
#pragma unroll
                    for (int h = 0; h < 8; ++h) acc[h] += LG4[j * 2048 + h * 256 + slot] * (h < 4 ? v0[i] : v1[i]); }
            }
#pragma unroll
            for (int h = 0; h < 8; ++h) PV4[(w * 4 + j) * 512 + h * 64 + lane] = acc[h];
        }
        __syncthreads();
#pragma unroll
        for (int j = 0; j < 4; ++j) { float o = 0.f;
#pragma unroll
            for (int ww = 0; ww < 8; ++ww) o += PV4[(ww * 4 + j) * 512 + tid];
            ATT[(r0 + j) * 512 + tid] = (bf16_t)(cvt_pk_bf16(o, 0.f) & 0xffffu); }
        __syncthreads();
    }
}

__device__ __forceinline__ void p4_all(const Frame& F, int rep, int parts) {
    if (parts & 1) p4_vtranspose(F);
    if (parts & 2) p4_conv(F);
    if (parts & 4) { for (int b = F.bid; b < DB; b += F.nblk) p4_sample_unit(F, b); }
    if (!(parts & 8)) return;
    LAS int* qslot = (LAS int*)(F.lds + LDS_MISC + 32);
    __syncthreads();
    if (F.tid == 0) *qslot = (int)__hip_atomic_fetch_add(F.ctl + CW_Q4 + 64 * rep, 1u, __ATOMIC_RELAXED, __HIP_MEMORY_SCOPE_AGENT);
    for (;;) {
        __syncthreads();
        const int u = *qslot;
        if (u >= NB * 32) break;
        p4_prompt_unit(F, u & 31, 31 - (u >> 5), parts, qslot, F.ctl + CW_Q4 + 64 * rep);
    }
}

template <bool FAST> __device__ __forceinline__ void p5_unit_t(const Frame& F, int b, int kvh, int qt, const bf16x8 (&qf)[4], float mq, u32x4 kv, u32x4 vv, u64 mw) {
    const bf16_t* Q = WSP(bf16_t, WS_Q); const bf16_t* K = WSP(bf16_t, WS_K); const bf16_t* VTR = WSP(bf16_t, WS_VTR); const u64* MASK = WSP(u64, WS_MASK); bf16_t* ATT = WSP(bf16_t, WS_ATT);
    LAS unsigned char* Kl = F.lds;
    LAS unsigned char* Vl = F.lds + 64 * 144;
    const int w = F.wave, lane = F.lane, q = lane & 31, half = lane >> 5, tid = F.tid;
    const int g = w & 3, th = w >> 2, head = kvh * 4 + g;
    const size_t rowq = (size_t)b * 2048 + qt * 64 + th * 32 + q;
    f32x16 O0, O1;
#pragma unroll
    for (int i = 0; i < 16; ++i) { O0[i] = 0.f; O1[i] = 0.f; }
    float mrun = -1e30f, lrun = 0.f;
    const int rw = tid >> 3, ch = tid & 7;
    const bf16_t* kgp = K + ((size_t)b * 2048 + rw) * 128 + kvh * 64 + ch * 8;
    const bf16_t* vgp = VTR + ((size_t)((b * 2 + kvh) * 64 + rw)) * 2048 + ch * 8;
    for (int kt = 0; kt <= qt; ++kt) {
        __syncthreads();
        *(LAS u32x4*)(Kl + rw * 144 + ch * 16) = kv;
        *(LAS u32x4*)(Vl + rw * 144 + ch * 16) = vv;
        const u64 mwc = mw;
        __syncthreads();
        { const int kn = kt < qt ? kt + 1 : kt;
          kv = *(const u32x4*)(kgp + (size_t)kn * 64 * 128); vv = *(const u32x4*)(vgp + kn * 64); mw = MASK[rowq * 32 + kn]; }
        f32x16 S[2];
#pragma unroll
        for (int ks = 0; ks < 2; ++ks) {
            f32x16 a;
#pragma unroll
            for (int i = 0; i < 16; ++i) a[i] = FAST ? -mq : 0.f;
#pragma unroll
            for (int s = 0; s < 4; ++s) { const bf16x8 kf = *(const LAS bf16x8*)(Kl + (ks * 32 + q) * 144 + s * 32 + half * 16); a = __builtin_amdgcn_mfma_f32_32x32x16_bf16(kf, qf[s], a, 0, 0, 0); }
            S[ks] = a;
        }
        const u64 mh = mwc >> (4 * half);
        const unsigned mword[2] = {(unsigned)mh, (unsigned)(mh >> 32)};
        if (FAST) {
            float ls = 0.f;
#pragma unroll
            for (int ks = 0; ks < 2; ++ks)
#pragma unroll
                for (int i = 0; i < 16; ++i) { const unsigned keep = (unsigned)__builtin_amdgcn_sbfe((int)mword[ks], 8 * (i >> 2) + (i & 3), 1);
                    const float p = __uint_as_float(__float_as_uint(__builtin_amdgcn_exp2f(S[ks][i])) & keep); S[ks][i] = p; ls += p; }
            lrun += ls;
        } else {
            float mx = -INFINITY;
#pragma unroll
            for (int ks = 0; ks < 2; ++ks)
#pragma unroll
                for (int i = 0; i < 16; ++i) { const bool on = (mword[ks] >> (8 * (i >> 2) + (i & 3))) & 1u; const float sv = on ? S[ks][i] : -INFINITY; S[ks][i] = sv; mx = fmaxf(mx, sv); }
            mx = fmaxf(mx, __shfl_xor(mx, 32));
            const float mnew = fmaxf(mrun, mx);
            const float alpha = __builtin_amdgcn_exp2f(mrun - mnew);
            float ls = 0.f;
#pragma unroll
            for (int ks = 0; ks < 2; ++ks)
#pragma unroll
                for (int i = 0; i < 16; ++i) { const float p = __builtin_amdgcn_exp2f(S[ks][i] - mnew); S[ks][i] = p; ls += p; }
            lrun = lrun * alpha + ls;
            if (__any(mnew != mrun)) {
#pragma unroll
                for (int i = 0; i < 16; ++i) { O0[i] *= alpha; O1[i] *= alpha; } }
            mrun = mnew;
        }
#pragma unroll
        for (int ks = 0; ks < 2; ++ks)
#pragma unroll
            for (int s2 = 0; s2 < 2; ++s2) {
                u32x4 pw; pw.x = cvt_pk_bf16(S[ks][8 * s2 + 0], S[ks][8 * s2 + 1]); pw.y = cvt_pk_bf16(S[ks][8 * s2 + 2], S[ks][8 * s2 + 3]); pw.z = cvt_pk_bf16(S[ks][8 * s2 + 4], S[ks][8 * s2 + 5]); pw.w = cvt_pk_bf16(S[ks][8 * s2 + 6], S[ks][8 * s2 + 7]);
                const bf16x8 pf = __builtin_bit_cast(bf16x8, pw);
                const int kb = (ks * 32 + 16 * s2 + 4 * half) * 2;
                { const u32x2 a = *(const LAS u32x2*)(Vl + q * 144 + kb), c = *(const LAS u32x2*)(Vl + q * 144 + kb + 16);
                  const bf16x8 vf = __builtin_bit_cast(bf16x8, (u32x4){a.x, a.y, c.x, c.y}); O0 = __builtin_amdgcn_mfma_f32_32x32x16_bf16(vf, pf, O0, 0, 0, 0); }
                { const u32x2 a = *(const LAS u32x2*)(Vl + (32 + q) * 144 + kb), c = *(const LAS u32x2*)(Vl + (32 + q) * 144 + kb + 16);
                  const bf16x8 vf = __builtin_bit_cast(bf16x8, (u32x4){a.x, a.y, c.x, c.y}); O1 = __builtin_amdgcn_mfma_f32_32x32x16_bf16(vf, pf, O1, 0, 0, 0); }
            }
    }
    const float inv = 1.0f / (lrun + __shfl_xor(lrun, 32));
    bf16_t* op = ATT + rowq * 512 + head * 64 + 4 * half;
#pragma unroll
    for (int gq = 0; gq < 4; ++gq) {
        u32x2 a; a.x = cvt_pk_bf16(O0[4 * gq] * inv, O0[4 * gq + 1] * inv); a.y = cvt_pk_bf16(O0[4 * gq + 2] * inv, O0[4 * gq + 3] * inv); *(u32x2*)(op + 8 * gq) = a;
        u32x2 c; c.x = cvt_pk_bf16(O1[4 * gq] * inv, O1[4 * gq + 1] * inv); c.y = cvt_pk_bf16(O1[4 * gq + 2] * inv, O1[4 * gq + 3] * inv); *(u32x2*)(op + 32 + 8 * gq) = c;
    }
}
__device__ __forceinline__ void p5_unit_fast(const Frame& F, int b, int kvh, int qt, const bf16x8 (&qf)[4], float mq, u32x4 kv, u32x4 vv, u32x4 kv1, u32x4 vv1, u64 mcur, u64 mnxt) {
    const bf16_t* K = WSP(bf16_t, WS_K); const bf16_t* VTR = WSP(bf16_t, WS_VTR); const u64* MASK = WSP(u64, WS_MASK); bf16_t* ATT = WSP(bf16_t, WS_ATT);
    LAS unsigned char* Kl = F.lds;
    LAS unsigned char* Vl = F.lds + 3 * 64 * 144;
    const int w = F.wave, lane = F.lane, q = lane & 31, half = lane >> 5, tid = F.tid;
    const int g = w & 3, th = w >> 2, head = kvh * 4 + g;
    const size_t rowq = (size_t)b * 2048 + qt * 64 + th * 32 + q;
    f32x16 O0, O1, L;
#pragma unroll
    for (int i = 0; i < 16; ++i) { O0[i] = 0.f; O1[i] = 0.f; L[i] = 0.f; }
    bf16x8 ones;
    { u32x4 o; o.x = o.y = o.z = o.w = 0x3F803F80u; asm volatile("" : "+v"(o)); ones = __builtin_bit_cast(bf16x8, o); }
    const int rw = tid >> 3, ch = tid & 7, nt = qt + 1;
    const int vwo = (ch >> 1) * 32 + (ch & 1) * 8;
    const bf16_t* kgp = K + ((size_t)b * 2048 + rw) * 128 + kvh * 64 + ch * 8;
    const bf16_t* vgp = VTR + ((size_t)((b * 2 + kvh) * 64 + rw)) * 2048 + ch * 8;
    const int k2 = nt > 2 ? 2 : 0;
    __syncthreads();
    *(LAS u32x4*)(Kl + rw * 144 + ch * 16) = kv; *(LAS u32x2*)(Vl + rw * 144 + vwo) = (u32x2){vv.x, vv.y}; *(LAS u32x2*)(Vl + rw * 144 + vwo + 16) = (u32x2){vv.z, vv.w};
    *(LAS u32x4*)(Kl + 9216 + rw * 144 + ch * 16) = kv1; *(LAS u32x2*)(Vl + 9216 + rw * 144 + vwo) = (u32x2){vv1.x, vv1.y}; *(LAS u32x2*)(Vl + 9216 + rw * 144 + vwo + 16) = (u32x2){vv1.z, vv1.w};
    __syncthreads();
    const int k3 = nt > 3 ? 3 : 0;
    kv = *(const u32x4*)(kgp + (size_t)k2 * 64 * 128); vv = *(const u32x4*)(vgp + k2 * 64);
    u32x4 kvB = *(const u32x4*)(kgp + (size_t)k3 * 64 * 128), vvB = *(const u32x4*)(vgp + k3 * 64);
    int ob0 = 0, ob1 = 9216, ob2 = 18432;
    f32x16 SA[2], SB[2];
#pragma unroll
    for (int ks = 0; ks < 2; ++ks) {
        f32x16 a;
#pragma unroll
        for (int i = 0; i < 16; ++i) a[i] = 0.f;
#pragma unroll
        for (int s = 0; s < 4; ++s) { const bf16x8 kf = *(const LAS bf16x8*)(Kl + (ks * 32 + q) * 144 + s * 32 + half * 16); a = __builtin_amdgcn_mfma_f32_32x32x16_bf16(kf, qf[s], a, 0, 0, 0); }
        SA[ks] = a;
    }
    auto tile = [&](f32x16 (&Sc)[2], f32x16 (&Sn)[2], u32x4& kv, u32x4& vv, u64& mk, const int kt) __attribute__((always_inline)) {
        *(LAS u32x4*)(Kl + ob2 + rw * 144 + ch * 16) = kv; *(LAS u32x2*)(Vl + ob2 + rw * 144 + vwo) = (u32x2){vv.x, vv.y}; *(LAS u32x2*)(Vl + ob2 + rw * 144 + vwo + 16) = (u32x2){vv.z, vv.w};
        { const int kn = kt + 4 < nt ? kt + 4 : kt;
          kv = *(const u32x4*)(kgp + (size_t)kn * 64 * 128); vv = *(const u32x4*)(vgp + kn * 64); }
        bf16x8 kf[9];
        const LAS unsigned char* kfb = Kl + ob1 + q * 144 + half * 16;
        kf[0] = *(const LAS bf16x8*)kfb;
        const u64 mh = mk >> (4 * half);
        const unsigned mword[2] = {(unsigned)mh, (unsigned)(mh >> 32)};
        mk = MASK[rowq * 32 + (kt + 2 < nt ? kt + 2 : kt)];
#pragma unroll
        for (int i = 0; i < 16; ++i) { Sn[0][i] = 0.f; Sn[1][i] = 0.f; }
#pragma unroll
        for (int j = 0; j < 8; ++j) {
            const int ks = j & 1, s = j >> 1;
            if (j < 7) kf[j + 1] = *(const LAS bf16x8*)(kfb + ((j + 1) & 1) * 32 * 144 + ((j + 1) >> 1) * 32);
            Sn[ks] = __builtin_amdgcn_mfma_f32_32x32x16_bf16(kf[j], qf[s], Sn[ks], 0, 0, 0);
            const int eks = j >> 2;
#pragma unroll
            for (int e = 0; e < 4; ++e) { const int i = (j & 3) * 4 + e;
                unsigned keep;
                asm("v_bfe_i32 %0, %1, %2, 1" : "=v"(keep) : "v"(mword[eks]), "n"(8 * (i >> 2) + (i & 3)));
                Sc[eks][i] = __uint_as_float(__float_as_uint(__builtin_amdgcn_exp2f(Sc[eks][i])) & keep); }
            __builtin_amdgcn_sched_barrier(0);
        }
#pragma unroll
        for (int ks = 0; ks < 2; ++ks)
#pragma unroll
            for (int s2 = 0; s2 < 2; ++s2) {
                u32x4 pw; pw.x = cvt_pk_bf16(Sc[ks][8 * s2 + 0], Sc[ks][8 * s2 + 1]); pw.y = cvt_pk_bf16(Sc[ks][8 * s2 + 2], Sc[ks][8 * s2 + 3]); pw.z = cvt_pk_bf16(Sc[ks][8 * s2 + 4], Sc[ks][8 * s2 + 5]); pw.w = cvt_pk_bf16(Sc[ks][8 * s2 + 6], Sc[ks][8 * s2 + 7]);
                const bf16x8 pf = __builtin_bit_cast(bf16x8, pw);
                const int kb = (ks * 2 + s2) * 32 + half * 16;
                const LAS unsigned char* vb = Vl + ob0;
                { const bf16x8 vf = *(const LAS bf16x8*)(vb + q * 144 + kb); O0 = __builtin_amdgcn_mfma_f32_32x32x16_bf16(vf, pf, O0, 0, 0, 0); }
                { const bf16x8 vf = *(const LAS bf16x8*)(vb + (32 + q) * 144 + kb); O1 = __builtin_amdgcn_mfma_f32_32x32x16_bf16(vf, pf, O1, 0, 0, 0); }
                L = __builtin_amdgcn_mfma_f32_32x32x16_bf16(ones, pf, L, 0, 0, 0);
            }
        { const int t = ob0; ob0 = ob1; ob1 = ob2; ob2 = t; }
        asm volatile("s_waitcnt lgkmcnt(0)" ::: "memory");
        __builtin_amdgcn_s_barrier();
        asm volatile("" ::: "memory");
    };
    int kt = 0;
    for (; kt + 1 < nt; kt += 2) { tile(SA, SB, kv, vv, mcur, kt); tile(SB, SA, kvB, vvB, mnxt, kt + 1); }
    if (kt < nt) tile(SA, SB, kv, vv, mcur, kt);
    const float inv = 1.0f / L[0];
    bf16_t* op = ATT + rowq * 512 + head * 64 + 4 * half;
#pragma unroll
    for (int gq = 0; gq < 4; ++gq) {
        u32x2 a; a.x = cvt_pk_bf16(O0[4 * gq] * inv, O0[4 * gq + 1] * inv); a.y = cvt_pk_bf16(O0[4 * gq + 2] * inv, O0[4 * gq + 3] * inv); *(u32x2*)(op + 8 * gq) = a;
        u32x2 c; c.x = cvt_pk_bf16(O1[4 * gq] * inv, O1[4 * gq + 1] * inv); c.y = cvt_pk_bf16(O1[4 * gq + 2] * inv, O1[4 * gq + 3] * inv); *(u32x2*)(op + 32 + 8 * gq) = c;
    }
}
__device__ __forceinline__ void p5_unit(const Frame& F, int b, int kvh, int qt, float kbound) {
    const bf16_t* Q = WSP(bf16_t, WS_Q);
    const int w = F.wave, lane = F.lane, q = lane & 31, half = lane >> 5;
    const int g = w & 3, th = w >> 2, head = kvh * 4 + g;
    const size_t rowq = (size_t)b * 2048 + qt * 64 + th * 32 + q;
    bf16x8 qf[4]; float qs = 0.f;
    u32x4 qraw[4];
#pragma unroll
    for (int s = 0; s < 4; ++s) qraw[s] = *(const u32x4*)(Q + rowq * 512 + head * 64 + s * 16 + half * 8);
    const int rw0 = F.tid >> 3, ch0 = F.tid & 7, k1 = qt > 0 ? 1 : 0;
    const bf16_t* kgp0 = WSP(bf16_t, WS_K) + ((size_t)b * 2048 + rw0) * 128 + kvh * 64 + ch0 * 8;
    const bf16_t* vgp0 = WSP(bf16_t, WS_VTR) + ((size_t)((b * 2 + kvh) * 64 + rw0)) * 2048 + ch0 * 8;
    const u32x4 kv0 = *(const u32x4*)kgp0, vv0 = *(const u32x4*)vgp0;
    const u32x4 kv1 = *(const u32x4*)(kgp0 + (size_t)k1 * 64 * 128), vv1 = *(const u32x4*)(vgp0 + k1 * 64);
    const u64 m0 = WSP(u64, WS_MASK)[rowq * 32], m1 = WSP(u64, WS_MASK)[rowq * 32 + k1];
#pragma unroll
    for (int s = 0; s < 4; ++s) { float t8[8]; unpack8(qraw[s], t8);
#pragma unroll
        for (int e = 0; e < 8; ++e) t8[e] *= 0.125f * 1.4426950408889634f;
        const u32x4 pk = pack8(t8); qf[s] = __builtin_bit_cast(bf16x8, pk);
        float r8[8]; unpack8(pk, r8);
#pragma unroll
        for (int e = 0; e < 8; ++e) qs += r8[e] * r8[e]; }
    qs += __shfl_xor(qs, 32);
    const float mq = sqrtf(qs) * kbound;
    LAS int* slowflag = (LAS int*)(F.lds + LDS_MISC + 40);
    if (__any(!(mq <= 40.0f)) && lane == 0) *slowflag = 1;
    __syncthreads();
    if (__builtin_amdgcn_readfirstlane(*slowflag) == 0) p5_unit_fast(F, b, kvh, qt, qf, mq, kv0, vv0, kv1, vv1, m0, m1);
    else p5_unit_t<false>(F, b, kvh, qt, qf, 0.f, kv0, vv0, m0);
}
__device__ __forceinline__ void p5_all(const Frame& F, int rep) {
    const float kbound = 8.1f * wave_max(fabsf(F.k_norm_w[F.lane]));

    LAS int* qslot = (LAS int*)(F.lds + LDS_MISC + 32);
    const int xq = blockIdx.x & 7;
    int unext = 0;
    if (F.tid == 0) unext = (int)__hip_atomic_fetch_add(F.ctl + CW_Q5 + 64 * (xq + 8 * rep), 1u, __ATOMIC_RELAXED, __HIP_MEMORY_SCOPE_AGENT);
    for (;;) {
        __syncthreads();
        if (F.tid == 0) { *qslot = unext; qslot[2] = 0; }
        __syncthreads();
        const int u = *qslot;
        if (u >= 4 * 2 * 32) break;
        if (F.tid == 0) unext = (int)__hip_atomic_fetch_add(F.ctl + CW_Q5 + 64 * (xq + 8 * rep), 1u, __ATOMIC_RELAXED, __HIP_MEMORY_SCOPE_AGENT);
        p5_unit(F, 4 * xq + ((u >> 1) & 3), u & 1, 31 - (u >> 3), kbound);
    }
}

__device__ __forceinline__ void ce_desc(unsigned& a, unsigned& b) { const unsigned hi = a > b ? a : b, lo = a > b ? b : a; a = hi; b = lo; }
__device__ __forceinline__ void sort16_desc(unsigned (&a)[16]) {
#pragma unroll
    for (int k = 2; k <= 16; k <<= 1)
#pragma unroll
        for (int j = k >> 1; j > 0; j >>= 1)
#pragma unroll
            for (int i = 0; i < 16; ++i) { const int l = i ^ j; if (l > i) { if ((i & k) == 0) ce_desc(a[i], a[l]); else ce_desc(a[l], a[i]); } }
}
__device__ __forceinline__ void merge_top16(unsigned (&L)[16], const unsigned (&N)[16]) {
#pragma unroll
    for (int i = 0; i < 16; ++i) L[i] = L[i] > N[15 - i] ? L[i] : N[15 - i];
#pragma unroll
    for (int j = 8; j > 0; j >>= 1)
#pragma unroll
        for (int i = 0; i < 16; ++i) { const int l = i ^ j; if (l > i) ce_desc(L[i], L[l]); }
}
__device__ __forceinline__ unsigned mono16(unsigned h) { return (h & 0x8000u) ? (~h & 0xffffu) : (h | 0x8000u); }
__device__ __forceinline__ float unmono16(unsigned k) { const unsigned h = (k & 0x8000u) ? (k & 0x7fffu) : (~k & 0xffffu); return (float)__builtin_bit_cast(_Float16, (unsigned short)h); }
__device__ __forceinline__ void p11_select(const Frame& F) {
    const unsigned short* PST = WSP(unsigned short, WS_SCR); int* EIDX = WSP(int, WS_EIDX); float* G = WSP(float, WS_G);
    LAS unsigned char* TILE = F.lds;
    LAS unsigned* LST = (LAS unsigned*)F.lds;
    const int tid = F.tid;
    for (int unit = F.bid; unit < 258 * 8; unit += F.nblk) {
        const int pm = unit >> 3, h = unit & 7;
        const int row = tid & 255, p = tid >> 8;
        __syncthreads();
#pragma unroll
        for (int i = 0; i < 16; ++i) { const int e = tid + 512 * i, rw = e >> 5, ch = e & 31;
            *(LAS u32x4*)(TILE + rw * 528 + ch * 16) = *(const u32x4*)(PST + (size_t)unit * 65536 + rw * 256 + ch * 8); }
        __syncthreads();
        unsigned L[16];
#pragma unroll 1
        for (int k0 = 0; k0 < 128; k0 += 16) {
            const u32x4 a = *(const LAS u32x4*)(TILE + row * 528 + p * 256 + k0 * 2), b = *(const LAS u32x4*)(TILE + row * 528 + p * 256 + k0 * 2 + 16);
            const unsigned wv[8] = {a.x, a.y, a.z, a.w, b.x, b.y, b.z, b.w};
            unsigned N[16];
#pragma unroll
            for (int e = 0; e < 8; ++e) { N[2 * e] = (mono16(wv[e] & 0xffffu) << 16) | (unsigned)(127 - (k0 + 2 * e)); N[2 * e + 1] = (mono16(wv[e] >> 16) << 16) | (unsigned)(127 - (k0 + 2 * e + 1)); }
            sort16_desc(N);
            if (k0 == 0) {
#pragma unroll
                for (int e = 0; e < 16; ++e) L[e] = N[e];
            } else merge_top16(L, N);
        }
        __syncthreads();
#pragma unroll
        for (int q = 0; q < 16; ++q) LST[tid * 17 + q] = L[q];
        __syncthreads();
        if (tid < 256) {
            unsigned L2[16];
#pragma unroll
            for (int q = 0; q < 16; ++q) L2[q] = LST[(tid + 256) * 17 + q];
            float s1[16], s2[16];
#pragma unroll
            for (int q = 0; q < 16; ++q) { s1[q] = unmono16(L[q] >> 16); s2[q] = unmono16(L2[q] >> 16); }
            unsigned C[16], N[16]; int nn = 0; bool first = true;
#pragma unroll
            for (int i = 0; i < 16; ++i)
#pragma unroll
                for (int j = 0; j < 16; ++j)
                    if ((i + 1) * (j + 1) <= 16) {
                        N[nn++] = (mono(s1[i] + s2[j]) & ~255u) | (unsigned)(255 - (i * 16 + j));
                        if (nn == 16) { sort16_desc(N); if (first) {
#pragma unroll
                                for (int e = 0; e < 16; ++e) C[e] = N[e];
                                first = false; } else merge_top16(C, N); nn = 0; }
                    }
            {
#pragma unroll
                for (int e = 2; e < 16; ++e) N[e] = 0u;
                sort16_desc(N); merge_top16(C, N); }
            float sv[16]; int ev[16]; float mx = -INFINITY;
#pragma unroll
            for (int q = 0; q < 16; ++q) { const int pos = 255 - (int)(C[q] & 255u); const int i = pos >> 4, j = pos & 15;
                const unsigned k1 = LST[tid * 17 + i], k2 = LST[(tid + 256) * 17 + j];
                ev[q] = (127 - (int)(k1 & 127u)) * 128 + (127 - (int)(k2 & 127u));
                sv[q] = unmono16(k1 >> 16) + unmono16(k2 >> 16); mx = fmaxf(mx, sv[q]); }
            float sum = 0.f;
#pragma unroll
            for (int q = 0; q < 16; ++q) { sv[q] = __expf(sv[q] - mx); sum += sv[q]; }
            const float inv = 1.0f / sum;
            const size_t ob = ((size_t)(pm * 256 + row) * 8 + h) * 16;
#pragma unroll
            for (int q4 = 0; q4 < 4; ++q4) {
                *(int4*)(EIDX + ob + q4 * 4) = make_int4(ev[q4 * 4], ev[q4 * 4 + 1], ev[q4 * 4 + 2], ev[q4 * 4 + 3]);
                *(f32x4*)(G + ob + q4 * 4) = (f32x4){sv[q4 * 4] * inv, sv[q4 * 4 + 1] * inv, sv[q4 * 4 + 2] * inv, sv[q4 * 4 + 3] * inv}; }
        }
    }
}

typedef float f32x2v __attribute__((ext_vector_type(2)));
typedef __bf16 bf2_t __attribute__((ext_vector_type(2)));
__device__ __forceinline__ float dpp_add_xor1(float x) { return x + __uint_as_float(__builtin_amdgcn_update_dpp(0u, __float_as_uint(x), 0xB1, 0xF, 0xF, true)); }
__device__ __forceinline__ float dpp_add_xor2(float x) { return x + __uint_as_float(__builtin_amdgcn_update_dpp(0u, __float_as_uint(x), 0x4E, 0xF, 0xF, true)); }
__device__ __forceinline__ float dpp_add_hmir(float x) { return x + __uint_as_float(__builtin_amdgcn_update_dpp(0u, __float_as_uint(x), 0x141, 0xF, 0xF, true)); }

constexpr int P12A_TB_ = 48;
__device__ __forceinline__ void p12a_entry(const u32x4 (&rows)[8], int ent, const LAS unsigned char* H2L, int l8, float* ACT, int tb) {
    const int tl = (ent >> 21) & 63, slot = (ent >> 14) & 127;
    const LAS unsigned char* hp = H2L + tl * 2080 + l8 * 32;
    float acc = 0.f;
#pragma unroll
    for (int j = 0; j < 8; ++j) {
        const u32x4 ha = *(const LAS u32x4*)(hp + j * 256), hb = *(const LAS u32x4*)(hp + j * 256 + 16);
        const unsigned hw[8] = {ha.x, ha.y, ha.z, ha.w, hb.x, hb.y, hb.z, hb.w};
        const unsigned uw[4] = {rows[j].x, rows[j].y, rows[j].z, rows[j].w};
#pragma unroll
        for (int k = 0; k < 4; ++k) {
            acc = __builtin_amdgcn_fdot2_f32_bf16(__builtin_amdgcn_cvt_scalef32_pk_bf16_fp8(uw[k], 1.0f, false), __builtin_bit_cast(bf2_t, hw[2 * k]), acc, false);
            acc = __builtin_amdgcn_fdot2_f32_bf16(__builtin_amdgcn_cvt_scalef32_pk_bf16_fp8(uw[k], 1.0f, true), __builtin_bit_cast(bf2_t, hw[2 * k + 1]), acc, false); }
    }
    acc = dpp_add_hmir(dpp_add_xor2(dpp_add_xor1(acc)));
    if (l8 == 0 && ent >= 0) ACT[((size_t)tb * P12A_TB_ + tl) * 128 + slot] = acc;
}

constexpr int P12A_TB = 48, P12A_HSTRIDE = 2080;
__device__ __forceinline__ void p12a_act(const Frame& F, int probe) {
    const unsigned char* H2 = WSP(unsigned char, WS_H); const int* EIDX = WSP(int, WS_EIDX); const unsigned char* UT = WSP(unsigned char, WS_UT); float* ACT = (probe & 64) ? WSP(float, WS_SCR) : WSP(float, WS_ACT);
    const int emask = (probe & 64) ? 0x38ff : 0x3fff;
    LAS unsigned char* H2L = F.lds;
    LAS int* LSTL = (LAS int*)(F.lds + P12A_TB * P12A_HSTRIDE);
    LAS int* CTR = (LAS int*)(F.lds + P12A_TB * P12A_HSTRIDE + 6144 * 4);
    const int lane = F.lane, w = F.wave, tid = F.tid, g = lane >> 3, l8 = lane & 7;
    const bool part = (F.nblk & 7) == 0;
    const int xv = part ? (F.bid & 7) : 0, r = part ? (F.bid >> 3) : F.bid, nr = part ? (F.nblk >> 3) : F.nblk, npass = part ? 1 : 8;
    for (int pass = 0; pass < npass; ++pass) {
        const int v = xv * npass + pass;
        for (int tb = r; tb < T / P12A_TB; tb += nr) {
            u32x4 hreg[12]; int eAs[6], eBs[6];
#pragma unroll
            for (int i = 0; i < 12; ++i) { const int e_ = tid + 512 * i, row = e_ >> 7, ch = e_ & 127; hreg[i] = *(const u32x4*)(H2 + ((size_t)(tb * P12A_TB + row)) * 2048 + ch * 16); }
#pragma unroll
            for (int i = 0; i < 6; ++i) { const size_t t = (size_t)tb * P12A_TB + 6 * w + i; eAs[i] = EIDX[t * 128 + lane]; eBs[i] = EIDX[t * 128 + 64 + lane]; }
            __syncthreads();
            if (tid == 0) *CTR = 0;
#pragma unroll
            for (int i = 0; i < 12; ++i) { const int e_ = tid + 512 * i, row = e_ >> 7, ch = e_ & 127; *(LAS u32x4*)(H2L + row * P12A_HSTRIDE + ch * 16) = hreg[i]; }
            __syncthreads();
#pragma unroll
            for (int i = 0; i < 6; ++i) {
                const int tl = 6 * w + i; const int eA = eAs[i], eB = eBs[i];
                const bool onA = (eA >> 11) == v, onB = (eB >> 11) == v;
                const u64 mA = __ballot(onA), mB = __ballot(onB);
                const int nA = __popcll(mA), cnt = nA + __popcll(mB);
                int base = 0;
                if (lane == 0 && cnt > 0) base = __hip_atomic_fetch_add(CTR, cnt, __ATOMIC_RELAXED, __HIP_MEMORY_SCOPE_WORKGROUP);
                base = __builtin_amdgcn_readfirstlane(base);
                if (onA) LSTL[base + mbcnt64(mA)] = (tl << 21) | (lane << 14) | eA;
                if (onB) LSTL[base + nA + mbcnt64(mB)] = (tl << 21) | ((64 + lane) << 14) | eB;
            }
            __syncthreads();
            const int total = *CTR;
            const int nsteps = (total + 7) >> 3;
#define P12A_ENT(s_) ({ const int ix_ = (s_) * 8 + g; ix_ < total ? LSTL[ix_] : -1; })
#define P12A_ROWS(dst, ent_) do { const unsigned char* rp_ = UT + (size_t)((ent_) & emask) * 1024 + l8 * 16; \
        _Pragma("unroll") for (int j_ = 0; j_ < 8; ++j_) dst[j_] = *(const u32x4*)(rp_ + j_ * 128); } while (0)
            int s = w;
            if (s < nsteps) {
                int e0 = P12A_ENT(s), e1 = P12A_ENT(s + 8);
                u32x4 ra[8], rb[8];
                P12A_ROWS(ra, e0);
                for (;;) {
                    P12A_ROWS(rb, e1);
                    const int e2 = P12A_ENT(s + 16);
                    __builtin_amdgcn_sched_barrier(0);
                    p12a_entry(ra, e0, H2L, l8, ACT, tb);
                    s += 8; if (s >= nsteps) break;
                    P12A_ROWS(ra, e2);
                    const int e3 = P12A_ENT(s + 16);
                    __builtin_amdgcn_sched_barrier(0);
                    p12a_entry(rb, e1, H2L, l8, ACT, tb);
                    s += 8; if (s >= nsteps) break;
                    e0 = e2; e1 = e3;
                }
            }
#undef P12A_ENT
#undef P12A_ROWS
        }
    }
}

__device__ __forceinline__ void p12c_coef(const Frame& F) {
    const int* EIDX = WSP(int, WS_EIDX); const float* G = WSP(float, WS_G); const float* ACT = WSP(float, WS_ACT); const float* USC = WSP(float, WS_TSC); const float* VSC = WSP(float, WS_TSC) + 16384;
    u64* META = WSP(u64, WS_METAG);
    const size_t gt = (size_t)F.bid * 512 + F.tid, gn = (size_t)F.nblk * 512;
    size_t i = gt;
    for (; i + 3 * gn < (size_t)T * 128; i += 4 * gn) {
        int e[4]; float gg[4], aa[4], us[4], vs[4];
#pragma unroll
        for (int k = 0; k < 4; ++k) { e[k] = EIDX[i + k * gn]; gg[k] = G[i + k * gn]; aa[k] = ACT[i + k * gn]; }
#pragma unroll
        for (int k = 0; k < 4; ++k) { us[k] = USC[e[k]]; vs[k] = VSC[e[k]]; }
#pragma unroll
        for (int k = 0; k < 4; ++k) { const float c = gg[k] * gelu_tanh(aa[k] * us[k]) * vs[k]; META[i + k * gn] = (u64)(unsigned)e[k] | ((u64)__float_as_uint(c) << 32); }
    }
    for (; i < (size_t)T * 128; i += gn) { const int e = EIDX[i]; const float c = G[i] * gelu_tanh(ACT[i] * USC[e]) * VSC[e];
        META[i] = (u64)(unsigned)e | ((u64)__float_as_uint(c) << 32); }
}

__device__ __forceinline__ void p12b_out(const Frame& F) {
    const u64* METAG = WSP(u64, WS_METAG); const unsigned char* VT2 = WSP(unsigned char, WS_VT2); const float* MOD = WSP(float, WS_MOD); const bf16_t* Dm = WSP(bf16_t, WS_X1);
    const int lane = F.lane, w = F.wave, g = lane >> 3, l8 = lane & 7;
    LAS u64* META = (LAS u64*)(F.lds + w * 16384);
    const bool part = (F.nblk & 7) == 0;
    const int xv = part ? (F.bid & 7) : 0, r = part ? (F.bid >> 3) : F.bid, nr = part ? (F.nblk >> 3) : F.nblk, npass = part ? 1 : 8;
    const int qstride = nr * 8, nq = T / 8;
    for (int pass = 0; pass < npass; ++pass) {
        const int v = xv * npass + pass;
        const unsigned char* vbase = VT2 + v * 128 + l8 * 16;
        int q = r * 8 + w, buf = 0;
        if (q < nq) {
#pragma unroll
            for (int i = 0; i < 16; ++i) META[i * 64 + lane] = METAG[(size_t)q * 1024 + i * 64 + lane];
        }
        for (; q < nq; q += qstride) {
            const int qn = q + qstride;
            if (qn < nq) {
#pragma unroll
                for (int i = 0; i < 8; ++i) __builtin_amdgcn_global_load_lds((const unsigned*)((const unsigned char*)METAG + (size_t)qn * 8192 + i * 1024 + lane * 16), (LAS unsigned*)((LAS unsigned char*)(META + (buf ^ 1) * 1024) + i * 1024), 16, 0, 0); }
            const LAS u64* mp = META + buf * 1024 + g * 128;
            f32x2v acc[8];
#pragma unroll
            for (int k = 0; k < 8; ++k) acc[k] = (f32x2v){0.f, 0.f};
            u32x4 pa[16], pb[16];
            const LAS unsigned* mw = (const LAS unsigned*)mp;
#define P12B_LOAD(dst, c_) do { _Pragma("unroll") for (int i_ = 0; i_ < 16; ++i_) dst[i_] = *(const u32x4*)(vbase + (size_t)(mw[2 * ((c_) * 16 + i_)] & 0x3fffu) * 1024); } while (0)
#define P12B_FMA(srcb, c_) do { _Pragma("unroll") for (int i_ = 0; i_ < 16; ++i_) { const u32x4 p_ = srcb[i_]; const int wv_[4] = {(int)p_.x, (int)p_.y, (int)p_.z, (int)p_.w}; \
        const float cfv_ = __uint_as_float(mw[2 * ((c_) * 16 + i_) + 1]); const f32x2v cc_ = (f32x2v){cfv_, cfv_}; \
        _Pragma("unroll") for (int k_ = 0; k_ < 4; ++k_) { acc[2 * k_] += cc_ * __builtin_amdgcn_cvt_pk_f32_fp8(wv_[k_], false); acc[2 * k_ + 1] += cc_ * __builtin_amdgcn_cvt_pk_f32_fp8(wv_[k_], true); } } } while (0)
            P12B_LOAD(pa, 0);
#pragma unroll 1
            for (int cc = 0; cc < 3; ++cc) { P12B_LOAD(pb, 2 * cc + 1); P12B_FMA(pa, 2 * cc); P12B_LOAD(pa, 2 * cc + 2); P12B_FMA(pb, 2 * cc + 1); }
            P12B_LOAD(pb, 7); P12B_FMA(pa, 6); P12B_FMA(pb, 7);
#undef P12B_LOAD
#undef P12B_FMA
            { const size_t t = (size_t)q * 8 + g; const int c0 = v * 128 + l8 * 16;
              const float* xr = (t < (size_t)TP ? F.x_prompt + t * 1024 : F.x_sample + (t - TP) * 1024) + c0; const bf16_t* dr = Dm + t * 1024 + c0;
              const float* g2 = MOD + (size_t)mod_row((int)t) * NMOD + 5 * 1024 + c0; float* yr = F.out + t * 1024 + c0;
#pragma unroll
              for (int k = 0; k < 4; ++k) { const u32x2 dv = *(const u32x2*)(dr + 4 * k); const f32x4 xv4 = *(const f32x4*)(xr + 4 * k) + (f32x4){bf_lo(dv.x), bf_hi(dv.x), bf_lo(dv.y), bf_hi(dv.y)}, gv4 = *(const f32x4*)(g2 + 4 * k);
                  *(f32x4*)(yr + 4 * k) = xv4 + gv4 * (f32x4){acc[2 * k].x, acc[2 * k].y, acc[2 * k + 1].x, acc[2 * k + 1].y}; } }
            asm volatile("s_waitcnt vmcnt(0)" ::: "memory");
            buf ^= 1;
        }
    }
}


#ifndef SELF_CHECK
#define SELF_CHECK 0
#endif
#if SELF_CHECK
__device__ __forceinline__ void chk_fail(const Frame& F, size_t off) { F.out[off] = __uint_as_float(0x7fc00000u); }
__device__ __forceinline__ void self_check_mask(const Frame& F) {
    if (F.bid >= 18 || F.wave != 0) return;
    const int bs[3] = {0, 13, 31}; const int ts[6] = {255, 256, 300, 777, 1500, 2047};
    const int b = bs[F.bid / 6], t = ts[F.bid % 6], n = t + 1;
    const float* sc = WSP(float, WS_SCR) + ((size_t)b * 2048 + t) * 2048; const u64* mk = WSP(u64, WS_MASK) + ((size_t)b * 2048 + t) * 32;
    int bad = 0;
    for (int s = F.lane; s < 2048; s += 64) {
        bool sel = false;
        if (s < n) { const float v = sc[s]; int cnt = 0; for (int s2 = 0; s2 < n; ++s2) { const float v2 = sc[s2]; cnt += (v2 > v || (v2 == v && s2 < s)) ? 1 : 0; } sel = cnt < 256; }
        const bool got = (mk[s >> 6] >> (s & 63)) & 1ull;
        bad += (sel != got) ? 1 : 0;
    }
    if (__ballot(bad != 0) != 0ull && F.lane == 0) chk_fail(F, OFF_KP);
}
__device__ __forceinline__ void self_check_attn(const Frame& F) {
    if (F.bid >= 18) return;
    const int bs[3] = {0, 13, 31}; const int ts[6] = {0, 255, 256, 300, 1500, 2047};
    const int b = bs[F.bid / 6], t = ts[F.bid % 6], head = F.wave, kvh = head >> 2;
    const bf16_t* Q = WSP(bf16_t, WS_Q); const bf16_t* K = WSP(bf16_t, WS_K); const bf16_t* V = WSP(bf16_t, WS_V); const bf16_t* ATT = WSP(bf16_t, WS_ATT);
    const u64* mk = WSP(u64, WS_MASK) + ((size_t)b * 2048 + t) * 32;
    const size_t rq = (size_t)b * 2048 + t;
    float mx = -INFINITY;
    for (int s = F.lane; s <= t; s += 64) if ((mk[s >> 6] >> (s & 63)) & 1ull) { float d = 0.f; for (int e = 0; e < 64; ++e) d += bf2f(Q[rq * 512 + head * 64 + e]) * bf2f(K[((size_t)b * 2048 + s) * 128 + kvh * 64 + e]); mx = fmaxf(mx, d * 0.125f); }
    mx = wave_max(mx);
    float o[64]; float l = 0.f;
#pragma unroll
    for (int e = 0; e < 64; ++e) o[e] = 0.f;
    for (int s = F.lane; s <= t; s += 64) if ((mk[s >> 6] >> (s & 63)) & 1ull) { float d = 0.f; for (int e = 0; e < 64; ++e) d += bf2f(Q[rq * 512 + head * 64 + e]) * bf2f(K[((size_t)b * 2048 + s) * 128 + kvh * 64 + e]);
        const float p = __expf(d * 0.125f - mx); l += p;
#pragma unroll
        for (int e = 0; e < 64; ++e) o[e] += p * bf2f(V[((size_t)b * 2048 + s) * 128 + kvh * 64 + e]); }
    l = wave_sum(l); float err = 0.f, mag = 0.f;
#pragma unroll
    for (int e = 0; e < 64; ++e) { const float r = wave_sum(o[e]) / l; const float gts = bf2f(ATT[rq * 512 + head * 64 + e]); err = fmaxf(err, fabsf(r - gts)); mag = fmaxf(mag, fabsf(r)); }
    if (!(err <= 0.03f * mag + 2e-3f) && F.lane == 0) chk_fail(F, OFF_VP);
}
__device__ __forceinline__ void self_check_peer(const Frame& F) {
    if (F.bid >= 6) return;
    const int tsamp[6] = {0, 1000, 40000, 65535, 65536, 66047};
    const int t = tsamp[F.bid], tid = F.tid;
    const bf16_t* H2 = WSP(bf16_t, WS_H); const int* EIDX = WSP(int, WS_EIDX); const float* G = WSP(float, WS_G);
    const bf16_t* Dm = WSP(bf16_t, WS_X1); const float* MOD = WSP(float, WS_MOD);
    LAS float* S = (LAS float*)F.lds;
    LAS int* REF = (LAS int*)(F.lds + 8192);
    LAS float* CO = (LAS float*)(F.lds + 8192 + 512);
    LAS int* CNTW = (LAS int*)(F.lds + 8192 + 1024);
    LAS float* QF = (LAS float*)(F.lds + 16384);
#pragma unroll 1
    for (int i = tid; i < 2048; i += 512) { float d = 0.f;
#pragma unroll 1
        for (int k = 0; k < 1024; ++k) d += bf2f(H2[(size_t)t * 1024 + k]) * F.peer_w_q[(size_t)k * 2048 + i];
        QF[i] = d; }
    __syncthreads();
    for (int i = tid; i < 2048; i += 512) { const int hp = i >> 7, key = i & 127, h = hp >> 1, p = hp & 1; float d = 0.f;
        for (int e = 0; e < 128; ++e) d += QF[h * 256 + p * 128 + e] * F.peer_sub_keys[(((size_t)p * 8 + h) * 128 + key) * 128 + e];
        S[i] = d; }
    if (tid == 0) *CNTW = 0;
    __syncthreads();
    if (tid < 8) { const int h = tid; int i1[16], i2[16]; float s1[16], s2[16];
        for (int p = 0; p < 2; ++p) { const LAS float* sp = S + (h * 2 + p) * 128; int n = 0;
            for (int k = 0; k < 128; ++k) { int rank = 0; for (int k2 = 0; k2 < 128; ++k2) rank += (sp[k2] > sp[k] || (sp[k2] == sp[k] && k2 < k)) ? 1 : 0;
                if (rank < 16) { if (p == 0) { i1[rank] = k; s1[rank] = sp[k]; } else { i2[rank] = k; s2[rank] = sp[k]; } ++n; } } }
        for (int a = 0; a < 16; ++a) for (int c = 0; c < 16; ++c) { const float v = s1[a] + s2[c]; int rank = 0;
            for (int a2 = 0; a2 < 16; ++a2) for (int c2 = 0; c2 < 16; ++c2) { const float v2 = s1[a2] + s2[c2]; rank += (v2 > v || (v2 == v && (a2 * 16 + c2) < (a * 16 + c))) ? 1 : 0; }
            if (rank < 16) REF[h * 16 + rank] = i1[a] * 128 + i2[c]; } }
    __syncthreads();
    if (tid < 128) { const int h = tid >> 4; const int e = EIDX[(size_t)t * 128 + tid]; bool found = false; for (int k = 0; k < 16; ++k) found |= (REF[h * 16 + k] == e); if (!found) atomicAdd((int*)CNTW, 1); }
    __syncthreads();
    if (tid == 0 && *CNTW > 12) chk_fail(F, OFF_KIP);
    { const int slot = tid >> 2, part = tid & 3; const int e = EIDX[(size_t)t * 128 + slot]; float d = 0.f;
      for (int c = part * 256; c < part * 256 + 256; ++c) d += F.peer_u[(size_t)e * 1024 + c] * bf2f(H2[(size_t)t * 1024 + c]);
      d += __shfl_xor(d, 1); d += __shfl_xor(d, 2);
      if (part == 0) CO[slot] = G[(size_t)t * 128 + slot] * gelu_tanh(d); }
    __syncthreads();
    float err = 0.f, mag = 0.f;
    for (int c = tid; c < 1024; c += 512) { float o = 0.f; for (int slot = 0; slot < 128; ++slot) o += CO[slot] * F.peer_v[(size_t)EIDX[(size_t)t * 128 + slot] * 1024 + c];
        const float g2 = MOD[(size_t)mod_row(t) * NMOD + 5 * 1024 + c]; const float ref = g2 * o, got = F.out[(size_t)t * 1024 + c] - ((t < TP ? F.x_prompt[(size_t)t * 1024 + c] : F.x_sample[(size_t)(t - TP) * 1024 + c]) + bf2f(Dm[(size_t)t * 1024 + c]));
        err = fmaxf(err, fabsf(ref - got)); mag = fmaxf(mag, fabsf(ref)); }
    err = wave_max(err); mag = wave_max(mag);
    LAS float* RED = (LAS float*)(F.lds + 8192 + 2048);
    if (F.lane == 0) { RED[F.wave] = err; RED[8 + F.wave] = mag; }
    __syncthreads();
    if (tid == 0) { float e2 = 0.f, m2 = 0.f; for (int w = 0; w < 8; ++w) { e2 = fmaxf(e2, RED[w]); m2 = fmaxf(m2, RED[8 + w]); } if (!(e2 <= 0.12f * m2 + 1e-4f)) chk_fail(F, OFF_CONVP); }
}
#endif

constexpr int N_PHASES = 15;
__device__ __forceinline__ void p1_fold_weight(const Frame& F) {
 bf16_t* WQF = WSP(bf16_t, WS_WQ); const bf16_t* WQN = WSP(bf16_t, WS_Q2); const bf16_t* SKC = WSP(bf16_t, WS_SKBD);
          const int q = F.lane & 31, half = F.lane >> 5;
          for (int gw = F.bid * 8 + F.wave; gw < 2048; gw += F.nblk * 8) {
              const int kr = gw & 31, nc = gw >> 5;
              const bf16_t* ap = WQN + (size_t)(kr * 32 + q) * 2048 + (nc >> 2) * 128 + half * 8;
              const bf16_t* bp = SKC + (size_t)(nc * 32 + q) * 128 + half * 8;
              u32x4 a[8], b[8];
#pragma unroll
              for (int s = 0; s < 8; ++s) { a[s] = *(const u32x4*)(ap + s * 16); b[s] = *(const u32x4*)(bp + s * 16); }
              f32x16 acc;
#pragma unroll
              for (int i = 0; i < 16; ++i) acc[i] = 0.f;
#pragma unroll
              for (int s = 0; s < 8; ++s) acc = __builtin_amdgcn_mfma_f32_32x32x16_bf16(__builtin_bit_cast(bf16x8, a[s]), __builtin_bit_cast(bf16x8, b[s]), acc, 0, 0, 0);
              bf16_t* dp = WQF + (size_t)(nc * 32 + q) * 1024 + kr * 32 + 4 * half;
#pragma unroll
              for (int g4 = 0; g4 < 4; ++g4) { u32x2 d; d.x = cvt_pk_bf16(acc[4 * g4], acc[4 * g4 + 1]); d.y = cvt_pk_bf16(acc[4 * g4 + 2], acc[4 * g4 + 3]); *(u32x2*)(dp + 8 * g4) = d; }
          }
}

__global__ void __launch_bounds__(512, 2) fwd_kernel(Params P) {
    extern __shared__ __attribute__((aligned(16))) unsigned char lds_raw[];
    Frame F;
    F.lds = (LAS unsigned char*)lds_raw; F.tid = threadIdx.x; F.lane = F.tid & 63; F.wave = __builtin_amdgcn_readfirstlane(F.tid >> 6); F.bid = blockIdx.x; F.nblk = gridDim.x;
    F.ws = P.ws; F.ctl = (unsigned*)(P.ws + WS_CTL); F.out = P.out;
    F.x_prompt = P.in[0]; F.x_sample = P.in[1]; F.cache_k = P.in[2]; F.cache_v = P.in[3]; F.cache_kidx = P.in[4]; F.state_conv = P.in[5]; F.page_table = (const int*)P.in[6];
    F.c_prompt = P.in[7]; F.c_sample = P.in[8]; F.w_ada = P.in[9]; F.b_ada = P.in[10]; F.norm1_w = P.in[11]; F.w_in = P.in[12]; F.conv_w = P.in[13]; F.q_norm_w = P.in[14]; F.k_norm_w = P.in[15];
    F.w_conv_out = P.in[16]; F.w_attn_out = P.in[17]; F.w_out = P.in[18]; F.norm2_w = P.in[19]; F.peer_w_q = P.in[20]; F.peer_sub_keys = P.in[21]; F.peer_u = P.in[22]; F.peer_v = P.in[23];
    if (F.tid < 16) ((LAS unsigned*)(F.lds + LDS_MISC))[F.tid] = 0u;
    __syncthreads();
    const int lo = P.ph_lo, hi = P.ph_hi;
    const bool one = (hi - lo) > 1;
    XcdBarrier bar; bar.bar = F.ctl + CW_BAR; bar.x = 0; bar.st = nullptr;
    if (one) bar = xcd_barrier_post(F.ctl + CW_BAR, (volatile LAS unsigned*)(F.lds + LDS_MISC));
#define IN(k) (lo <= (k) && (k) < hi)
#define SEAM(k) do { if (IN(k) && IN((k) + 1)) xcd_barrier(bar); } while (0)

#define PHASE(k, ...) do { if (IN(k)) { const int rep = 0; __VA_ARGS__; } SEAM(k); } while (0)

    PHASE(0, p0_convert(F));
    PHASE(1, {
        float* MODw = WSP(float, WS_MOD); const float* bias = F.b_ada;
        skinny_phase<false>(F, WSP(bf16_t, WS_CB), WSP(bf16_t, WS_WADA), nullptr, nullptr, 1024, 1024, NMOD, 0, 3, [=](int r, int c, const float (&s01)[4], const float (&s23)[4]) {
            const f32x4 bv = *(const f32x4*)(bias + c);
            *(f32x4*)(MODw + (size_t)r * NMOD + c) = (f32x4){s01[0] + s23[0] + bv[0], s01[1] + s23[1] + bv[1], s01[2] + s23[2] + bv[2], s01[3] + s23[3] + bv[3]}; });
        p1_fold_weight(F); });
    PHASE(2, row_norm_pass<false>(F));
    PHASE(3, {
        pg8::Gemm g{WSP(bf16_t, WS_H), WSP(bf16_t, WS_WIN), T, NPROJ_PAD, 1024, 1024, 1024, 0}; pg8::StaticOrder S; S.init(T, NPROJ_PAD, F.nblk, F.bid);
        EpiInProj E{WSP(bf16_t, WS_U), WSP(bf16_t, WS_BG), WSP(bf16_t, WS_Q), WSP(bf16_t, WS_K), WSP(bf16_t, WS_V), WSP(bf16_t, WS_QI), WSP(bf16_t, WS_KI), WSP(bf16_t, WS_SGA), WSP(bf16_t, WS_SGB),
                    WSP(float, WS_WI), F.q_norm_w, F.k_norm_w, WSP(f32x2, WS_ROPE), F.out};
        pg8::gemm_phase(F.lds, g, S, E);
        { const int tail = S.nwg % F.nblk;
          if (tail == 0) p0_peer_tables(F, F.bid, F.nblk); else if (F.bid >= tail) p0_peer_tables(F, F.bid - tail, F.nblk - tail); } });
    PHASE(4, p4_all(F, rep, P.pad));
#if SELF_CHECK
#define SC_MASK() self_check_mask(F)
#define SC_ATTN() self_check_attn(F)
#else
#define SC_MASK() do {} while (0)
#define SC_ATTN() do {} while (0)
#endif
    PHASE(5, { SC_MASK(); p5_all(F, rep); });
    PHASE(6, { SC_ATTN();
        { pg8::Gemm g{WSP(bf16_t, WS_APRE), WSP(bf16_t, WS_WCO), TP, 1024, 1024, 512, 512, 0, WSP(bf16_t, WS_ATT), WSP(bf16_t, WS_WAO)}; pg8::StaticOrder S; S.init(TP, 1024, F.nblk, F.bid);
          EpiMixFused E{WSP(bf16_t, WS_SGA), WSP(bf16_t, WS_SGB), WSP(bf16_t, WS_MIX)}; pg8::gemm_phase<EpiMixFused, pg8::StaticOrder, true, true, true>(F.lds, g, S, E); }
        { const bf16_t* SGA = WSP(bf16_t, WS_SGA); const bf16_t* SGB = WSP(bf16_t, WS_SGB); bf16_t* MIX = WSP(bf16_t, WS_MIX);
          skinny_phase<true>(F, WSP(bf16_t, WS_APRE), WSP(bf16_t, WS_WCO), WSP(bf16_t, WS_ATT), WSP(bf16_t, WS_WAO), 512, 512, 1024, TP, 8, [=](int r, int c, const float (&s01)[4], const float (&s23)[4]) {
              const size_t o = (size_t)r * 1024 + c; const u32x2 ga = *(const u32x2*)(SGA + o), gb = *(const u32x2*)(SGB + o);
              u32x2 m; m.x = cvt_pk_bf16(bf_lo(ga.x) * s01[0] + bf_lo(gb.x) * s23[0], bf_hi(ga.x) * s01[1] + bf_hi(gb.x) * s23[1]);
              m.y = cvt_pk_bf16(bf_lo(ga.y) * s01[2] + bf_lo(gb.y) * s23[2], bf_hi(ga.y) * s01[3] + bf_hi(gb.y) * s23[3]); *(u32x2*)(MIX + o) = m; }); } });
    PHASE(7, {
        pg8::Gemm g{WSP(bf16_t, WS_MIX), WSP(bf16_t, WS_WOUT), TP, 1024, 1024, 1024, 1024, 0}; pg8::StaticOrder S; S.init(TP, 1024, F.nblk, F.bid);
        EpiOut E{WSP(float, WS_MOD), WSP(bf16_t, WS_X1)}; pg8::gemm_phase(F.lds, g, S, E);
        { const float* MOD = WSP(float, WS_MOD); bf16_t* Dm = WSP(bf16_t, WS_X1);
          skinny_phase<false>(F, WSP(bf16_t, WS_MIX), WSP(bf16_t, WS_WOUT), nullptr, nullptr, 1024, 1024, 1024, TP, 8, [=](int r, int c, const float (&s01)[4], const float (&s23)[4]) {
              const f32x4 g1 = *(const f32x4*)(MOD + (size_t)mod_row(r) * NMOD + 2048 + c);
              u32x2 d; d.x = cvt_pk_bf16(g1[0] * (s01[0] + s23[0]), g1[1] * (s01[1] + s23[1])); d.y = cvt_pk_bf16(g1[2] * (s01[2] + s23[2]), g1[3] * (s01[3] + s23[3]));
              *(u32x2*)(Dm + (size_t)r * 1024 + c) = d; }); } });
    PHASE(8, row_norm_pass<true>(F));
    PHASE(9, {
        pg8::Gemm g{WSP(bf16_t, WS_H), WSP(bf16_t, WS_WQ), TP, 2048, 1024, 1024, 1024, 0}; pg8::StaticOrder S; S.init(TP, 2048, F.nblk, F.bid);
        EpiPST E{WSP(unsigned short, WS_SCR)}; pg8::gemm_phase<EpiPST, pg8::StaticOrder, false, true>(F.lds, g, S, E);
        { unsigned short* PST = WSP(unsigned short, WS_SCR);
          skinny_phase<false>(F, WSP(bf16_t, WS_H), WSP(bf16_t, WS_WQ), nullptr, nullptr, 1024, 1024, 2048, TP, 8, [=](int r, int c, const float (&s01)[4], const float (&s23)[4]) {
              u32x2 d; d.x = cvt_pk_f16(s01[0] + s23[0], s01[1] + s23[1]); d.y = cvt_pk_f16(s01[2] + s23[2], s01[3] + s23[3]);
              *(u32x2*)(PST + (size_t)((r >> 8) * 8 + (c >> 8)) * 65536 + (size_t)(r & 255) * 256 + (c & 255)) = d; }); } });
    PHASE(11, p11_select(F));
    PHASE(12, p12a_act(F, P.pad));
    PHASE(13, p12c_coef(F));
    PHASE(14, p12b_out(F));
#if SELF_CHECK
    xcd_barrier(bar);
    self_check_peer(F);
#endif
#undef PHASE
#undef IN
#undef SEAM
}

extern "C" void kernel_launch(void* const* d_in, const int* in_sizes, int n_in, void* d_out, int out_size, void* d_ws, size_t ws_size, hipStream_t stream) {
    static int grid = 0;
    if (grid == 0) {
        if (n_in != 24 || (size_t)out_size != OUT_TOTAL || ws_size < WS_END) { fprintf(stderr, "kernel_launch: unexpected sizes n_in %d out %d ws %zu (need %zu)\n", n_in, out_size, ws_size, (size_t)WS_END); grid = -1; return; }
        int dev = 0, cus = 0, per_cu = 0;
        if (hipGetDevice(&dev) != hipSuccess || hipDeviceGetAttribute(&cus, hipDeviceAttributeMultiprocessorCount, dev) != hipSuccess) { grid = -1; return; }
        if (hipFuncSetAttribute((const void*)fwd_kernel, hipFuncAttributeMaxDynamicSharedMemorySize, LDS_BYTES) != hipSuccess) { fprintf(stderr, "kernel_launch: hipFuncSetAttribute failed\n"); grid = -1; return; }
        if (hipOccupancyMaxActiveBlocksPerMultiprocessor(&per_cu, (const void*)fwd_kernel, 512, LDS_BYTES) != hipSuccess || per_cu < 1) { fprintf(stderr, "kernel_launch: occupancy query says %d\n", per_cu); }
        (void)hipGetLastError();
        grid = cus;
    }
    if (grid < 0) return;
    (void)hipMemsetAsync((char*)d_ws + WS_CTL, 0, CTL_BYTES, stream);
    Params p{};
    for (int i = 0; i < 24; ++i) p.in[i] = (const float*)d_in[i];
    p.out = (float*)d_out; p.ws = (unsigned char*)d_ws; p.rep_mask = 0; p.pad = 15;
#if N_LAUNCH_MODE == 1
    p.ph_lo = 0; p.ph_hi = N_PHASES;
    hipLaunchKernelGGL(fwd_kernel, dim3(grid), dim3(512), LDS_BYTES, stream, p);
#else
    for (int k = 0; k < N_PHASES; ++k) { p.ph_lo = k; p.ph_hi = k + 1; hipLaunchKernelGGL(fwd_kernel, dim3(grid), dim3(512), LDS_BYTES, stream, p);
        if ((REPEAT_MASK >> k) & 1) { (void)hipMemsetAsync((char*)d_ws + WS_CTL, 0, CTL_BYTES, stream); p.pad = PROBE_PARTS; hipLaunchKernelGGL(fwd_kernel, dim3(grid), dim3(512), LDS_BYTES, stream, p); p.pad = 15; } }
#endif
}
```
